# Optimizing an MI355X kernel written in HIP

```python
import jax, jax.numpy as jnp
from jax import lax
import numpy as np

D_MODEL = 1024
BATCH = 8
SEQ = 2048
DEPTH = 1

CHUNK = 64
Q_BLOCK = 128
MLA_HEADS = 8
MLA_NOPE = 64
MLA_ROPE = 32
MLA_V = 64
Q_LORA = 384
KV_LORA = 256
ROPE_THETA = 10000.0
HG_HEADS = 4
HG_DK = 128
HG_DV = 128
D_MIX = MLA_HEADS * MLA_V + HG_HEADS * HG_DV
IN_SPLITS = (Q_LORA, KV_LORA, MLA_ROPE, HG_HEADS * HG_DK, HG_HEADS * HG_DK, HG_HEADS * HG_DV, HG_HEADS * HG_DV)
IN_COLS = Q_LORA + KV_LORA + MLA_ROPE + 2 * HG_HEADS * HG_DK + 2 * HG_HEADS * HG_DV
N_EXPERTS = 32
TOP_K = 4
D_EXPERT = 1024
SWIGLU_LIMIT = 7.0
SWIGLU_ALPHA = 1.702
MOE_BLOCK = 128
LN_EPS = 1e-5
RMS_EPS = 1e-6
DEEPNORM_ALPHA = (2.0 * DEPTH) ** 0.25
DEEPNORM_BETA = (8.0 * DEPTH) ** -0.25

kernel_name = "hymba_mla_hgrn2_gptoss_moe_deepnorm"


def layer_norm(x, g, b):
    xf = x.astype(jnp.float32)
    mu = jnp.mean(xf, axis=-1, keepdims=True)
    var = jnp.mean(jnp.square(xf - mu), axis=-1, keepdims=True)
    return ((xf - mu) * lax.rsqrt(var + LN_EPS) * g + b).astype(x.dtype)


def rms_norm(x, g):
    xf = x.astype(jnp.float32)
    return (xf * lax.rsqrt(jnp.mean(jnp.square(xf), axis=-1, keepdims=True) + RMS_EPS) * g).astype(x.dtype)


def rope_cos_sin(positions):
    inv_freq = ROPE_THETA ** (-jnp.arange(0, MLA_ROPE, 2, dtype=jnp.float32) / MLA_ROPE)
    ang = positions.astype(jnp.float32)[..., None] * inv_freq
    return jnp.cos(ang), jnp.sin(ang)


def apply_rope(x, cos, sin):
    x1, x2 = jnp.split(x.astype(jnp.float32), 2, axis=-1)
    return jnp.concatenate([x1 * cos - x2 * sin, x1 * sin + x2 * cos], axis=-1).astype(x.dtype)


def mla_attention(q_nope, q_rope, k_nope, k_rope, v):
    B, S, H, _ = q_nope.shape
    n_blocks = S // Q_BLOCK
    key_chunk = jnp.arange(S) // CHUNK
    scale = (MLA_NOPE + MLA_ROPE) ** -0.5

    def one_block(i):
        start = i * Q_BLOCK
        qn = lax.dynamic_slice_in_dim(q_nope, start, Q_BLOCK, axis=1)
        qr = lax.dynamic_slice_in_dim(q_rope, start, Q_BLOCK, axis=1)
        s = (jnp.einsum("bqhd,bkhd->bhqk", qn, k_nope)
             + jnp.einsum("bqhr,bkr->bhqk", qr, k_rope)).astype(jnp.float32) * scale
        q_chunk = (start + jnp.arange(Q_BLOCK)) // CHUNK
        mask = key_chunk[None, :] <= q_chunk[:, None]
        p = jax.nn.softmax(jnp.where(mask, s, -jnp.inf), axis=-1).astype(v.dtype)
        return jnp.einsum("bhqk,bkhd->bqhd", p, v)

    out = lax.map(one_block, jnp.arange(n_blocks))
    return out.transpose(1, 0, 2, 3, 4).reshape(B, S, H * v.shape[-1])


def hgrn2_chunkwise(q, k, log_f, v):
    B, S, H, DK = q.shape
    DV = v.shape[-1]
    N = S // CHUNK

    def to_chunks(a):
        return a.astype(jnp.float32).reshape(B, N, CHUNK, H, a.shape[-1]).swapaxes(0, 1)

    causal = jnp.tril(jnp.ones((CHUNK, CHUNK), dtype=bool))[None, :, :, None, None]

    def step(state, inp):
        qc, kc, lfc, vc = inp
        b = jnp.cumsum(lfc, axis=1)
        b_last = b[:, -1]
        diff = b[:, :, None] - b[:, None, :]
        decay = jnp.exp(jnp.where(causal, diff, -jnp.inf))
        scores = jnp.einsum("bthk,btshk,bshk->bhts", qc, decay, kc)
        o = (jnp.einsum("bhts,bshv->bthv", scores, vc)
             + jnp.einsum("bthk,bhkv->bthv", qc * jnp.exp(b), state))
        new_state = (jnp.exp(b_last)[..., None] * state
                     + jnp.einsum("bshk,bshv->bhkv", kc * jnp.exp(b_last[:, None] - b), vc))
        return new_state, o

    s0 = jnp.zeros((B, H, DK, DV), jnp.float32)
    _, o = lax.scan(step, s0, (to_chunks(q), to_chunks(k), to_chunks(log_f), to_chunks(v)))
    return o.swapaxes(0, 1).reshape(B, S, H, DV)


def hybrid_mixer(h, cos, sin, lb, w_in, q_a_norm_g, w_q_b, kv_a_norm_g, w_kv_b, mla_out_g, hgrn_out_g, w_o):
    B, S, _ = h.shape
    offsets = [int(o) for o in np.cumsum(IN_SPLITS)[:-1]]
    q_a, kv_a, k_rope, hq, hf, hi, hg = jnp.split(h @ w_in, offsets, axis=-1)

    q = (rms_norm(q_a, q_a_norm_g) @ w_q_b).reshape(B, S, MLA_HEADS, MLA_NOPE + MLA_ROPE)
    q_nope = q[..., :MLA_NOPE]
    q_rope = apply_rope(q[..., MLA_NOPE:], cos[:, :, None], sin[:, :, None])
    kv = (rms_norm(kv_a, kv_a_norm_g) @ w_kv_b).reshape(B, S, MLA_HEADS, MLA_NOPE + MLA_V)
    k_nope, v = kv[..., :MLA_NOPE], kv[..., MLA_NOPE:]
    k_rope = apply_rope(k_rope, cos, sin)
    attn = rms_norm(mla_attention(q_nope, q_rope, k_nope, k_rope, v), mla_out_g)

    def heads(a, d):
        return a.reshape(B, S, HG_HEADS, d)
    forget = lb + (1.0 - lb) * jax.nn.sigmoid(hf.astype(jnp.float32))
    o = hgrn2_chunkwise(heads(jax.nn.silu(hq), HG_DK), heads(1.0 - forget, HG_DK),
                        heads(jnp.log(forget), HG_DK), heads(hi, HG_DV))
    o = rms_norm(o, hgrn_out_g.reshape(HG_HEADS, HG_DV)) * jax.nn.silu(heads(hg, HG_DV).astype(jnp.float32))
    o = o.reshape(B, S, HG_HEADS * HG_DV).astype(h.dtype)

    return jnp.concatenate([attn, o], axis=-1) @ w_o


def moe_ffn(h, w_router, b_router, w_up, b_up, w_down, b_down):
    B, S, D = h.shape
    T = B * S
    A = T * TOP_K
    xt = h.reshape(T, D)
    logits = (xt @ w_router + b_router).astype(jnp.float32)
    top_logit, top_e = lax.top_k(logits, TOP_K)
    gate = jax.nn.softmax(top_logit, axis=-1)

    flat_e = top_e.reshape(A)
    order = jnp.argsort(flat_e, stable=True)
    sorted_e = flat_e[order]
    sorted_tok = (order // TOP_K).astype(jnp.int32)
    sorted_gate = gate.reshape(A)[order]
    counts = jnp.bincount(flat_e, length=N_EXPERTS)
    padded = (counts + MOE_BLOCK - 1) // MOE_BLOCK * MOE_BLOCK
    start = jnp.cumsum(counts) - counts
    pad_end = jnp.cumsum(padded)
    pad_start = pad_end - padded
    dest = pad_start[sorted_e] + (jnp.arange(A) - start[sorted_e])
    n_blocks = -(-A // MOE_BLOCK) + N_EXPERTS
    P = n_blocks * MOE_BLOCK
    slot_tok = jnp.zeros((P,), jnp.int32).at[dest].set(sorted_tok)
    slot_gate = jnp.zeros((P,), jnp.float32).at[dest].set(sorted_gate)
    block_e = jnp.minimum(jnp.searchsorted(pad_end, jnp.arange(n_blocks) * MOE_BLOCK, side="right"),
                          N_EXPERTS - 1)
    xs = xt[slot_tok].reshape(n_blocks, MOE_BLOCK, D)

    def expert_block(args):
        xb, e = args
        hb = xb @ w_up[e] + b_up[e]
        glu, lin = jnp.split(hb, 2, axis=-1)
        glu = jnp.minimum(glu, SWIGLU_LIMIT)
        lin = jnp.clip(lin, -SWIGLU_LIMIT, SWIGLU_LIMIT)
        act = glu * jax.nn.sigmoid(SWIGLU_ALPHA * glu) * (lin + 1.0)
        return act @ w_down[e] + b_down[e]

    ys = lax.map(expert_block, (xs, block_e)).reshape(P, D)
    ys = ys * slot_gate[:, None].astype(ys.dtype)
    out = jnp.zeros((T, D), h.dtype).at[slot_tok].add(ys.astype(h.dtype))
    return out.reshape(B, S, D)


def setup_inputs(seed: int = 0) -> dict:
    key = jax.random.key(seed)
    ks = jax.random.split(key, 24)
    f32 = jnp.float32

    def dense(k, shape, fan_in, scale=1.0):
        return jax.random.normal(k, shape, f32) * (scale * fan_in ** -0.5)

    def gain(k, shape):
        return 1.0 + 0.02 * jax.random.normal(k, shape, f32)

    def bias(k, shape, s=0.02):
        return s * jax.random.normal(k, shape, f32)

    x = jax.random.normal(ks[0], (BATCH, SEQ, D_MODEL), f32)
    positions = (jax.random.randint(ks[1], (BATCH, 1), 0, 4096, dtype=jnp.int32)
                 + jnp.arange(SEQ, dtype=jnp.int32)[None, :])
    hv = HG_HEADS * HG_DV
    in_col_scale = jnp.concatenate([jnp.ones((IN_COLS - 2 * hv,), f32),
                                    jnp.full((hv,), DEEPNORM_BETA, f32),
                                    jnp.ones((hv,), f32)])
    kvb_col_scale = jnp.tile(jnp.concatenate([jnp.ones((MLA_NOPE,), f32),
                                              jnp.full((MLA_V,), DEEPNORM_BETA, f32)]), MLA_HEADS)
    return {
        "x": x,
        "positions": positions,
        "ln_in_g": gain(ks[2], (D_MODEL,)),
        "ln_in_b": bias(ks[3], (D_MODEL,)),
        "w_in": dense(ks[4], (DEPTH, D_MODEL, IN_COLS), D_MODEL) * in_col_scale,
        "q_a_norm_g": gain(ks[5], (DEPTH, Q_LORA)),
        "w_q_b": dense(ks[6], (DEPTH, Q_LORA, MLA_HEADS * (MLA_NOPE + MLA_ROPE)), Q_LORA),
        "kv_a_norm_g": gain(ks[7], (DEPTH, KV_LORA)),
        "w_kv_b": dense(ks[8], (DEPTH, KV_LORA, MLA_HEADS * (MLA_NOPE + MLA_V)), KV_LORA) * kvb_col_scale,
        "hgrn_lb_logits": 0.5 * jax.random.normal(ks[9], (DEPTH + 1, HG_HEADS * HG_DK), f32),
        "mla_out_g": gain(ks[10], (DEPTH, MLA_HEADS * MLA_V)),
        "hgrn_out_g": gain(ks[11], (DEPTH, HG_HEADS * HG_DV)),
        "w_o": dense(ks[12], (DEPTH, D_MIX, D_MODEL), D_MIX, DEEPNORM_BETA),
        "ln1_g": gain(ks[13], (DEPTH, D_MODEL)),
        "ln1_b": bias(ks[14], (DEPTH, D_MODEL)),
        "w_router": dense(ks[15], (DEPTH, D_MODEL, N_EXPERTS), D_MODEL),
        "b_router": bias(ks[16], (DEPTH, N_EXPERTS), 0.01),
        "w_up": dense(ks[17], (DEPTH, N_EXPERTS, D_MODEL, 2 * D_EXPERT), D_MODEL),
        "b_up": bias(ks[18], (DEPTH, N_EXPERTS, 2 * D_EXPERT)),
        "w_down": dense(ks[19], (DEPTH, N_EXPERTS, D_EXPERT, D_MODEL), D_EXPERT, DEEPNORM_BETA),
        "b_down": bias(ks[20], (DEPTH, N_EXPERTS, D_MODEL)),
        "ln2_g": gain(ks[21], (DEPTH, D_MODEL)),
        "ln2_b": bias(ks[22], (DEPTH, D_MODEL)),
    }


def reference(x, positions, ln_in_g, ln_in_b, w_in, q_a_norm_g, w_q_b, kv_a_norm_g, w_kv_b,
              hgrn_lb_logits, mla_out_g, hgrn_out_g, w_o, ln1_g, ln1_b, w_router, b_router,
              w_up, b_up, w_down, b_down, ln2_g, ln2_b):
    cos, sin = rope_cos_sin(positions)
    lower_bounds = jnp.cumsum(jax.nn.softmax(hgrn_lb_logits.astype(jnp.float32), axis=0), axis=0)
    h = layer_norm(x, ln_in_g, ln_in_b)
    for l in range(DEPTH):
        mix = hybrid_mixer(h, cos, sin, lower_bounds[l], w_in[l], q_a_norm_g[l], w_q_b[l],
                           kv_a_norm_g[l], w_kv_b[l], mla_out_g[l], hgrn_out_g[l], w_o[l])
        h = layer_norm(DEEPNORM_ALPHA * h + mix, ln1_g[l], ln1_b[l])
        ffn = moe_ffn(h, w_router[l], b_router[l], w_up[l], b_up[l], w_down[l], b_down[l])
        h = layer_norm(DEEPNORM_ALPHA * h + ffn, ln2_g[l], ln2_b[l])
    return h
```

```cpp
#include <hip/hip_runtime.h>
#include <cstdio>
#include <cstdint>

#ifndef DBG_STAGE
#define DBG_STAGE 0
#endif

#define GAS __attribute__((address_space(1)))
#define LAS __attribute__((address_space(3)))
typedef unsigned short bf16_t;
typedef short bf16x8 __attribute__((ext_vector_type(8)));
typedef float f32x4 __attribute__((ext_vector_type(4)));
typedef float f32x2 __attribute__((ext_vector_type(2)));
typedef unsigned u32x4 __attribute__((ext_vector_type(4)));
typedef unsigned u32x2 __attribute__((ext_vector_type(2)));
typedef GAS unsigned gu32;

constexpr int T = 16384, SEQ = 2048, NB = 8, D = 1024;
constexpr int IN_COLS = 2720, NPROJ = 2816;
constexpr int QL = 384, KVL = 256;
constexpr int NE = 32, DE = 1024;
constexpr float LN_EPS = 1e-5f, RMS_EPS = 1e-6f;
constexpr float DN_ALPHA = 1.189207115002721f;
constexpr int PC_KVA = 0, PC_QA = 256, PC_KR = 640, PC_HQ = 768, PC_HF = 1280, PC_HI = 1792, PC_HG = 2304;

constexpr size_t MiB = 1u << 20;
constexpr size_t WS_CTL = 0, CTL_ZERO_BYTES = 1 * MiB;
constexpr size_t WS_COS = 1 * MiB, WS_SIN = 2 * MiB, WS_LB = 3 * MiB;
constexpr size_t WS_WIN = 4 * MiB;
constexpr size_t WS_WQB = 10 * MiB, WS_WKVB = 11 * MiB, WS_WO = 12 * MiB;
constexpr size_t WS_WUP = 14 * MiB;
constexpr size_t WS_WDN = 142 * MiB;
constexpr size_t WS_H0 = 206 * MiB;
constexpr size_t WS_PROJ = 238 * MiB;
constexpr size_t WS_Q = 326 * MiB;
constexpr size_t WS_KV = 350 * MiB;
constexpr size_t WS_MIX = 382 * MiB;
constexpr size_t WS_SSQ = 414 * MiB;
constexpr size_t WS_LT = 416 * MiB;
constexpr size_t WS_SST = 480 * MiB;
constexpr size_t WS_DEC = 512 * MiB;
constexpr size_t WS_Y = 514 * MiB;
constexpr size_t WS_H1 = 578 * MiB;
constexpr size_t WS_LTOK = 610 * MiB, WS_LGATE = 612 * MiB, WS_TSLOT = 614 * MiB;
constexpr size_t WS_ACT = 616 * MiB;
constexpr size_t WS_YS = 760 * MiB;
constexpr size_t WS_END_A = 904 * MiB;
constexpr int CW_CNT = 1024;
constexpr int CW_DBG = 8;
constexpr int CW_BAR = 4096;

constexpr int RING_BYTES = 131072;
constexpr int XTRA_OFF = RING_BYTES, XTRA_BYTES = 20480;
constexpr int MISC_OFF = XTRA_OFF + XTRA_BYTES;
constexpr int LDS_BYTES = MISC_OFF + 256;

#define RLX_AGENT __ATOMIC_RELAXED, __HIP_MEMORY_SCOPE_AGENT
#define LDS_WAIT() asm volatile("s_waitcnt lgkmcnt(0)" ::: "memory")
#define VM_WAIT() asm volatile("s_waitcnt vmcnt(0)" ::: "memory")
__device__ __forceinline__ unsigned f2bf(float f) { unsigned u = __builtin_bit_cast(unsigned, f); return (u + 0x7fffu + ((u >> 16) & 1u)) >> 16; }
__device__ __forceinline__ unsigned pk2(float lo, float hi) { return f2bf(lo) | (f2bf(hi) << 16); }
__device__ __forceinline__ float bf2f(bf16_t h) { return __builtin_bit_cast(float, (unsigned)h << 16); }
__device__ __forceinline__ float wave_sum(float v) {
#pragma unroll
    for (int o = 1; o < 64; o <<= 1) v += __shfl_xor(v, o);
    return v;
}
__device__ __forceinline__ int fresh_lane() { int l; asm volatile("v_mbcnt_lo_u32_b32 %0, -1, 0\n\tv_mbcnt_hi_u32_b32 %0, -1, %0" : "=v"(l)); return l; }
__device__ __forceinline__ float silu_f(float x) { return x * __builtin_amdgcn_rcpf(1.f + __expf(-x)); }

namespace pg8 {
constexpr int BM = 256, BK = 64, HALF = 128, HTB = HALF * BK * 2, STAGE_BYTES = 8 * HTB, NXCD = 8, WGM = 8;
__host__ __device__ __forceinline__ int lds_byte(int r, int c) { const int st = (r >> 4) * 2 + (c >> 5), rr = r & 15, cc = c & 31, ob = rr * 64 + cc * 2; return st * 1024 + (ob ^ (((ob >> 9) & 1) << 5)); }
__host__ __device__ __forceinline__ void stage_rc(int b, int& R, int& C) { const int st = b / 1024, sb = b % 1024, swz = sb ^ (((sb >> 9) & 1) << 5); R = (st >> 1) * 16 + swz / 64; C = (st & 1) * 32 + (swz % 64) / 2; }
__host__ __device__ __forceinline__ int perm32(int rho) { const int n = rho >> 4, i = rho & 15; return 8 * (i >> 2) + 4 * n + (i & 3); }

struct Unit { int pm, pn, e; };

struct DenseOrder {
    const bf16_t* A; const bf16_t* Bt; int lda, K;
    int nM, nN, nwg, G, c;
    __device__ __forceinline__ void init(const bf16_t* A_, int lda_, const bf16_t* Bt_, int K_, int M, int N, int G_, int c_) { A = A_; Bt = Bt_; lda = lda_; K = K_; nM = M / BM; nN = N / BM; nwg = nM * nN; G = G_; c = c_; }
    __device__ __forceinline__ bool next(int i, Unit& u) const {
        const long L = (long)i * G + c; if (L >= nwg) return false;
        int wgid = (int)L; { const int q = nwg / NXCD, r = nwg % NXCD, xcd = wgid % NXCD, off = wgid / NXCD; wgid = (xcd < r ? xcd * (q + 1) : r * (q + 1) + (xcd - r) * q) + off; }
        const int nig = WGM * nN, gid = wgid / nig, fm = gid * WGM, gsz = (nM - fm) < WGM ? (nM - fm) : WGM;
        u.pm = fm + ((wgid % nig) % gsz); u.pn = (wgid % nig) / gsz; u.e = 0; return true;
    }
    __device__ __forceinline__ const char* a_base(const Unit& u) const { return (const char*)A + (size_t)u.pm * BM * lda * 2; }
    __device__ __forceinline__ const char* b_base(const Unit& u) const { return (const char*)Bt + (size_t)u.pn * BM * K * 2; }
    __device__ __forceinline__ void a_offs(const Unit&, const int (&R)[2], const int (&C)[2], unsigned (&v)[2][2]) const {
#pragma unroll
        for (int h = 0; h < 2; ++h)
#pragma unroll
            for (int i = 0; i < 2; ++i) v[h][i] = (unsigned)((h * HALF + R[i]) * lda + C[i]) * 2u;
    }
    static constexpr bool GATHER = false;
};

template <class Epi, class Sched>
__device__ __forceinline__ void gemm_phase(LAS unsigned char* lds, const int K, const Sched& S, const Epi& E, const int wave) {
    const int lane = fresh_lane(), wid = wave, tid = wid * 64 + lane, wr = wid >> 2, wc = wid & 3, fr = lane & 15, fq = lane >> 4;
    const int nt = K / BK;
    int RA[2], CA[2]; unsigned voffB[2];
#pragma unroll
    for (int i = 0; i < 2; ++i) { int R, C; stage_rc(tid * 16 + i * 8192, R, C); const int Rb = Epi::PERM ? ((R & ~31) + perm32(R & 31)) : R;
        RA[i] = R; CA[i] = C; voffB[i] = (unsigned)(Rb * K + C) * 2u; }
    const size_t kstep = (size_t)(BK * 2);
    const size_t hstepB = (size_t)HALF * K * 2;
    const unsigned ldsw = (unsigned)wid * 1024u;
    const int aoff = lds_byte(wr * 64 + fr, fq * 8), boff = lds_byte(wc * 32 + fr, fq * 8);
#define PG8_SA(b, h) (((b) * 2 + (h)) * HTB)
#define PG8_SB(b, h) ((4 + (b) * 2 + (h)) * HTB)
#define PG8_STAGE(bufoff, gbase, voff) do { _Pragma("unroll") for (int _i = 0; _i < 2; ++_i) \
        __builtin_amdgcn_global_load_lds((const unsigned*)((const char*)(gbase) + (voff)[_i]), (LAS unsigned*)(lds + (bufoff) + ldsw + _i * 8192), 16, 0, 0); } while (0)
#define PG8_LDA(dst, b, h) do { _Pragma("unroll") for (int m = 0; m < 4; ++m) _Pragma("unroll") for (int k = 0; k < 2; ++k) dst[m][k] = *(const LAS bf16x8*)(lds + PG8_SA(b, h) + aoff + m * 2048 + k * 1024); } while (0)
#define PG8_LDB(dst, b, h) do { _Pragma("unroll") for (int n = 0; n < 2; ++n) _Pragma("unroll") for (int k = 0; k < 2; ++k) dst[n][k] = *(const LAS bf16x8*)(lds + PG8_SB(b, h) + boff + n * 2048 + k * 1024); } while (0)
#define PG8_MMA(ai, bj, At, Bt) do { __builtin_amdgcn_s_setprio(1); _Pragma("unroll") for (int m = 0; m < 4; ++m) _Pragma("unroll") for (int n = 0; n < 2; ++n) _Pragma("unroll") for (int k = 0; k < 2; ++k) \
        acc[ai][bj][m][n] = __builtin_amdgcn_mfma_f32_16x16x32_bf16(Bt[n][k], At[m][k], acc[ai][bj][m][n], 0, 0, 0); __builtin_amdgcn_s_setprio(0); } while (0)
#define PG8_WAIT_V(n) asm volatile("s_waitcnt vmcnt(" #n ")" ::: "memory")
#define PG8_WAIT_L(n) asm volatile("s_waitcnt lgkmcnt(" #n ")" ::: "memory")
#define PG8_BAR __builtin_amdgcn_s_barrier()
#define PG8_SCHED __builtin_amdgcn_sched_barrier(0)
    Unit cur, nxt; int ui = 0;
    if (!S.next(0, cur)) return;
    f32x4 acc[2][2][4][2];
#pragma unroll
    for (int a = 0; a < 2; ++a)
#pragma unroll
        for (int b = 0; b < 2; ++b)
#pragma unroll
            for (int m = 0; m < 4; ++m)
#pragma unroll
                for (int n = 0; n < 2; ++n) acc[a][b][m][n] = (f32x4){0.f, 0.f, 0.f, 0.f};
    bf16x8 At[4][2], B0[2][2], B1[2][2];
    const char* cA = S.a_base(cur); const char* cB = S.b_base(cur);
    unsigned vC[2][2], vN[2][2];
    S.a_offs(cur, RA, CA, vC);
#pragma unroll
    for (int h = 0; h < 2; ++h) { vN[h][0] = vC[h][0]; vN[h][1] = vC[h][1]; }
    PG8_STAGE(PG8_SB(0, 0), cB, voffB); PG8_STAGE(PG8_SB(0, 1), cB + hstepB, voffB); PG8_STAGE(PG8_SA(0, 0), cA, vC[0]); PG8_STAGE(PG8_SA(0, 1), cA, vC[1]);
    if (wr == 1) PG8_BAR;
    PG8_WAIT_V(2); PG8_BAR;
    PG8_STAGE(PG8_SB(1, 0), cB + kstep, voffB); PG8_STAGE(PG8_SA(1, 0), cA + kstep, vC[0]); PG8_STAGE(PG8_SB(1, 1), cB + hstepB + kstep, voffB);
    PG8_WAIT_V(6); PG8_BAR;
    for (;;) {
        const bool has_next = S.next(ui + 1, nxt);
        const char* nA = has_next ? S.a_base(nxt) : cA; const char* nB = has_next ? S.b_base(nxt) : cB;
        if (Sched::GATHER) { if (has_next) S.a_offs(nxt, RA, CA, vN); else {
#pragma unroll
            for (int h = 0; h < 2; ++h) { vN[h][0] = vC[h][0]; vN[h][1] = vC[h][1]; } } }
#pragma nounroll
        for (int t = 0; t < nt; t += 2) {
            const bool last = (t == nt - 2);
            const char* a1 = cA + (size_t)(t + 1) * kstep;
            const char* a2 = last ? nA : cA + (size_t)(t + 2) * kstep; const char* b2 = last ? nB : cB + (size_t)(t + 2) * kstep;
            const char* a3 = a2 + kstep; const char* b3 = b2 + kstep;
            unsigned v2[2][2];
#pragma unroll
            for (int h = 0; h < 2; ++h) { v2[h][0] = (Sched::GATHER && last) ? vN[h][0] : vC[h][0]; v2[h][1] = (Sched::GATHER && last) ? vN[h][1] : vC[h][1]; }
            PG8_LDB(B0, 0, 0); PG8_LDB(B1, 0, 1); PG8_SCHED; PG8_LDA(At, 0, 0); PG8_STAGE(PG8_SA(1, 1), a1, vC[1]);
            PG8_WAIT_V(8); PG8_WAIT_L(0); PG8_BAR; PG8_MMA(0, 0, At, B0); PG8_MMA(0, 1, At, B1); PG8_BAR; PG8_SCHED;
            PG8_LDA(At, 0, 1); PG8_STAGE(PG8_SB(0, 0), b2, voffB); PG8_STAGE(PG8_SB(0, 1), b2 + hstepB, voffB); PG8_STAGE(PG8_SA(0, 0), a2, v2[0]);
            PG8_WAIT_V(8); PG8_WAIT_L(0); PG8_BAR; PG8_MMA(1, 0, At, B0); PG8_MMA(1, 1, At, B1); PG8_BAR; PG8_SCHED;
            PG8_LDB(B0, 1, 0); PG8_LDB(B1, 1, 1); PG8_SCHED; PG8_LDA(At, 1, 0); PG8_STAGE(PG8_SA(0, 1), a2, v2[1]);
            PG8_WAIT_V(8); PG8_WAIT_L(0); PG8_BAR; PG8_MMA(0, 0, At, B0); PG8_MMA(0, 1, At, B1); PG8_BAR; PG8_SCHED;
            PG8_LDA(At, 1, 1); PG8_STAGE(PG8_SB(1, 0), b3, voffB); PG8_STAGE(PG8_SB(1, 1), b3 + hstepB, voffB); PG8_STAGE(PG8_SA(1, 0), a3, v2[0]);
            PG8_WAIT_V(8); PG8_WAIT_L(0); PG8_BAR; PG8_MMA(1, 0, At, B0); PG8_MMA(1, 1, At, B1); PG8_BAR; PG8_SCHED;
        }
        if (wr == 0) PG8_BAR;
        { int fr_e = fr, fq_e = fq; asm volatile("" : "+v"(fr_e), "+v"(fq_e));
          E(acc, cur, wr, wc, fr_e, fq_e); }
        if (!has_next) break;
#pragma unroll
        for (int a = 0; a < 2; ++a)
#pragma unroll
            for (int b = 0; b < 2; ++b)
#pragma unroll
                for (int m = 0; m < 4; ++m)
#pragma unroll
                    for (int n = 0; n < 2; ++n) acc[a][b][m][n] = (f32x4){0.f, 0.f, 0.f, 0.f};
        cur = nxt; cA = nA; cB = nB; ++ui;
#pragma unroll
        for (int h = 0; h < 2; ++h) { vC[h][0] = vN[h][0]; vC[h][1] = vN[h][1]; }
        if (wr == 1) PG8_BAR;
    }
    PG8_WAIT_V(0);
    PG8_BAR;
#undef PG8_SA
#undef PG8_SB
#undef PG8_STAGE
#undef PG8_LDA
#undef PG8_LDB
#undef PG8_MMA
#undef PG8_WAIT_V
#undef PG8_WAIT_L
#undef PG8_BAR
#undef PG8_SCHED
}
}

#define XB_TMO      128
#define XB_XCNT(j)  (256  + 64 * (j))
#define XB_XSUB(j)  (1280 + 64 * (j))
#define XB_XGEN(j)  (2304 + 64 * (j))
#define XB_TOP      3328
#define XB_TOPGEN   3392
#define XCD_BAR_WORDS 3456
#define XB_SPIN_CAP (1u << 18)
__device__ __forceinline__ unsigned xb_ld(unsigned* p)              { return __hip_atomic_load(p, __ATOMIC_RELAXED, __HIP_MEMORY_SCOPE_AGENT); }
__device__ __forceinline__ unsigned xb_add(unsigned* p, unsigned v) { return __hip_atomic_fetch_add(p, v, __ATOMIC_RELAXED, __HIP_MEMORY_SCOPE_AGENT); }
__device__ __forceinline__ unsigned xb_xcc_id() { return (unsigned)__builtin_amdgcn_s_getreg((3 << 11) | 20) & 0xFu; }
#define XB_SPIN(cond, bar) do { unsigned _sp = 0; while (cond) { __builtin_amdgcn_s_sleep(1); \
    if ((++_sp & 255u) == 0u) { if (xb_ld(&(bar)[XB_TMO])) break; if (_sp > XB_SPIN_CAP) { atomicAdd(&(bar)[XB_TMO], 1u); break; } } } } while (0)
struct XcdBarrier { unsigned* bar; unsigned x; volatile LAS unsigned* st; };
__device__ __forceinline__ XcdBarrier xcd_barrier_post(unsigned* bar, volatile LAS unsigned* st) {
    XcdBarrier b; b.bar = bar; b.x = xb_xcc_id(); b.st = st;
    if (threadIdx.x == 0) (void)xb_add(&bar[XB_XCNT(b.x)], 1u);
    return b;
}
__device__ __forceinline__ void xcd_barrier_complete(unsigned* bar, unsigned x, unsigned& nloc, unsigned& nx) {
    const unsigned G = gridDim.x * gridDim.y * gridDim.z;
    unsigned sum, cnt, mine, sp = 0u;
    for (;;) {
        sum = 0u; cnt = 0u; mine = 0u;
#pragma unroll
        for (unsigned j = 0; j < 16; ++j) { const unsigned c = xb_ld(&bar[XB_XCNT(j)]); sum += c; cnt += (c > 0u) ? 1u : 0u; mine = (j == x) ? c : mine; }
        if (sum == G) break;
        __builtin_amdgcn_s_sleep(1);
        if ((++sp & 255u) == 0u) { if (xb_ld(&bar[XB_TMO])) break; if (sp > XB_SPIN_CAP) { atomicAdd(&bar[XB_TMO], 1u); break; } }
    }
    nloc = mine > 0u ? mine : 1u; nx = cnt > 0u ? cnt : 1u;
}
__device__ __forceinline__ void xcd_barrier(const XcdBarrier& b) {
    asm volatile("s_waitcnt vmcnt(0)" ::: "memory");
    __syncthreads();
    if (threadIdx.x == 0) {
        unsigned* bar = b.bar;
        __builtin_amdgcn_s_waitcnt(0);
        unsigned nloc = b.st[0], nx = b.st[1];
        if (nloc == 0u) { xcd_barrier_complete(bar, b.x, nloc, nx); b.st[0] = nloc; b.st[1] = nx; }
        const unsigned old = xb_add(&bar[XB_XSUB(b.x)], 1u);
        const unsigned gen = old / nloc;
        if (old + 1u == (gen + 1u) * nloc) {
            __builtin_amdgcn_fence(__ATOMIC_RELEASE, "agent");
            asm volatile("s_waitcnt vmcnt(0)" ::: "memory");
            const unsigned og = xb_add(&bar[XB_TOP], 1u);
            const unsigned tg = og / nx;
            if (og + 1u == (tg + 1u) * nx) xb_add(&bar[XB_TOPGEN], 1u);
            else XB_SPIN(xb_ld(&bar[XB_TOPGEN]) == tg, bar);
            __builtin_amdgcn_fence(__ATOMIC_ACQUIRE, "agent");
            xb_add(&bar[XB_XGEN(b.x)], 1u);
            asm volatile("s_waitcnt vmcnt(0)" ::: "memory");
        } else {
            XB_SPIN(xb_ld(&bar[XB_XGEN(b.x)]) == gen, bar);
            __builtin_amdgcn_fence(__ATOMIC_ACQUIRE, "agent");
            asm volatile("s_waitcnt vmcnt(0)" ::: "memory");
        }
    }
    __syncthreads();
}

struct Args { const void* in[23]; float* out; unsigned char* ws; };
struct Frame {
    LAS unsigned char* lds;
    volatile LAS unsigned* MISC;
    gu32* ctl;
    int tid, lane, wave, vcu, G;
    unsigned char* ws;
    __device__ __forceinline__ void refresh() { lane = fresh_lane(); tid = wave * 64 + lane; }
};

__device__ __forceinline__ int srcmap(int kind, int r) {
    if (kind == 0) { if (r < 256) return 384 + r; if (r < 640) return r - 256; if (r < 672) { const int j = r - 640; return 640 + (j & 1) * 16 + (j >> 1); } if (r < 768) return -1; return r - 96; }
    if (kind == 1) { const int h = r / 96, d = r - h * 96; if (d < 64) return r; const int j = d - 64; return h * 96 + 64 + (j & 1) * 16 + (j >> 1); }
    if (kind == 3) { const int pn = r >> 8, j = r & 255; return j < 128 ? pn * 128 + j : 1024 + pn * 128 + (j - 128); }
    return r;
}
__device__ __forceinline__ void transpose_item(const float* W, int Nsrc, int Kd, bf16_t* WT, int kind, const float* kscale, int ndest, LAS float* scr, int item, int lane) {
    const int nblk = ndest >> 6, kb = item / nblk, nb = item - kb * nblk, k0 = 64 * kb, r0 = 64 * nb;
    const int n4 = lane & 15, kq = lane >> 4;
    const int s0 = srcmap(kind, r0 + 4 * n4), s1 = srcmap(kind, r0 + 4 * n4 + 1), s2 = srcmap(kind, r0 + 4 * n4 + 2), s3 = srcmap(kind, r0 + 4 * n4 + 3);
    const bool fast = (s0 >= 0) && ((s0 & 3) == 0) && (s1 == s0 + 1) && (s2 == s0 + 2) && (s3 == s0 + 3);
    if (fast) {
        f32x4 v[16];
#pragma unroll
        for (int i = 0; i < 16; ++i) v[i] = *(const GAS f32x4*)(W + (size_t)(k0 + kq + 4 * i) * Nsrc + s0);
#pragma unroll
        for (int i = 0; i < 16; ++i) { const int kk = kq + 4 * i; const float sc = kscale ? kscale[k0 + kk] : 1.f; LAS float* d = scr + kk * 65 + 4 * n4;
            d[0] = v[i].x * sc; d[1] = v[i].y * sc; d[2] = v[i].z * sc; d[3] = v[i].w * sc; }
    } else {
        for (int i = 0; i < 16; ++i) { const int kk = kq + 4 * i; const float sc = kscale ? kscale[k0 + kk] : 1.f; const float* wr_ = W + (size_t)(k0 + kk) * Nsrc; LAS float* d = scr + kk * 65 + 4 * n4;
            d[0] = s0 >= 0 ? wr_[s0] * sc : 0.f; d[1] = s1 >= 0 ? wr_[s1] * sc : 0.f; d[2] = s2 >= 0 ? wr_[s2] * sc : 0.f; d[3] = s3 >= 0 ? wr_[s3] * sc : 0.f; }
    }
    LDS_WAIT(); asm volatile("" ::: "memory");
    const int c = lane & 7;
#pragma unroll
    for (int j = 0; j < 8; ++j) { const int n = (lane >> 3) + 8 * j; const LAS float* s = scr + (8 * c) * 65 + n;
        u32x4 o; o.x = pk2(s[0 * 65], s[1 * 65]); o.y = pk2(s[2 * 65], s[3 * 65]); o.z = pk2(s[4 * 65], s[5 * 65]); o.w = pk2(s[6 * 65], s[7 * 65]);
        *(GAS u32x4*)(WT + (size_t)(r0 + n) * Kd + k0 + 8 * c) = o; }
    LDS_WAIT(); asm volatile("" ::: "memory");
}
__device__ __forceinline__ void ln_row_to_bf16(const float* xrow, const float* g, const float* b, bf16_t* orow, int lane, float eps) {
    const GAS f32x4* xr = (const GAS f32x4*)xrow + lane;
    f32x4 v[4]; float s = 0.f;
#pragma unroll
    for (int j = 0; j < 4; ++j) { v[j] = xr[64 * j]; s += (v[j].x + v[j].y) + (v[j].z + v[j].w); }
    const float mean = wave_sum(s) * (1.f / D); float s2 = 0.f;
#pragma unroll
    for (int j = 0; j < 4; ++j) { v[j] = v[j] - mean; s2 += (v[j].x * v[j].x + v[j].y * v[j].y) + (v[j].z * v[j].z + v[j].w * v[j].w); }
    const float rstd = 1.f / sqrtf(wave_sum(s2) * (1.f / D) + eps);
    GAS unsigned long long* o8 = (GAS unsigned long long*)orow + lane;
#pragma unroll
    for (int j = 0; j < 4; ++j) { const f32x4 gg = *((const GAS f32x4*)g + lane + 64 * j), bb = *((const GAS f32x4*)b + lane + 64 * j);
        const f32x4 o = v[j] * rstd * gg + bb;
        o8[64 * j] = (unsigned long long)pk2(o.x, o.y) | ((unsigned long long)pk2(o.z, o.w) << 32); }
}
__device__ __forceinline__ void p0_prologue(Frame& F, const Args& a) {
    F.refresh();
    LAS float* scr = (LAS float*)(F.lds + F.wave * 16640);
    const int gw = F.vcu * 8 + F.wave, NGW = F.G * 8;
    const float* w_in = (const float*)a.in[4]; const float* qg = (const float*)a.in[5]; const float* w_qb = (const float*)a.in[6];
    const float* kvg = (const float*)a.in[7]; const float* w_kvb = (const float*)a.in[8]; const float* w_o = (const float*)a.in[12];
    const float* w_up = (const float*)a.in[17]; const float* w_dn = (const float*)a.in[19];
    bf16_t* WinT = (bf16_t*)(F.ws + WS_WIN); bf16_t* WqbT = (bf16_t*)(F.ws + WS_WQB); bf16_t* WkvbT = (bf16_t*)(F.ws + WS_WKVB); bf16_t* WoT = (bf16_t*)(F.ws + WS_WO);
    bf16_t* WupT = (bf16_t*)(F.ws + WS_WUP); bf16_t* WdnT = (bf16_t*)(F.ws + WS_WDN);
    constexpr int I_IN = 16 * 44, I_QB = 6 * 12, I_KVB = 4 * 16, I_O = 16 * 16, I_UP1 = 16 * 32, I_DN1 = 16 * 16;
#if DBG_STAGE == 1
    constexpr int NITEMS = I_IN + I_QB + I_KVB + I_O;
#else
    constexpr int NITEMS = I_IN + I_QB + I_KVB + I_O + NE * I_UP1 + NE * I_DN1;
#endif
    for (int it = gw; it < NITEMS; it += NGW) {
        int r = it;
        if (r < I_IN) { transpose_item(w_in, IN_COLS, D, WinT, 0, nullptr, NPROJ, scr, r, F.lane); continue; } r -= I_IN;
        if (r < I_QB) { transpose_item(w_qb, 768, QL, WqbT, 1, qg, 768, scr, r, F.lane); continue; } r -= I_QB;
        if (r < I_KVB) { transpose_item(w_kvb, 1024, KVL, WkvbT, 2, kvg, 1024, scr, r, F.lane); continue; } r -= I_KVB;
        if (r < I_O) { transpose_item(w_o, 1024, 1024, WoT, 2, nullptr, 1024, scr, r, F.lane); continue; } r -= I_O;
        if (r < NE * I_UP1) { const int e = r / I_UP1; transpose_item(w_up + (size_t)e * D * 2048, 2048, D, WupT + (size_t)e * 2048 * D, 3, nullptr, 2048, scr, r - e * I_UP1, F.lane); continue; } r -= NE * I_UP1;
        { const int e = r / I_DN1; transpose_item(w_dn + (size_t)e * DE * D, D, DE, WdnT + (size_t)e * D * DE, 2, nullptr, D, scr, r - e * I_DN1, F.lane); }
    }
    const float* x = (const float*)a.in[0]; const float* g = (const float*)a.in[2]; const float* b = (const float*)a.in[3];
    bf16_t* H0 = (bf16_t*)(F.ws + WS_H0);
    for (int m = gw; m < T; m += NGW) ln_row_to_bf16(x + (size_t)m * D, g, b, H0 + (size_t)m * D, F.lane, LN_EPS);
    const int* pos = (const int*)a.in[1]; float* cs = (float*)(F.ws + WS_COS); float* sn = (float*)(F.ws + WS_SIN);
    for (int i = F.vcu * 512 + F.tid; i < T * 16; i += F.G * 512) {
        const int t = i >> 4, j = i & 15;
        const float inv = powf(10000.0f, -(float)(2 * j) / 32.0f);
        const float ang = (float)pos[t] * inv;
        double rev = (double)ang * 0.15915494309189535; rev -= floor(rev);
        const float rf = (float)rev;
        cs[i] = __builtin_amdgcn_cosf(rf); sn[i] = __builtin_amdgcn_sinf(rf);
    }
    if (F.vcu == 0) { const float* lbl = (const float*)a.in[9]; float* lb = (float*)(F.ws + WS_LB);
        for (int c = F.tid; c < 512; c += 512) lb[c] = 1.f / (1.f + expf(lbl[512 + c] - lbl[c])); }
}

struct EpiProj {
    static constexpr bool PERM = true;
    bf16_t* P; const float* cs; const float* sn; const float* lb;
    __device__ __forceinline__ void operator()(const f32x4 (&acc)[2][2][4][2], const pg8::Unit& u, int wr, int wc, int fr, int fq) const {
#pragma unroll
        for (int bj = 0; bj < 2; ++bj) {
            const int cb = u.pn * 256 + bj * 128 + wc * 32, c0 = cb + 8 * fq;
            const int kind = cb < PC_KR ? 0 : cb == PC_KR ? 1 : cb < PC_HQ ? 0 : cb < PC_HF ? 2 : cb < PC_HI ? 3 : cb < PC_HG ? 0 : 2;
            float lbv[8];
            if (kind == 3) {
#pragma unroll
                for (int j = 0; j < 8; ++j) lbv[j] = lb[c0 - PC_HF + j];
            }
#pragma unroll
            for (int ai = 0; ai < 2; ++ai)
#pragma unroll
                for (int m = 0; m < 4; ++m) {
                    const int row = u.pm * 256 + ai * 128 + wr * 64 + m * 16 + fr;
                    float v[8];
#pragma unroll
                    for (int j = 0; j < 4; ++j) { v[j] = acc[ai][bj][m][0][j]; v[4 + j] = acc[ai][bj][m][1][j]; }
                    if (kind == 1) {
                        const f32x4 cc = *(const f32x4*)(cs + (size_t)row * 16 + 4 * fq), ss = *(const f32x4*)(sn + (size_t)row * 16 + 4 * fq);
#pragma unroll
                        for (int p = 0; p < 4; ++p) { const float x1 = v[2 * p], x2 = v[2 * p + 1]; v[2 * p] = x1 * cc[p] - x2 * ss[p]; v[2 * p + 1] = x1 * ss[p] + x2 * cc[p]; }
                    } else if (kind == 2) {
#pragma unroll
                        for (int j = 0; j < 8; ++j) v[j] = silu_f(v[j]);
                    } else if (kind == 3) {
#pragma unroll
                        for (int j = 0; j < 8; ++j) { const float s = __builtin_amdgcn_rcpf(1.f + __expf(-v[j])); v[j] = __logf(lbv[j] + (1.f - lbv[j]) * s); }
                    }
                    u32x4 w; w.x = pk2(v[0], v[1]); w.y = pk2(v[2], v[3]); w.z = pk2(v[4], v[5]); w.w = pk2(v[6], v[7]);
                    *(u32x4*)(P + (size_t)row * NPROJ + c0) = w;
                }
        }
    }
};

constexpr float QSCALE = 0.10206207261596577f * 1.4426950408889634f;
__device__ __forceinline__ void rs_table(const bf16_t* P, int pm, int c0, int ncols, LAS float* tab, int tid) {
    const int r = tid >> 1, half = tid & 1, nh = ncols >> 1;
    const bf16_t* p = P + (size_t)(pm * 256 + r) * NPROJ + c0 + half * nh;
    float s = 0.f;
    for (int k = 0; k < nh; k += 8) { const u32x4 w = *(const GAS u32x4*)(p + k);
#pragma unroll
        for (int j = 0; j < 4; ++j) { const float a = __builtin_bit_cast(float, w[j] << 16), b = __builtin_bit_cast(float, w[j] & 0xffff0000u); s += a * a + b * b; } }
    s += __shfl_xor(s, 1);
    if (half == 0) tab[r] = 1.f / sqrtf(s / (float)ncols + RMS_EPS);
}
struct EpiQ {
    static constexpr bool PERM = true;
    bf16_t* Q; const float* cs; const float* sn; const LAS float* rs;
    __device__ __forceinline__ void operator()(const f32x4 (&acc)[2][2][4][2], const pg8::Unit& u, int wr, int wc, int fr, int fq) const {
#pragma unroll
        for (int bj = 0; bj < 2; ++bj) {
            const int c0 = u.pn * 256 + bj * 128 + wc * 32 + 8 * fq;
            const int hh = c0 / 96, d0 = c0 - hh * 96;
#pragma unroll
            for (int ai = 0; ai < 2; ++ai)
#pragma unroll
                for (int m = 0; m < 4; ++m) {
                    const int rl = ai * 128 + wr * 64 + m * 16 + fr, row = u.pm * 256 + rl;
                    const float sc = rs[rl] * QSCALE;
                    float v[8];
#pragma unroll
                    for (int j = 0; j < 4; ++j) { v[j] = acc[ai][bj][m][0][j] * sc; v[4 + j] = acc[ai][bj][m][1][j] * sc; }
                    if (d0 >= 64) {
                        const int i0 = (d0 - 64) >> 1;
                        const f32x4 cc = *(const f32x4*)(cs + (size_t)row * 16 + i0), ss = *(const f32x4*)(sn + (size_t)row * 16 + i0);
#pragma unroll
                        for (int p = 0; p < 4; ++p) { const float x1 = v[2 * p], x2 = v[2 * p + 1]; v[2 * p] = x1 * cc[p] - x2 * ss[p]; v[2 * p + 1] = x1 * ss[p] + x2 * cc[p]; }
                    }
                    u32x4 w; w.x = pk2(v[0], v[1]); w.y = pk2(v[2], v[3]); w.z = pk2(v[4], v[5]); w.w = pk2(v[6], v[7]);
                    *(u32x4*)(Q + (size_t)row * 768 + c0) = w;
                }
        }
    }
};
struct EpiKV {
    static constexpr bool PERM = true;
    bf16_t* KV; const LAS float* rs;
    __device__ __forceinline__ void operator()(const f32x4 (&acc)[2][2][4][2], const pg8::Unit& u, int wr, int wc, int fr, int fq) const {
#pragma unroll
        for (int bj = 0; bj < 2; ++bj) {
            const int c0 = u.pn * 256 + bj * 128 + wc * 32 + 8 * fq;
#pragma unroll
            for (int ai = 0; ai < 2; ++ai)
#pragma unroll
                for (int m = 0; m < 4; ++m) {
                    const int rl = ai * 128 + wr * 64 + m * 16 + fr, row = u.pm * 256 + rl;
                    const float sc = rs[rl];
                    u32x4 w; w.x = pk2(acc[ai][bj][m][0][0] * sc, acc[ai][bj][m][0][1] * sc); w.y = pk2(acc[ai][bj][m][0][2] * sc, acc[ai][bj][m][0][3] * sc);
                    w.z = pk2(acc[ai][bj][m][1][0] * sc, acc[ai][bj][m][1][1] * sc); w.w = pk2(acc[ai][bj][m][1][2] * sc, acc[ai][bj][m][1][3] * sc);
                    *(u32x4*)(KV + (size_t)row * 1024 + c0) = w;
                }
        }
    }
};

namespace att {
typedef float f32x16 __attribute__((ext_vector_type(16)));
typedef short s16x4 __attribute__((ext_vector_type(4)));
constexpr int KSLOT = 12288, VSLOT = 8192, BUFB = KSLOT + VSLOT;
constexpr int LDS_WS = 2 * BUFB, LDS_OST = LDS_WS + 2048, LDS_END = LDS_OST + 8 * 4096;
__device__ __forceinline__ int crow(int r, int hi) { return (r & 3) + 8 * (r >> 2) + 4 * hi; }
__device__ __forceinline__ unsigned cvtpk(float lo, float hi) { unsigned r; asm volatile("v_cvt_pk_bf16_f32 %0, %1, %2" : "=v"(r) : "v"(lo), "v"(hi)); return r; }
__device__ __forceinline__ void pv(f32x16* o, int vb, bf16x8 pa0, bf16x8 pa1, bf16x8 pa2, bf16x8 pa3) {
#pragma unroll
    for (int d0 = 0; d0 < 2; ++d0) { s16x4 lo[4], hi[4];
        asm volatile("ds_read_b64_tr_b16 %0,%8 offset:%c9\n\tds_read_b64_tr_b16 %1,%8 offset:%c10\n\tds_read_b64_tr_b16 %2,%8 offset:%c11\n\tds_read_b64_tr_b16 %3,%8 offset:%c12\n\t"
                     "ds_read_b64_tr_b16 %4,%8 offset:%c13\n\tds_read_b64_tr_b16 %5,%8 offset:%c14\n\tds_read_b64_tr_b16 %6,%8 offset:%c15\n\tds_read_b64_tr_b16 %7,%8 offset:%c16\n\ts_waitcnt lgkmcnt(0)"
                     : "=&v"(lo[0]), "=&v"(hi[0]), "=&v"(lo[1]), "=&v"(hi[1]), "=&v"(lo[2]), "=&v"(hi[2]), "=&v"(lo[3]), "=&v"(hi[3])
                     : "v"(vb), "i"(d0 * 4096), "i"(d0 * 4096 + 512), "i"(d0 * 4096 + 1024), "i"(d0 * 4096 + 1536), "i"(d0 * 4096 + 2048), "i"(d0 * 4096 + 2560), "i"(d0 * 4096 + 3072), "i"(d0 * 4096 + 3584) : "memory");
#define PK(k) (bf16x8){lo[k][0], lo[k][1], lo[k][2], lo[k][3], hi[k][0], hi[k][1], hi[k][2], hi[k][3]}
        o[d0] = __builtin_amdgcn_mfma_f32_32x32x16_bf16(pa0, PK(0), o[d0], 0, 0, 0);
        o[d0] = __builtin_amdgcn_mfma_f32_32x32x16_bf16(pa1, PK(1), o[d0], 0, 0, 0);
        o[d0] = __builtin_amdgcn_mfma_f32_32x32x16_bf16(pa2, PK(2), o[d0], 0, 0, 0);
        o[d0] = __builtin_amdgcn_mfma_f32_32x32x16_bf16(pa3, PK(3), o[d0], 0, 0, 0);
#undef PK
    }
}
__device__ __forceinline__ void unit(int b, int h, int qb, const bf16_t* Q, const bf16_t* KV, const bf16_t* PROJ, bf16_t* MIX, float* SSQ, LAS unsigned char* lds, const int wid) {
    const int lane = fresh_lane(), r32 = lane & 31, hi = lane >> 5;
    const size_t rowbase = (size_t)b * SEQ; const int q0 = qb * 256;
    const bf16_t* Qw = Q + (rowbase + q0 + wid * 32) * 768 + h * 96;
    bf16x8 qr[6];
#pragma unroll
    for (int d0 = 0; d0 < 6; ++d0) qr[d0] = *(const GAS bf16x8*)(Qw + (size_t)r32 * 768 + d0 * 16 + hi * 8);
    const int cw = (q0 + 32 * wid) >> 6, NT = 4 * qb + 4;
    LAS float* wsf = (LAS float*)(lds + LDS_WS) + wid * 64;
    const bf16_t* ksrc = KV + (rowbase + lane) * 1024 + h * 128 + wid * 8;
    const bf16_t* rsrc = PROJ + (rowbase + lane) * NPROJ + PC_KR + (wid & 3) * 8;
    const bf16_t* vsrc = KV + (rowbase + 16 * (wid & 3) + (lane >> 2)) * 1024 + h * 128 + 64 + (wid >> 2) * 32 + (lane & 3) * 8;
#define ATT_DMA(t, buf) do { \
        __builtin_amdgcn_global_load_lds((const unsigned*)(ksrc + (size_t)(t) * 64 * 1024), (LAS unsigned*)(lds + (buf) * BUFB + wid * 1024), 16, 0, 0); \
        if (wid < 4) __builtin_amdgcn_global_load_lds((const unsigned*)(rsrc + (size_t)(t) * 64 * NPROJ), (LAS unsigned*)(lds + (buf) * BUFB + (8 + wid) * 1024), 16, 0, 0); \
        __builtin_amdgcn_global_load_lds((const unsigned*)(vsrc + (size_t)(t) * 64 * 1024), (LAS unsigned*)(lds + (buf) * BUFB + KSLOT + wid * 1024), 16, 0, 0); } while (0)
    float m_run = -INFINITY, l_run = 0.f; f32x16 o[2]; o[0] = f32x16{}; o[1] = f32x16{};
    const int vb0 = (int)(unsigned)(size_t)(lds + KSLOT) + ((lane >> 4) & 1) * 32 + (lane & 3) * 8 + (4 * hi + ((lane & 15) >> 2)) * 64;
    asm volatile("s_waitcnt vmcnt(0)" ::: "memory");
    ATT_DMA(0, 0);
    for (int t = 0; t < NT; ++t) {
        const int buf = t & 1;
        if (t + 1 < NT) { ATT_DMA(t + 1, buf ^ 1); if (wid < 4) asm volatile("s_waitcnt vmcnt(3)" ::: "memory"); else asm volatile("s_waitcnt vmcnt(2)" ::: "memory"); }
        else asm volatile("s_waitcnt vmcnt(0)" ::: "memory");
        __builtin_amdgcn_s_barrier(); asm volatile("" ::: "memory");
        if (t <= cw) {
            f32x16 p0 = f32x16{}, p1 = f32x16{};
            const LAS unsigned char* kb = lds + buf * BUFB + hi * 1024 + r32 * 16;
#pragma unroll
            for (int d0 = 0; d0 < 6; ++d0) {
                const bf16x8 b0 = *(const LAS bf16x8*)(kb + d0 * 2048), b1 = *(const LAS bf16x8*)(kb + d0 * 2048 + 512);
                p0 = __builtin_amdgcn_mfma_f32_32x32x16_bf16(b0, qr[d0], p0, 0, 0, 0); p1 = __builtin_amdgcn_mfma_f32_32x32x16_bf16(b1, qr[d0], p1, 0, 0, 0); }
            float rm = p0[0];
#pragma unroll
            for (int r = 1; r < 16; ++r) rm = fmaxf(rm, p0[r]);
#pragma unroll
            for (int r = 0; r < 16; ++r) rm = fmaxf(rm, p1[r]);
            { auto rr = __builtin_amdgcn_permlane32_swap(__float_as_uint(rm), __float_as_uint(rm), false, false); rm = fmaxf(__uint_as_float(rr[0]), __uint_as_float(rr[1])); }
            const float m_new = fmaxf(m_run, rm), sc = __builtin_amdgcn_exp2f(m_run - m_new); m_run = m_new;
            float ls = 0.f;
#pragma unroll
            for (int r = 0; r < 16; ++r) { p0[r] = __builtin_amdgcn_exp2f(p0[r] - m_new); p1[r] = __builtin_amdgcn_exp2f(p1[r] - m_new); ls += p0[r] + p1[r]; }
            l_run = l_run * sc + ls;
            if (hi == 0) wsf[r32] = sc;
            asm volatile("s_waitcnt lgkmcnt(0)" ::: "memory");
#pragma unroll
            for (int r = 0; r < 16; ++r) { const float f = wsf[crow(r, hi)]; o[0][r] *= f; o[1][r] *= f; }
            u32x4 pw0, pw1, pw2, pw3;
            pw0 = (u32x4){cvtpk(p0[0], p0[1]), cvtpk(p0[2], p0[3]), cvtpk(p0[4], p0[5]), cvtpk(p0[6], p0[7])};
            pw1 = (u32x4){cvtpk(p0[8], p0[9]), cvtpk(p0[10], p0[11]), cvtpk(p0[12], p0[13]), cvtpk(p0[14], p0[15])};
            pw2 = (u32x4){cvtpk(p1[0], p1[1]), cvtpk(p1[2], p1[3]), cvtpk(p1[4], p1[5]), cvtpk(p1[6], p1[7])};
            pw3 = (u32x4){cvtpk(p1[8], p1[9]), cvtpk(p1[10], p1[11]), cvtpk(p1[12], p1[13]), cvtpk(p1[14], p1[15])};
            pv(o, vb0 + buf * BUFB, __builtin_bit_cast(bf16x8, pw0), __builtin_bit_cast(bf16x8, pw1), __builtin_bit_cast(bf16x8, pw2), __builtin_bit_cast(bf16x8, pw3));
        }
        asm volatile("s_waitcnt lgkmcnt(0)" ::: "memory"); __builtin_amdgcn_s_barrier(); asm volatile("" ::: "memory");
    }
#undef ATT_DMA
    { auto rr = __builtin_amdgcn_permlane32_swap(__float_as_uint(l_run), __float_as_uint(l_run), false, false); l_run = __uint_as_float(rr[0]) + __uint_as_float(rr[1]); }
    if (hi == 0) wsf[32 + r32] = l_run;
    asm volatile("s_waitcnt lgkmcnt(0)" ::: "memory");
    LAS bf16_t* stg = (LAS bf16_t*)(lds + LDS_OST) + wid * 2048;
#pragma unroll
    for (int r = 0; r < 16; ++r) { const int orow = crow(r, hi); const float rl = __builtin_amdgcn_rcpf(wsf[32 + orow]);
        stg[orow * 64 + r32] = (bf16_t)f2bf(o[0][r] * rl); stg[orow * 64 + 32 + r32] = (bf16_t)f2bf(o[1][r] * rl); }
    asm volatile("s_waitcnt lgkmcnt(0)" ::: "memory");
    bf16_t* Ow = MIX + (rowbase + q0 + wid * 32) * 1024 + h * 64;
#pragma unroll
    for (int i = 0; i < 4; ++i) { const int row = i * 8 + (lane >> 3), ch = lane & 7; const u32x4 v = *(const LAS u32x4*)(stg + row * 64 + ch * 8);
        *(GAS u32x4*)(Ow + (size_t)row * 1024 + ch * 8) = v;
        float s = 0.f;
#pragma unroll
        for (int j = 0; j < 4; ++j) { const float a = __builtin_bit_cast(float, v[j] << 16), bb = __builtin_bit_cast(float, v[j] & 0xffff0000u); s += a * a + bb * bb; }
        s += __shfl_xor(s, 1); s += __shfl_xor(s, 2); s += __shfl_xor(s, 4);
        if (ch == 0) SSQ[(rowbase + q0 + wid * 32 + row) * 8 + h] = s; }
    asm volatile("s_waitcnt lgkmcnt(0)" ::: "memory"); __builtin_amdgcn_s_barrier(); asm volatile("" ::: "memory");
}
}

__device__ __forceinline__ void attn_normalise(Frame& F, const float* g) {
    F.refresh();
    bf16_t* MIX = (bf16_t*)(F.ws + WS_MIX); const float* SSQ = (const float*)(F.ws + WS_SSQ);
    const int gw = F.vcu * 8 + F.wave, NGW = F.G * 8;
    f32x4 g0 = *((const GAS f32x4*)g + 2 * F.lane), g1 = *((const GAS f32x4*)g + 2 * F.lane + 1);
    for (int m = gw; m < T; m += NGW) {
        const f32x4 s0 = *(const GAS f32x4*)(SSQ + (size_t)m * 8), s1 = *(const GAS f32x4*)(SSQ + (size_t)m * 8 + 4);
        const float tot = ((s0.x + s0.y) + (s0.z + s0.w)) + ((s1.x + s1.y) + (s1.z + s1.w));
        const float rs = 1.f / sqrtf(tot * (1.f / 512.f) + RMS_EPS);
        GAS u32x4* p = (GAS u32x4*)(MIX + (size_t)m * 1024) + F.lane;
        const u32x4 v = *p; u32x4 w;
        w.x = pk2(__builtin_bit_cast(float, v.x << 16) * rs * g0.x, __builtin_bit_cast(float, v.x & 0xffff0000u) * rs * g0.y);
        w.y = pk2(__builtin_bit_cast(float, v.y << 16) * rs * g0.z, __builtin_bit_cast(float, v.y & 0xffff0000u) * rs * g0.w);
        w.z = pk2(__builtin_bit_cast(float, v.z << 16) * rs * g1.x, __builtin_bit_cast(float, v.z & 0xffff0000u) * rs * g1.y);
        w.w = pk2(__builtin_bit_cast(float, v.w << 16) * rs * g1.z, __builtin_bit_cast(float, v.w & 0xffff0000u) * rs * g1.w);
        *p = w;
    }
}

namespace hg {
typedef float f32x16 __attribute__((ext_vector_type(16)));
typedef short s16x4 __attribute__((ext_vector_type(4)));
constexpr int OFF_QDEC = 0, OFF_QD1 = 16384, OFF_KD0 = 24576, OFF_KD1 = 32768, OFF_V = 49152, OFF_S = 65536, OFF_O = 98304, OFF_TOT = 132096;
constexpr int OPITCH = 132;
__device__ __forceinline__ int crow(int r, int hi) { return (r & 3) + 8 * (r >> 2) + 4 * hi; }
__device__ __forceinline__ bf16x8 trfrag(int base, int off) {
    s16x4 lo, hi;
    asm volatile("ds_read_b64_tr_b16 %0,%2\n\tds_read_b64_tr_b16 %1,%2 offset:512\n\ts_waitcnt lgkmcnt(0)" : "=&v"(lo), "=&v"(hi) : "v"(base + off) : "memory");
    return (bf16x8){lo[0], lo[1], lo[2], lo[3], hi[0], hi[1], hi[2], hi[3]};
}
__device__ __forceinline__ void dma_tl(const bf16_t* src, LAS unsigned char* img, int wid, int lane) {
#pragma unroll
    for (int i = 0; i < 2; ++i) { const int p = wid * 2 + i, cb = p >> 2, tg = p & 3;
        __builtin_amdgcn_global_load_lds((const unsigned*)(src + (size_t)(tg * 16 + (lane >> 2)) * NPROJ + cb * 32 + (lane & 3) * 8), (LAS unsigned*)(img + p * 1024), 16, 0, 0); }
}
__device__ __forceinline__ void cumsum16(const bf16_t* gsrc, int kcol, int seg, float (&g)[16], float (&b)[16], LAS float* tot, float& r1, float& blast) {
#pragma unroll
    for (int i = 0; i < 16; ++i) g[i] = bf2f(gsrc[(size_t)(seg * 16 + i) * NPROJ + kcol]);
    float run = 0.f;
#pragma unroll
    for (int i = 0; i < 16; ++i) { run += g[i]; b[i] = run; }
    tot[seg * 128 + kcol] = run;
    LDS_WAIT(); __syncthreads();
    const float t0 = tot[kcol], t1 = tot[128 + kcol], t2 = tot[256 + kcol], t3 = tot[384 + kcol];
    const float off = seg == 0 ? 0.f : seg == 1 ? t0 : seg == 2 ? t0 + t1 : t0 + t1 + t2;
    r1 = t0 + t1; blast = (t0 + t1) + (t2 + t3);
#pragma unroll
    for (int i = 0; i < 16; ++i) b[i] += off;
}
__device__ __forceinline__ void pass_a(int unit, const bf16_t* PROJ, float* LT, float* DEC, LAS unsigned char* lds, const int wid) {
    const int lane = fresh_lane(), tid = wid * 64 + lane, r32 = lane & 31, hi = lane >> 5;
    const int bh = unit >> 5, n = unit & 31, b_ = bh >> 2, h = bh & 3;
    const size_t tok0 = (size_t)b_ * SEQ + n * 64;
    LAS unsigned char* kimg = lds; LAS unsigned char* vimg = lds + 16384; LAS float* tot = (LAS float*)(lds + OFF_TOT);
    __syncthreads();
    dma_tl(PROJ + tok0 * NPROJ + PC_HI + h * 128, vimg, wid, lane);
    const int kcol = tid & 127, seg = tid >> 7;
    float g[16], b[16], r1, blast;
    cumsum16(PROJ + tok0 * NPROJ + PC_HF + h * 128, kcol, seg, g, b, tot, r1, blast);
#pragma unroll
    for (int i = 0; i < 16; ++i) { const float kd = (1.f - __expf(g[i])) * __expf(blast - b[i]);
        *(LAS bf16_t*)(kimg + ((kcol >> 5) * 4 + seg) * 1024 + i * 64 + (kcol & 31) * 2) = (bf16_t)f2bf(kd); }
    if (seg == 0) DEC[(size_t)unit * 128 + kcol] = __expf(blast);
    asm volatile("s_waitcnt vmcnt(0) lgkmcnt(0)" ::: "memory"); __syncthreads();
    const int lo_ = ((lane >> 4) & 1) * 32 + (lane & 3) * 8 + (4 * hi + ((lane & 15) >> 2)) * 64;
    const int vbase = (int)(unsigned)(size_t)vimg + lo_, kbase = (int)(unsigned)(size_t)kimg + lo_;
    const int vb = wid & 3;
    bf16x8 af[4];
#pragma unroll
    for (int ks = 0; ks < 4; ++ks) af[ks] = trfrag(vbase, vb * 4096 + ks * 1024);
#pragma unroll
    for (int j = 0; j < 2; ++j) { const int kb = (wid >> 2) * 2 + j; f32x16 acc = f32x16{};
#pragma unroll
        for (int ks = 0; ks < 4; ++ks) { const bf16x8 bfr = trfrag(kbase, kb * 4096 + ks * 1024); acc = __builtin_amdgcn_mfma_f32_32x32x16_bf16(af[ks], bfr, acc, 0, 0, 0); }
        float* dst = LT + (size_t)unit * 16384 + kb * 32 + r32;
#pragma unroll
        for (int r = 0; r < 16; ++r) dst[(size_t)(vb * 32 + crow(r, hi)) * 128] = acc[r]; }
}
__device__ __forceinline__ void pass_b(const float* LT, const float* DEC, bf16_t* SST, int gtid, int gthreads) {
    for (int i = gtid; i < 32 * 4096; i += gthreads) {
        const int bh = i >> 12, e4 = i & 4095, k4 = (e4 & 31) * 4;
        f32x4 S = (f32x4){0.f, 0.f, 0.f, 0.f};
#pragma unroll 4
        for (int n = 0; n < 32; ++n) { const size_t u = (size_t)bh * 32 + n;
            u32x2 w; w.x = pk2(S.x, S.y); w.y = pk2(S.z, S.w);
            *(GAS u32x2*)(SST + u * 16384 + (size_t)e4 * 4) = w;
            const f32x4 L = *(const GAS f32x4*)(LT + u * 16384 + (size_t)e4 * 4), Dv = *(const GAS f32x4*)(DEC + u * 128 + k4);
            S = Dv * S + L; }
    }
}
__device__ __forceinline__ void pass_c(int unit, const bf16_t* PROJ, const bf16_t* SST, const float* gout, bf16_t* MIX, LAS unsigned char* lds, const int wid) {
    const int lane = fresh_lane(), tid = wid * 64 + lane, r32 = lane & 31, hi = lane >> 5;
    const int bh = unit >> 5, n = unit & 31, b_ = bh >> 2, h = bh & 3;
    const size_t tok0 = (size_t)b_ * SEQ + n * 64;
    LAS float* tot = (LAS float*)(lds + OFF_TOT);
    __syncthreads();
    dma_tl(PROJ + tok0 * NPROJ + PC_HI + h * 128, lds + OFF_V, wid, lane);
    { const bf16_t* S = SST + (size_t)unit * 16384;
#pragma unroll
        for (int i = 0; i < 4; ++i) { const int p = wid * 4 + i, c = p >> 1, rh = p & 1;
            __builtin_amdgcn_global_load_lds((const unsigned*)(S + (size_t)(rh * 64 + lane) * 128 + c * 8), (LAS unsigned*)(lds + OFF_S + c * 2048 + rh * 1024), 16, 0, 0); } }
    const int kcol = tid & 127, seg = tid >> 7;
    float g[16], b[16], r1, blast;
    cumsum16(PROJ + tok0 * NPROJ + PC_HF + h * 128, kcol, seg, g, b, tot, r1, blast);
    { const bf16_t* qsrc = PROJ + tok0 * NPROJ + PC_HQ + h * 128 + kcol;
      const int cl = (kcol >> 3), ce = (kcol & 7) * 2;
#pragma unroll
      for (int i = 0; i < 16; ++i) { const int t = seg * 16 + i;
        const float q = bf2f(qsrc[(size_t)t * NPROJ]), kk = 1.f - __expf(g[i]);
        *(LAS bf16_t*)(lds + OFF_QDEC + cl * 1024 + t * 16 + ce) = (bf16_t)f2bf(q * __expf(b[i]));
        *(LAS bf16_t*)(lds + OFF_KD1 + cl * 1024 + t * 16 + ce) = (bf16_t)f2bf(kk * __expf(r1 - b[i]));
        if (seg < 2) *(LAS bf16_t*)(lds + OFF_KD0 + cl * 512 + t * 16 + ce) = (bf16_t)f2bf(kk * __expf(-b[i]));
        else *(LAS bf16_t*)(lds + OFF_QD1 + cl * 512 + (t - 32) * 16 + ce) = (bf16_t)f2bf(q * __expf(b[i] - r1)); } }
    asm volatile("s_waitcnt vmcnt(0) lgkmcnt(0)" ::: "memory"); __syncthreads();
    const int I = wid & 1, vb = wid >> 1;
    f32x16 o = f32x16{};
#pragma unroll
    for (int kk = 0; kk < 8; ++kk) {
        const bf16x8 a = *(const LAS bf16x8*)(lds + OFF_QDEC + (2 * kk + hi) * 1024 + (I * 32 + r32) * 16);
        const bf16x8 bb = *(const LAS bf16x8*)(lds + OFF_S + (2 * kk + hi) * 2048 + (vb * 32 + r32) * 16);
        o = __builtin_amdgcn_mfma_f32_32x32x16_bf16(a, bb, o, 0, 0, 0); }
    const int vbase = (int)(unsigned)(size_t)(lds + OFF_V) + ((lane >> 4) & 1) * 32 + (lane & 3) * 8 + (4 * hi + ((lane & 15) >> 2)) * 64;
    for (int J = 0; J <= I; ++J) {
        f32x16 st = f32x16{};
#pragma unroll
        for (int kk = 0; kk < 8; ++kk) {
            const bf16x8 a = (I == 0) ? *(const LAS bf16x8*)(lds + OFF_KD0 + (2 * kk + hi) * 512 + r32 * 16) : *(const LAS bf16x8*)(lds + OFF_KD1 + (2 * kk + hi) * 1024 + (J * 32 + r32) * 16);
            const bf16x8 bq = (I == 0) ? *(const LAS bf16x8*)(lds + OFF_QDEC + (2 * kk + hi) * 1024 + r32 * 16) : *(const LAS bf16x8*)(lds + OFF_QD1 + (2 * kk + hi) * 512 + r32 * 16);
            st = __builtin_amdgcn_mfma_f32_32x32x16_bf16(a, bq, st, 0, 0, 0); }
        if (J == I) {
#pragma unroll
            for (int r = 0; r < 16; ++r) if (crow(r, hi) > r32) st[r] = 0.f; }
        u32x4 pw0, pw1;
        pw0 = (u32x4){pk2(st[0], st[1]), pk2(st[2], st[3]), pk2(st[4], st[5]), pk2(st[6], st[7])};
        pw1 = (u32x4){pk2(st[8], st[9]), pk2(st[10], st[11]), pk2(st[12], st[13]), pk2(st[14], st[15])};
        const bf16x8 v0 = trfrag(vbase, vb * 4096 + (2 * J) * 1024), v1 = trfrag(vbase, vb * 4096 + (2 * J + 1) * 1024);
        o = __builtin_amdgcn_mfma_f32_32x32x16_bf16(__builtin_bit_cast(bf16x8, pw0), v0, o, 0, 0, 0);
        o = __builtin_amdgcn_mfma_f32_32x32x16_bf16(__builtin_bit_cast(bf16x8, pw1), v1, o, 0, 0, 0);
    }
    LAS float* ot = (LAS float*)(lds + OFF_O);
#pragma unroll
    for (int r = 0; r < 16; ++r) ot[(I * 32 + crow(r, hi)) * OPITCH + vb * 32 + r32] = o[r];
    LDS_WAIT(); __syncthreads();
#pragma unroll
    for (int it = 0; it < 2; ++it) { const int task = it * 512 + tid, t = task >> 4, c8 = (task & 15) * 8;
        const f32x4 x0 = *(const LAS f32x4*)(ot + t * OPITCH + c8), x1 = *(const LAS f32x4*)(ot + t * OPITCH + c8 + 4);
        float s = (x0.x * x0.x + x0.y * x0.y) + (x0.z * x0.z + x0.w * x0.w) + (x1.x * x1.x + x1.y * x1.y) + (x1.z * x1.z + x1.w * x1.w);
        s += __shfl_xor(s, 1); s += __shfl_xor(s, 2); s += __shfl_xor(s, 4); s += __shfl_xor(s, 8);
        const float rs = 1.f / sqrtf(s * (1.f / 128.f) + RMS_EPS);
        const f32x4 g0 = *(const GAS f32x4*)(gout + h * 128 + c8), g1 = *(const GAS f32x4*)(gout + h * 128 + c8 + 4);
        const u32x4 gt = *(const GAS u32x4*)(PROJ + (tok0 + t) * NPROJ + PC_HG + h * 128 + c8);
        u32x4 w;
        w.x = pk2(x0.x * rs * g0.x * __builtin_bit_cast(float, gt.x << 16), x0.y * rs * g0.y * __builtin_bit_cast(float, gt.x & 0xffff0000u));
        w.y = pk2(x0.z * rs * g0.z * __builtin_bit_cast(float, gt.y << 16), x0.w * rs * g0.w * __builtin_bit_cast(float, gt.y & 0xffff0000u));
        w.z = pk2(x1.x * rs * g1.x * __builtin_bit_cast(float, gt.z << 16), x1.y * rs * g1.y * __builtin_bit_cast(float, gt.z & 0xffff0000u));
        w.w = pk2(x1.z * rs * g1.z * __builtin_bit_cast(float, gt.w << 16), x1.w * rs * g1.w * __builtin_bit_cast(float, gt.w & 0xffff0000u));
        *(GAS u32x4*)(MIX + (tok0 + t) * 1024 + 512 + h * 128 + c8) = w; }
}
}

struct EpiY {
    static constexpr bool PERM = false;
    float* Y; const bf16_t* H0;
    __device__ __forceinline__ void operator()(const f32x4 (&acc)[2][2][4][2], const pg8::Unit& u, int wr, int wc, int fr, int fq) const {
#pragma unroll
        for (int ai = 0; ai < 2; ++ai)
#pragma unroll
            for (int m = 0; m < 4; ++m) { const size_t row = (size_t)u.pm * 256 + ai * 128 + wr * 64 + m * 16 + fr;
#pragma unroll
                for (int bj = 0; bj < 2; ++bj)
#pragma unroll
                    for (int n = 0; n < 2; ++n) { const int c = u.pn * 256 + bj * 128 + wc * 32 + 16 * n + 4 * fq;
                        const u32x2 hv = *(const u32x2*)(H0 + row * 1024 + c);
                        f32x4 o = acc[ai][bj][m][n];
                        o.x += DN_ALPHA * __builtin_bit_cast(float, hv.x << 16); o.y += DN_ALPHA * __builtin_bit_cast(float, hv.x & 0xffff0000u);
                        o.z += DN_ALPHA * __builtin_bit_cast(float, hv.y << 16); o.w += DN_ALPHA * __builtin_bit_cast(float, hv.y & 0xffff0000u);
                        *(f32x4*)(Y + row * 1024 + c) = o; } }
    }
};

__device__ __forceinline__ void p6_router(Frame& F, const Args& a) {
    F.refresh();
    const float* Y = (const float*)(F.ws + WS_Y); bf16_t* H1 = (bf16_t*)(F.ws + WS_H1);
    const float* g = (const float*)a.in[13]; const float* bta = (const float*)a.in[14]; const float* wr_ = (const float*)a.in[15]; const float* br = (const float*)a.in[16];
    LAS float* hrow = (LAS float*)(F.lds + F.wave * 16384);
    LAS unsigned* cnt = (LAS unsigned*)(F.lds + XTRA_OFF); LAS unsigned* base = cnt + 32;
    LAS int* asg_e = (LAS int*)(cnt + 64); LAS int* asg_r = asg_e + 256; LAS float* asg_g = (LAS float*)(asg_r + 256);
    if (F.tid < 32) cnt[F.tid] = 0u;
    __syncthreads();
    const int e = F.lane & 31, kh = F.lane >> 5;
    for (int p = 0; p < 2; ++p) {
#pragma unroll
        for (int r = 0; r < 4; ++r) {
            const size_t row = (size_t)F.vcu * 64 + F.wave * 8 + p * 4 + r;
            const GAS f32x4* yr = (const GAS f32x4*)(Y + row * 1024) + F.lane;
            f32x4 v[4]; float s = 0.f;
#pragma unroll
            for (int j = 0; j < 4; ++j) { v[j] = yr[64 * j]; s += (v[j].x + v[j].y) + (v[j].z + v[j].w); }
            const float mean = wave_sum(s) * (1.f / D); float s2 = 0.f;
#pragma unroll
            for (int j = 0; j < 4; ++j) { v[j] = v[j] - mean; s2 += (v[j].x * v[j].x + v[j].y * v[j].y) + (v[j].z * v[j].z + v[j].w * v[j].w); }
            const float rstd = 1.f / sqrtf(wave_sum(s2) * (1.f / D) + LN_EPS);
            GAS unsigned long long* o8 = (GAS unsigned long long*)(H1 + row * 1024) + F.lane;
#pragma unroll
            for (int j = 0; j < 4; ++j) { const f32x4 gg = *((const GAS f32x4*)g + F.lane + 64 * j), bb = *((const GAS f32x4*)bta + F.lane + 64 * j);
                const f32x4 o = v[j] * rstd * gg + bb;
                o8[64 * j] = (unsigned long long)pk2(o.x, o.y) | ((unsigned long long)pk2(o.z, o.w) << 32);
                *(LAS f32x4*)(hrow + r * 1024 + 4 * (F.lane + 64 * j)) = o; }
        }
        LDS_WAIT(); asm volatile("" ::: "memory");
        float acc[4] = {0.f, 0.f, 0.f, 0.f};
        const float* wp = wr_ + (size_t)kh * 512 * 32 + e; const LAS float* hp = hrow + kh * 512;
#pragma unroll 8
        for (int k = 0; k < 512; ++k) { const float w = wp[(size_t)k * 32];
#pragma unroll
            for (int r = 0; r < 4; ++r) acc[r] += w * hp[r * 1024 + k]; }
        const float be = br[e];
#pragma unroll
        for (int r = 0; r < 4; ++r) {
            float val = acc[r] + __shfl_xor(acc[r], 32) + be;
            int se[4]; float sl[4];
#pragma unroll
            for (int k = 0; k < 4; ++k) { float bv = val; int bi = e;
#pragma unroll
                for (int o = 1; o < 32; o <<= 1) { const float ov = __shfl_xor(bv, o); const int oi = __shfl_xor(bi, o); if (ov > bv || (ov == bv && oi < bi)) { bv = ov; bi = oi; } }
                se[k] = bi; sl[k] = bv; if (e == bi) val = -INFINITY; }
            const float e1 = __expf(sl[1] - sl[0]), e2 = __expf(sl[2] - sl[0]), e3 = __expf(sl[3] - sl[0]); const float inv = 1.f / (1.f + e1 + e2 + e3);
            const float gk[4] = {inv, e1 * inv, e2 * inv, e3 * inv};
            if (F.lane < 4) { const int k = F.lane; const int ee = k == 0 ? se[0] : k == 1 ? se[1] : k == 2 ? se[2] : se[3]; const float gg = k == 0 ? gk[0] : k == 1 ? gk[1] : k == 2 ? gk[2] : gk[3];
                const unsigned rank = __hip_atomic_fetch_add(&cnt[ee], 1u, __ATOMIC_RELAXED, __HIP_MEMORY_SCOPE_WORKGROUP); const int ai = (F.wave * 8 + p * 4 + r) * 4 + k;
                asg_e[ai] = ee; asg_r[ai] = (int)rank; asg_g[ai] = gg; }
        }
        LDS_WAIT(); asm volatile("" ::: "memory");
    }
    __syncthreads();
    if (F.tid < 32) base[F.tid] = __hip_atomic_fetch_add((unsigned*)(F.ctl + CW_CNT) + F.tid, cnt[F.tid], __ATOMIC_RELAXED, __HIP_MEMORY_SCOPE_AGENT);
    __syncthreads();
    if (F.tid < 256) { const int ee = asg_e[F.tid]; const int pos = (int)base[ee] + asg_r[F.tid]; const int tok = F.vcu * 64 + (F.tid >> 2);
        ((int*)(F.ws + WS_LTOK))[(size_t)ee * T + pos] = tok; ((float*)(F.ws + WS_LGATE))[(size_t)ee * T + pos] = asg_g[F.tid];
        ((int*)(F.ws + WS_TSLOT))[(size_t)tok * 4 + (F.tid & 3)] = (ee << 16) | pos; }
}
__device__ __forceinline__ void moe_table(Frame& F) {
    F.refresh();
    LAS int* cnt = (LAS int*)(F.lds + XTRA_OFF + 4096); LAS int* tstart = cnt + 32;
    if (F.tid < 32) cnt[F.tid] = (int)__hip_atomic_load(F.ctl + CW_CNT + F.tid, RLX_AGENT);
    __syncthreads();
    if (F.tid == 0) { int s = 0; for (int e = 0; e < 32; ++e) { tstart[e] = s; s += (cnt[e] + 255) >> 8; } tstart[32] = s; }
    __syncthreads();
}
template <bool GATH>
struct MoeOrder {
    const bf16_t* A; const bf16_t* Bt; int lda, K, npn, G, c; size_t bstride; const LAS int* cnt; const LAS int* tstart; const int* list;
    static constexpr bool GATHER = GATH;
    __device__ __forceinline__ bool next(int i, pg8::Unit& u) const {
        const int L = i * G + c; const int rt = L / npn;
        if (rt >= tstart[32]) return false;
        int e = 0; while (rt >= tstart[e + 1]) ++e;
        u.pm = rt; u.pn = L - rt * npn; u.e = e; return true;
    }
    __device__ __forceinline__ const char* a_base(const pg8::Unit& u) const { return GATH ? (const char*)A : (const char*)A + (size_t)u.pm * 256 * lda * 2; }
    __device__ __forceinline__ const char* b_base(const pg8::Unit& u) const { return (const char*)Bt + ((size_t)u.e * bstride + (size_t)u.pn * 256 * K) * 2; }
    __device__ __forceinline__ void a_offs(const pg8::Unit& u, const int (&R)[2], const int (&C)[2], unsigned (&v)[2][2]) const {
#pragma unroll
        for (int h = 0; h < 2; ++h)
#pragma unroll
            for (int i = 0; i < 2; ++i) {
                if (GATH) { const int slot = (u.pm - tstart[u.e]) * 256 + h * 128 + R[i]; const int tok = slot < cnt[u.e] ? list[(size_t)u.e * T + slot] : 0; v[h][i] = (unsigned)(tok * lda + C[i]) * 2u; }
                else v[h][i] = (unsigned)((h * 128 + R[i]) * lda + C[i]) * 2u; }
    }
};
constexpr float SW_LIMIT = 7.0f, SW_ALPHA = 1.702f;
struct EpiUp {
    static constexpr bool PERM = true;
    bf16_t* ACT; const float* bup;
    __device__ __forceinline__ void operator()(const f32x4 (&acc)[2][2][4][2], const pg8::Unit& u, int wr, int wc, int fr, int fq) const {
        const int c8 = wc * 32 + 8 * fq; const float* bg = bup + (size_t)u.e * 2048 + u.pn * 128 + c8; const float* bl = bg + 1024;
        const f32x4 bg0 = *(const f32x4*)bg, bg1 = *(const f32x4*)(bg + 4), bl0 = *(const f32x4*)bl, bl1 = *(const f32x4*)(bl + 4);
#pragma unroll
        for (int ai = 0; ai < 2; ++ai)
#pragma unroll
            for (int m = 0; m < 4; ++m) { const size_t row = (size_t)u.pm * 256 + ai * 128 + wr * 64 + m * 16 + fr;
                float v[8];
#pragma unroll
                for (int j = 0; j < 8; ++j) { float gl = (j < 4 ? acc[ai][0][m][0][j] + bg0[j] : acc[ai][0][m][1][j - 4] + bg1[j - 4]), li = (j < 4 ? acc[ai][1][m][0][j] + bl0[j] : acc[ai][1][m][1][j - 4] + bl1[j - 4]);
                    gl = fminf(gl, SW_LIMIT); li = fminf(fmaxf(li, -SW_LIMIT), SW_LIMIT);
                    v[j] = gl * __builtin_amdgcn_rcpf(1.f + __expf(-SW_ALPHA * gl)) * (li + 1.f); }
                u32x4 w; w.x = pk2(v[0], v[1]); w.y = pk2(v[2], v[3]); w.z = pk2(v[4], v[5]); w.w = pk2(v[6], v[7]);
                *(u32x4*)(ACT + row * 1024 + u.pn * 128 + c8) = w; }
    }
};
struct EpiDown {
    static constexpr bool PERM = true;
    bf16_t* YS; const float* bdn; const float* lgate; const LAS int* cnt; const LAS int* tstart;
    __device__ __forceinline__ void operator()(const f32x4 (&acc)[2][2][4][2], const pg8::Unit& u, int wr, int wc, int fr, int fq) const {
        const int nvalid = cnt[u.e] - (u.pm - tstart[u.e]) * 256;
#pragma unroll
        for (int ai = 0; ai < 2; ++ai)
#pragma unroll
            for (int m = 0; m < 4; ++m) { const int rl = ai * 128 + wr * 64 + m * 16 + fr; const size_t row = (size_t)u.pm * 256 + rl;
                const float gt = rl < nvalid ? lgate[(size_t)u.e * T + (u.pm - tstart[u.e]) * 256 + rl] : 0.f;
#pragma unroll
                for (int bj = 0; bj < 2; ++bj) { const int c0 = u.pn * 256 + bj * 128 + wc * 32 + 8 * fq; const float* bp = bdn + (size_t)u.e * 1024 + c0;
                    const f32x4 b0 = *(const f32x4*)bp, b1 = *(const f32x4*)(bp + 4);
                    u32x4 w; w.x = pk2((acc[ai][bj][m][0][0] + b0.x) * gt, (acc[ai][bj][m][0][1] + b0.y) * gt); w.y = pk2((acc[ai][bj][m][0][2] + b0.z) * gt, (acc[ai][bj][m][0][3] + b0.w) * gt);
                    w.z = pk2((acc[ai][bj][m][1][0] + b1.x) * gt, (acc[ai][bj][m][1][1] + b1.y) * gt); w.w = pk2((acc[ai][bj][m][1][2] + b1.z) * gt, (acc[ai][bj][m][1][3] + b1.w) * gt);
                    *(u32x4*)(YS + row * 1024 + c0) = w; } }
    }
};
__device__ __forceinline__ void p9_final(Frame& F, const Args& a) {
    F.refresh();
    const LAS int* tstart = (const LAS int*)(F.lds + XTRA_OFF + 4096) + 32;
    const bf16_t* H1 = (const bf16_t*)(F.ws + WS_H1); const bf16_t* YS = (const bf16_t*)(F.ws + WS_YS); const int* ts = (const int*)(F.ws + WS_TSLOT);
    const float* g = (const float*)a.in[21]; const float* bta = (const float*)a.in[22];
    const int gw = F.vcu * 8 + F.wave, NGW = F.G * 8;
    for (int m = gw; m < T; m += NGW) {
        float v[16];
#pragma unroll
        for (int j = 0; j < 2; ++j) { const u32x4 h = *(const GAS u32x4*)(H1 + (size_t)m * 1024 + 512 * j + 8 * F.lane);
#pragma unroll
            for (int q = 0; q < 4; ++q) { v[8 * j + 2 * q] = DN_ALPHA * __builtin_bit_cast(float, h[q] << 16); v[8 * j + 2 * q + 1] = DN_ALPHA * __builtin_bit_cast(float, h[q] & 0xffff0000u); } }
#pragma unroll
        for (int k = 0; k < 4; ++k) { const int sl = ts[(size_t)m * 4 + k]; const size_t row = (size_t)tstart[sl >> 16] * 256 + (sl & 0xffff);
#pragma unroll
            for (int j = 0; j < 2; ++j) { const u32x4 y = *(const GAS u32x4*)(YS + row * 1024 + 512 * j + 8 * F.lane);
#pragma unroll
                for (int q = 0; q < 4; ++q) { v[8 * j + 2 * q] += __builtin_bit_cast(float, y[q] << 16); v[8 * j + 2 * q + 1] += __builtin_bit_cast(float, y[q] & 0xffff0000u); } } }
        float s = 0.f;
#pragma unroll
        for (int i = 0; i < 16; ++i) s += v[i];
        const float mean = wave_sum(s) * (1.f / D); float s2 = 0.f;
#pragma unroll
        for (int i = 0; i < 16; ++i) { v[i] -= mean; s2 += v[i] * v[i]; }
        const float rstd = 1.f / sqrtf(wave_sum(s2) * (1.f / D) + LN_EPS);
#pragma unroll
        for (int j = 0; j < 2; ++j)
#pragma unroll
            for (int q = 0; q < 2; ++q) { const int c = 512 * j + 8 * F.lane + 4 * q; const f32x4 gg = *(const GAS f32x4*)(g + c), bb = *(const GAS f32x4*)(bta + c);
                f32x4 o; o.x = v[8 * j + 4 * q] * rstd * gg.x + bb.x; o.y = v[8 * j + 4 * q + 1] * rstd * gg.y + bb.y; o.z = v[8 * j + 4 * q + 2] * rstd * gg.z + bb.z; o.w = v[8 * j + 4 * q + 3] * rstd * gg.w + bb.w;
                *(GAS f32x4*)(a.out + (size_t)m * 1024 + c) = o; }
    }
}

__device__ __forceinline__ void dbg_fail(Frame& F, int id) { atomicOr((unsigned*)(F.ctl + CW_DBG), 1u << id); }
__device__ __forceinline__ bool close_enough(float got, float want, float atol, float rtol) { const float d = fabsf(got - want); return d <= atol + rtol * fabsf(want); }
__device__ __forceinline__ void dbg_check_proj(Frame& F, const Args& a) {
    F.refresh();
    const int NS = 16;
    if (F.vcu >= NS) return;
    const int row = (F.vcu * 1093 + 7) % T;
    const float* x = (const float*)a.in[0] + (size_t)row * D; const float* g = (const float*)a.in[2]; const float* b = (const float*)a.in[3];
    const float* w_in = (const float*)a.in[4]; const int* pos = (const int*)a.in[1]; const float* lbl = (const float*)a.in[9];
    LAS float* h = (LAS float*)F.lds; LAS float* red = h + 1024;
    float s = 0.f; for (int k = F.tid; k < D; k += 512) s += x[k];
    s = wave_sum(s); if (F.lane == 0) red[F.wave] = s; __syncthreads();
    float mean = 0.f; for (int w = 0; w < 8; ++w) mean += red[w]; mean *= (1.f / D); __syncthreads();
    float q = 0.f; for (int k = F.tid; k < D; k += 512) { const float d = x[k] - mean; q += d * d; }
    q = wave_sum(q); if (F.lane == 0) red[F.wave] = q; __syncthreads();
    float var = 0.f; for (int w = 0; w < 8; ++w) var += red[w]; var *= (1.f / D);
    const float rstd = 1.f / sqrtf(var + LN_EPS);
    const bf16_t* H0 = (const bf16_t*)(F.ws + WS_H0) + (size_t)row * D;
    for (int k = F.tid; k < D; k += 512) { const float hv = (x[k] - mean) * rstd * g[k] + b[k]; h[k] = hv; if (!close_enough(bf2f(H0[k]), hv, 0.02f, 0.01f)) dbg_fail(F, 1); }
    __syncthreads();
    const bf16_t* P = (const bf16_t*)(F.ws + WS_PROJ) + (size_t)row * NPROJ;
    for (int n = F.tid; n < IN_COLS; n += 512) {
        float acc = 0.f; for (int k = 0; k < D; ++k) acc += h[k] * w_in[(size_t)k * IN_COLS + n];
        float want; int c;
        if (n < 384) { c = PC_QA + n; want = acc; }
        else if (n < 640) { c = PC_KVA + (n - 384); want = acc; }
        else if (n < 672) {
            const int j = n - 640, i = j & 15, half = j >> 4; const int n2 = 640 + (1 - half) * 16 + i;
            float acc2 = 0.f; for (int k = 0; k < D; ++k) acc2 += h[k] * w_in[(size_t)k * IN_COLS + n2];
            const float inv = powf(10000.0f, -(float)(2 * i) / 32.0f); const float ang = (float)pos[row] * inv;
            const float cc = cosf(ang), ss = sinf(ang);
            const float x1 = half == 0 ? acc : acc2, x2 = half == 0 ? acc2 : acc;
            want = half == 0 ? x1 * cc - x2 * ss : x1 * ss + x2 * cc; c = PC_KR + 2 * i + half; }
        else if (n < 1184) { c = PC_HQ + (n - 672); want = acc / (1.f + expf(-acc)); }
        else if (n < 1696) { const int cc_ = n - 1184; c = PC_HF + cc_; const float lb = 1.f / (1.f + expf(lbl[512 + cc_] - lbl[cc_])); const float sg = 1.f / (1.f + expf(-acc)); want = logf(lb + (1.f - lb) * sg); }
        else if (n < 2208) { c = PC_HI + (n - 1696); want = acc; }
        else { c = PC_HG + (n - 2208); want = acc / (1.f + expf(-acc)); }
        if (!close_enough(bf2f(P[c]), want, 0.03f, 0.02f)) dbg_fail(F, 2);
    }
    for (int c = 672 + F.tid; c < 768; c += 512) if (bf2f(P[c]) != 0.f) dbg_fail(F, 3);
}
__device__ __forceinline__ void dbg_check_qkv(Frame& F, const Args& a) {
    F.refresh();
    const int NS = 16;
    if (F.vcu >= NS) return;
    const int row = (F.vcu * 2731 + 11) % T;
    const bf16_t* P = (const bf16_t*)(F.ws + WS_PROJ) + (size_t)row * NPROJ;
    const float* qg = (const float*)a.in[5]; const float* w_qb = (const float*)a.in[6]; const float* kvg = (const float*)a.in[7]; const float* w_kvb = (const float*)a.in[8];
    const int* pos = (const int*)a.in[1];
    LAS float* qa = (LAS float*)F.lds; LAS float* kva = qa + 384; LAS float* qraw = kva + 256;
    float sq = 0.f, sk = 0.f;
    for (int k = 0; k < 384; ++k) { const float v = bf2f(P[PC_QA + k]); sq += v * v; }
    for (int k = 0; k < 256; ++k) { const float v = bf2f(P[PC_KVA + k]); sk += v * v; }
    const float rq = 1.f / sqrtf(sq / 384.f + RMS_EPS), rk = 1.f / sqrtf(sk / 256.f + RMS_EPS);
    for (int k = F.tid; k < 384; k += 512) qa[k] = bf2f(P[PC_QA + k]) * rq * qg[k];
    for (int k = F.tid; k < 256; k += 512) kva[k] = bf2f(P[PC_KVA + k]) * rk * kvg[k];
    __syncthreads();
    for (int n = F.tid; n < 768; n += 512) { float acc = 0.f; for (int k = 0; k < 384; ++k) acc += qa[k] * w_qb[(size_t)k * 768 + n]; qraw[n] = acc; }
    __syncthreads();
    const bf16_t* Qb = (const bf16_t*)(F.ws + WS_Q) + (size_t)row * 768;
    for (int n = F.tid; n < 768; n += 512) {
        const int h = n / 96, d = n % 96; float want; int c;
        if (d < 64) { want = qraw[n]; c = n; }
        else { const int j = d - 64, i = j & 15, half = j >> 4; const float x1 = qraw[h * 96 + 64 + i], x2 = qraw[h * 96 + 80 + i];
            const float inv = powf(10000.0f, -(float)(2 * i) / 32.0f); const float ang = (float)pos[row] * inv; const float cc = cosf(ang), ss = sinf(ang);
            want = half == 0 ? x1 * cc - x2 * ss : x1 * ss + x2 * cc; c = h * 96 + 64 + 2 * i + half; }
        want *= QSCALE;
        if (!close_enough(bf2f(Qb[c]), want, 0.006f, 0.02f)) dbg_fail(F, 4);
    }
    const bf16_t* KVb = (const bf16_t*)(F.ws + WS_KV) + (size_t)row * 1024;
    for (int n = F.tid; n < 1024; n += 512) { float acc = 0.f; for (int k = 0; k < 256; ++k) acc += kva[k] * w_kvb[(size_t)k * 1024 + n];
        if (!close_enough(bf2f(KVb[n]), acc, 0.03f, 0.02f)) dbg_fail(F, 5); }
    __syncthreads();
}
__device__ __forceinline__ void dbg_check_attn(Frame& F) {
    F.refresh();
    const int NS = 64;
    if (F.vcu >= NS) return;
    const int t = (F.vcu * 4099 + 5 * F.vcu * F.vcu + 63) % T, h = F.vcu & 7;
    const int b = t / SEQ, tl = t % SEQ, nk = ((tl >> 6) + 1) * 64;
    const bf16_t* Q = (const bf16_t*)(F.ws + WS_Q) + (size_t)t * 768 + h * 96;
    const bf16_t* KV = (const bf16_t*)(F.ws + WS_KV) + (size_t)b * SEQ * 1024 + h * 128;
    const bf16_t* PR = (const bf16_t*)(F.ws + WS_PROJ) + (size_t)b * SEQ * NPROJ + PC_KR;
    LAS float* sc = (LAS float*)F.lds; LAS float* red = sc + 2048; LAS float* ov = red + 16;
    float mx = -INFINITY;
    for (int j = F.tid; j < nk; j += 512) { float s = 0.f;
        for (int d = 0; d < 64; ++d) s += bf2f(Q[d]) * bf2f(KV[(size_t)j * 1024 + d]);
        for (int d = 0; d < 32; ++d) s += bf2f(Q[64 + d]) * bf2f(PR[(size_t)j * NPROJ + d]);
        sc[j] = s; mx = fmaxf(mx, s); }
    for (int o = 1; o < 64; o <<= 1) mx = fmaxf(mx, __shfl_xor(mx, o));
    if (F.lane == 0) red[F.wave] = mx; __syncthreads();
    mx = red[0]; for (int w = 1; w < 8; ++w) mx = fmaxf(mx, red[w]); __syncthreads();
    float sm = 0.f;
    for (int j = F.tid; j < nk; j += 512) { const float p = exp2f(sc[j] - mx); sc[j] = p; sm += p; }
    sm = wave_sum(sm); if (F.lane == 0) red[F.wave] = sm; __syncthreads();
    float tot = 0.f; for (int w = 0; w < 8; ++w) tot += red[w];
    const bf16_t* M = (const bf16_t*)(F.ws + WS_MIX) + (size_t)t * 1024 + h * 64;
    if (F.tid < 64) { float acc = 0.f; for (int j = 0; j < nk; ++j) acc += sc[j] * bf2f(KV[(size_t)j * 1024 + 64 + F.tid]); acc /= tot; ov[F.tid] = acc;
        if (!close_enough(bf2f(M[F.tid]), acc, 0.01f, 0.03f)) dbg_fail(F, 6); }
    __syncthreads();
    if (F.tid == 0) { float s = 0.f; for (int d = 0; d < 64; ++d) s += ov[d] * ov[d]; const float got = ((const float*)(F.ws + WS_SSQ))[(size_t)t * 8 + h];
        if (!close_enough(got, s, 0.002f, 0.05f)) dbg_fail(F, 7); }
    __syncthreads();
}
__device__ __forceinline__ void dbg_check_norm(Frame& F, const float* g) {
    F.refresh();
    if (F.vcu >= 16 || F.tid != 0) return;
    const int t = (F.vcu * 1021 + 3) % T; const bf16_t* M = (const bf16_t*)(F.ws + WS_MIX) + (size_t)t * 1024;
    float s = 0.f; for (int c = 0; c < 512; ++c) { const float v = bf2f(M[c]) / g[c]; s += v * v; }
    if (!close_enough(s / 512.f, 1.f, 0.02f, 0.f)) dbg_fail(F, 8);
}
__device__ __forceinline__ void dbg_check_hgrn(Frame& F, const float* gout) {
    F.refresh();
    if (F.vcu >= 8) return;
    const int sidx = F.vcu * 8 + F.wave;
    const int tl = (sidx * 397 + 61 * (sidx & 7) + 5) % SEQ, b = sidx & 7, h = (sidx >> 3) & 3;
    const bf16_t* P = (const bf16_t*)(F.ws + WS_PROJ) + (size_t)b * SEQ * NPROJ;
    const int k0 = F.lane, k1 = F.lane + 64;
    const float q0 = bf2f(P[(size_t)tl * NPROJ + PC_HQ + h * 128 + k0]), q1 = bf2f(P[(size_t)tl * NPROJ + PC_HQ + h * 128 + k1]);
    float dec0 = 1.f, dec1 = 1.f, o0 = 0.f, o1 = 0.f;
    for (int s = tl; s >= 0; --s) {
        const bf16_t* ps = P + (size_t)s * NPROJ;
        const float g0 = bf2f(ps[PC_HF + h * 128 + k0]), g1 = bf2f(ps[PC_HF + h * 128 + k1]);
        float c = q0 * (1.f - expf(g0)) * dec0 + q1 * (1.f - expf(g1)) * dec1;
        c = wave_sum(c);
        o0 += c * bf2f(ps[PC_HI + h * 128 + k0]); o1 += c * bf2f(ps[PC_HI + h * 128 + k1]);
        dec0 *= expf(g0); dec1 *= expf(g1);
    }
    const float ss = wave_sum(o0 * o0 + o1 * o1), rs = 1.f / sqrtf(ss / 128.f + RMS_EPS);
    const bf16_t* pt = P + (size_t)tl * NPROJ;
    const float w0 = o0 * rs * gout[h * 128 + k0] * bf2f(pt[PC_HG + h * 128 + k0]), w1 = o1 * rs * gout[h * 128 + k1] * bf2f(pt[PC_HG + h * 128 + k1]);
    const bf16_t* M = (const bf16_t*)(F.ws + WS_MIX) + ((size_t)b * SEQ + tl) * 1024 + 512 + h * 128;
    if (!close_enough(bf2f(M[k0]), w0, 0.03f, 0.04f) || !close_enough(bf2f(M[k1]), w1, 0.03f, 0.04f)) dbg_fail(F, 9);
}
__device__ __forceinline__ void dbg_check_router(Frame& F, const Args& a) {
    F.refresh();
    if (F.vcu >= 16) return;
    const int row = (F.vcu * 3079 + 17) % T;
    const float* w_o = (const float*)a.in[12]; const float* g = (const float*)a.in[13]; const float* bta = (const float*)a.in[14]; const float* wr_ = (const float*)a.in[15]; const float* br = (const float*)a.in[16];
    const bf16_t* MIX = (const bf16_t*)(F.ws + WS_MIX) + (size_t)row * 1024; const bf16_t* H0 = (const bf16_t*)(F.ws + WS_H0) + (size_t)row * 1024;
    const float* Y = (const float*)(F.ws + WS_Y) + (size_t)row * 1024; const bf16_t* H1 = (const bf16_t*)(F.ws + WS_H1) + (size_t)row * 1024;
    LAS float* mx = (LAS float*)F.lds; LAS float* h1 = mx + 1024; LAS float* red = h1 + 1024; LAS float* lg = red + 16;
    for (int k = F.tid; k < 1024; k += 512) mx[k] = bf2f(MIX[k]);
    __syncthreads();
    for (int n = F.tid; n < 1024; n += 512) { float acc = 0.f; for (int k = 0; k < 1024; ++k) acc += mx[k] * w_o[(size_t)k * 1024 + n];
        const float want = DN_ALPHA * bf2f(H0[n]) + acc; if (!close_enough(Y[n], want, 0.03f, 0.02f)) dbg_fail(F, 10); }
    float s = 0.f; for (int k = F.tid; k < 1024; k += 512) s += Y[k];
    s = wave_sum(s); if (F.lane == 0) red[F.wave] = s; __syncthreads();
    float mean = 0.f; for (int w = 0; w < 8; ++w) mean += red[w]; mean *= (1.f / D); __syncthreads();
    float q = 0.f; for (int k = F.tid; k < 1024; k += 512) { const float d = Y[k] - mean; q += d * d; }
    q = wave_sum(q); if (F.lane == 0) red[F.wave] = q; __syncthreads();
    float var = 0.f; for (int w = 0; w < 8; ++w) var += red[w]; var *= (1.f / D);
    const float rstd = 1.f / sqrtf(var + LN_EPS);
    for (int k = F.tid; k < 1024; k += 512) { const float hv = (Y[k] - mean) * rstd * g[k] + bta[k]; h1[k] = hv; if (!close_enough(bf2f(H1[k]), hv, 0.02f, 0.01f)) dbg_fail(F, 11); }
    __syncthreads();
    if (F.tid < 32) { float acc = 0.f; for (int k = 0; k < 1024; ++k) acc += h1[k] * wr_[(size_t)k * 32 + F.tid]; lg[F.tid] = acc + br[F.tid]; }
    __syncthreads();
    if (F.tid == 0) {
        const int* ts = (const int*)(F.ws + WS_TSLOT) + (size_t)row * 4; float l[32]; for (int e = 0; e < 32; ++e) l[e] = lg[e];
        int se[4]; float sl[4];
        for (int k = 0; k < 4; ++k) { int bi = 0; for (int e = 1; e < 32; ++e) if (l[e] > l[bi]) bi = e; se[k] = bi; sl[k] = l[bi]; l[bi] = -INFINITY; }
        float den = 0.f; for (int k = 0; k < 4; ++k) den += expf(sl[k] - sl[0]);
        for (int k = 0; k < 4; ++k) { const int e = ts[k] >> 16, pos = ts[k] & 0xffff;
            if (e != se[k] && fabsf(lg[e] - sl[k]) > 1e-4f) dbg_fail(F, 12);
            const float gt = ((const float*)(F.ws + WS_LGATE))[(size_t)e * T + pos];
            if (!close_enough(gt, expf(sl[k] - sl[0]) / den, 1e-3f, 1e-3f)) dbg_fail(F, 12);
            if (((const int*)(F.ws + WS_LTOK))[(size_t)e * T + pos] != row) dbg_fail(F, 13);
            if (pos >= (int)__hip_atomic_load(F.ctl + CW_CNT + e, RLX_AGENT)) dbg_fail(F, 13); }
    }
    __syncthreads();
}
__device__ __forceinline__ void dbg_check_moe(Frame& F, const Args& a) {
    F.refresh();
    if (F.vcu >= 32) return;
    const LAS int* cnt = (const LAS int*)(F.lds + XTRA_OFF + 4096); const LAS int* tstart = cnt + 32;
    const int e = F.vcu; if (cnt[e] == 0) return;
    const int slot = (F.vcu * 997 + 13) % cnt[e];
    const size_t prow = (size_t)tstart[e] * 256 + slot;
    const int tok = ((const int*)(F.ws + WS_LTOK))[(size_t)e * T + slot]; const float gt = ((const float*)(F.ws + WS_LGATE))[(size_t)e * T + slot];
    const float* w_up = (const float*)a.in[17] + (size_t)e * 1024 * 2048; const float* b_up = (const float*)a.in[18] + (size_t)e * 2048;
    const float* w_dn = (const float*)a.in[19] + (size_t)e * 1024 * 1024; const float* b_dn = (const float*)a.in[20] + (size_t)e * 1024;
    const bf16_t* H1 = (const bf16_t*)(F.ws + WS_H1) + (size_t)tok * 1024; const bf16_t* ACT = (const bf16_t*)(F.ws + WS_ACT) + prow * 1024; const bf16_t* YS = (const bf16_t*)(F.ws + WS_YS) + prow * 1024;
    LAS float* hx = (LAS float*)F.lds + 4096; LAS float* ac = hx + 1024;
    __syncthreads();
    for (int k = F.tid; k < 1024; k += 512) { hx[k] = bf2f(H1[k]); ac[k] = bf2f(ACT[k]); }
    __syncthreads();
    for (int j = F.tid; j < 1024; j += 512) { float gl = 0.f, li = 0.f; for (int k = 0; k < 1024; ++k) { gl += hx[k] * w_up[(size_t)k * 2048 + j]; li += hx[k] * w_up[(size_t)k * 2048 + 1024 + j]; }
        gl += b_up[j]; li += b_up[1024 + j]; gl = fminf(gl, 7.f); li = fminf(fmaxf(li, -7.f), 7.f);
        const float want = gl / (1.f + expf(-1.702f * gl)) * (li + 1.f);
        if (!close_enough(ac[j], want, 0.03f, 0.03f)) dbg_fail(F, 14); }
    for (int n = F.tid; n < 1024; n += 512) { float acc = 0.f; for (int j = 0; j < 1024; ++j) acc += ac[j] * w_dn[(size_t)j * 1024 + n];
        const float want = (acc + b_dn[n]) * gt; if (!close_enough(bf2f(YS[n]), want, 0.01f, 0.03f)) dbg_fail(F, 15); }
    __syncthreads();
}
__device__ __forceinline__ void dbg_check_final(Frame& F, const Args& a) {
    F.refresh();
    if (F.vcu >= 16) return;
    const LAS int* tstart = (const LAS int*)(F.lds + XTRA_OFF + 4096) + 32;
    const int row = (F.vcu * 1789 + 29) % T; const int* ts = (const int*)(F.ws + WS_TSLOT) + (size_t)row * 4;
    const bf16_t* H1 = (const bf16_t*)(F.ws + WS_H1) + (size_t)row * 1024; const bf16_t* YS = (const bf16_t*)(F.ws + WS_YS);
    LAS float* vv = (LAS float*)F.lds + 8192; LAS float* red = vv + 1024;
    __syncthreads();
    float s = 0.f;
    for (int c = F.tid; c < 1024; c += 512) { float v = DN_ALPHA * bf2f(H1[c]); for (int k = 0; k < 4; ++k) v += bf2f(YS[((size_t)tstart[ts[k] >> 16] * 256 + (ts[k] & 0xffff)) * 1024 + c]); vv[c] = v; s += v; }
    s = wave_sum(s); if (F.lane == 0) red[F.wave] = s; __syncthreads();
    float mean = 0.f; for (int w = 0; w < 8; ++w) mean += red[w]; mean *= (1.f / D); __syncthreads();
    float q = 0.f; for (int c = F.tid; c < 1024; c += 512) { const float d = vv[c] - mean; q += d * d; }
    q = wave_sum(q); if (F.lane == 0) red[F.wave] = q; __syncthreads();
    float var = 0.f; for (int w = 0; w < 8; ++w) var += red[w]; var *= (1.f / D);
    const float rstd = 1.f / sqrtf(var + LN_EPS); const float* g = (const float*)a.in[21]; const float* bta = (const float*)a.in[22];
    for (int c = F.tid; c < 1024; c += 512) { const float want = (vv[c] - mean) * rstd * g[c] + bta[c]; if (!close_enough(a.out[(size_t)row * 1024 + c], want, 0.01f, 0.01f)) dbg_fail(F, 16); }
    __syncthreads();
}
__device__ __forceinline__ void dbg_emit(Frame& F, float* out) {
    F.refresh();
    const unsigned m = __hip_atomic_load(F.ctl + CW_DBG, RLX_AGENT);
    const unsigned tm = __hip_atomic_load(F.ctl + CW_BAR + XB_TMO, RLX_AGENT);
    float C = 0.f;
    if (tm) C = 1e15f;
    else if (m) { const int id = __builtin_ctz(m); C = sqrtf(powf(10.f, (float)id) - 1.f); }
    const f32x4 v = (f32x4){C, C, C, C};
    for (size_t i = (size_t)F.vcu * 512 + F.tid; i < (size_t)T * D / 4; i += (size_t)F.G * 512) ((GAS f32x4*)out)[i] = v;
}

__global__ void __launch_bounds__(512, 2) fwd_kernel(Args args) {
    extern __shared__ __attribute__((aligned(16))) unsigned char lds[];
    Frame F;
    F.lds = (LAS unsigned char*)lds;
    F.MISC = (volatile LAS unsigned*)(F.lds + MISC_OFF);
    F.wave = __builtin_amdgcn_readfirstlane((int)threadIdx.x >> 6); F.refresh();
    F.G = gridDim.x; { const int bx = blockIdx.x; F.vcu = (F.G % 8 == 0) ? (bx % 8) * (F.G / 8) + bx / 8 : bx; }
    F.ws = args.ws; F.ctl = (gu32*)(args.ws + WS_CTL);
    for (int u = F.tid; u < 64; u += 512) ((LAS unsigned*)(F.lds + MISC_OFF))[u] = 0u;
    __syncthreads();
    XcdBarrier bar = xcd_barrier_post((unsigned*)(F.ctl + CW_BAR), F.MISC + 8);

    p0_prologue(F, args);
    xcd_barrier(bar);
    {
        pg8::DenseOrder S; S.init((const bf16_t*)(F.ws + WS_H0), D, (const bf16_t*)(F.ws + WS_WIN), D, T, NPROJ, F.G, (int)blockIdx.x);
        EpiProj E{(bf16_t*)(F.ws + WS_PROJ), (const float*)(F.ws + WS_COS), (const float*)(F.ws + WS_SIN), (const float*)(F.ws + WS_LB)};
        pg8::gemm_phase<EpiProj, pg8::DenseOrder>(F.lds, D, S, E, F.wave);
    }
    xcd_barrier(bar);
#if DBG_STAGE == 1
    dbg_check_proj(F, args);
    xcd_barrier(bar);
    dbg_emit(F, args.out);
    return;
#endif
    {
        const bf16_t* PROJ = (const bf16_t*)(F.ws + WS_PROJ);
        LAS float* tabkv = (LAS float*)(F.lds + XTRA_OFF); LAS float* tabq = tabkv + 256;
        pg8::DenseOrder Skv; Skv.init(PROJ + PC_KVA, NPROJ, (const bf16_t*)(F.ws + WS_WKVB), KVL, T, 1024, F.G, (int)blockIdx.x);
        pg8::DenseOrder Sq; Sq.init(PROJ + PC_QA, NPROJ, (const bf16_t*)(F.ws + WS_WQB), QL, T, 768, F.G, (int)blockIdx.x);
        pg8::Unit u; F.refresh();
        if (Skv.next(0, u)) rs_table(PROJ, u.pm, PC_KVA, KVL, tabkv, F.tid);
        if (Sq.next(0, u)) rs_table(PROJ, u.pm, PC_QA, QL, tabq, F.tid);
        LDS_WAIT(); __syncthreads();
        EpiKV Ekv{(bf16_t*)(F.ws + WS_KV), tabkv};
        pg8::gemm_phase<EpiKV, pg8::DenseOrder>(F.lds, KVL, Skv, Ekv, F.wave);
        EpiQ Eq{(bf16_t*)(F.ws + WS_Q), (const float*)(F.ws + WS_COS), (const float*)(F.ws + WS_SIN), tabq};
        pg8::gemm_phase<EpiQ, pg8::DenseOrder>(F.lds, QL, Sq, Eq, F.wave);
        for (int j = 0; j < 4; ++j) { const int unit = F.vcu * 4 + j; if (unit < 1024) hg::pass_a(unit, PROJ, (float*)(F.ws + WS_LT), (float*)(F.ws + WS_DEC), F.lds, F.wave); }
    }
    xcd_barrier(bar);
    {
        F.refresh();
        hg::pass_b((const float*)(F.ws + WS_LT), (const float*)(F.ws + WS_DEC), (bf16_t*)(F.ws + WS_SST), F.vcu * 512 + F.tid, F.G * 512);
        const int bh = F.vcu >> 2, s = F.vcu & 3;
        if (bh < NB * 8) {
            att::unit(bh >> 3, bh & 7, 7 - s, (const bf16_t*)(F.ws + WS_Q), (const bf16_t*)(F.ws + WS_KV), (const bf16_t*)(F.ws + WS_PROJ), (bf16_t*)(F.ws + WS_MIX), (float*)(F.ws + WS_SSQ), F.lds, F.wave);
            att::unit(bh >> 3, bh & 7, s, (const bf16_t*)(F.ws + WS_Q), (const bf16_t*)(F.ws + WS_KV), (const bf16_t*)(F.ws + WS_PROJ), (bf16_t*)(F.ws + WS_MIX), (float*)(F.ws + WS_SSQ), F.lds, F.wave);
        }
    }
    xcd_barrier(bar);
#if DBG_STAGE >= 2
    dbg_check_proj(F, args);
    __syncthreads();
    dbg_check_qkv(F, args);
    dbg_check_attn(F);
    xcd_barrier(bar);
#endif
    attn_normalise(F, (const float*)args.in[10]);
    for (int j = 0; j < 4; ++j) { const int unit = F.vcu * 4 + j; if (unit < 1024) hg::pass_c(unit, (const bf16_t*)(F.ws + WS_PROJ), (const bf16_t*)(F.ws + WS_SST), (const float*)args.in[11], (bf16_t*)(F.ws + WS_MIX), F.lds, F.wave); }
    xcd_barrier(bar);
#if DBG_STAGE >= 3
    dbg_check_norm(F, (const float*)args.in[10]);
    dbg_check_hgrn(F, (const float*)args.in[11]);
    __syncthreads();
#endif
    {
        pg8::DenseOrder S; S.init((const bf16_t*)(F.ws + WS_MIX), D, (const bf16_t*)(F.ws + WS_WO), D, T, D, F.G, (int)blockIdx.x);
        EpiY E{(float*)(F.ws + WS_Y), (const bf16_t*)(F.ws + WS_H0)};
        pg8::gemm_phase<EpiY, pg8::DenseOrder>(F.lds, D, S, E, F.wave);
    }
    xcd_barrier(bar);
    p6_router(F, args);
    xcd_barrier(bar);
    moe_table(F);
    {
        const LAS int* cnt = (const LAS int*)(F.lds + XTRA_OFF + 4096); const LAS int* tstart = cnt + 32;
        MoeOrder<true> S{(const bf16_t*)(F.ws + WS_H1), (const bf16_t*)(F.ws + WS_WUP), D, D, 8, F.G, F.vcu, (size_t)2048 * D, cnt, tstart, (const int*)(F.ws + WS_LTOK)};
        EpiUp E{(bf16_t*)(F.ws + WS_ACT), (const float*)args.in[18]};
        pg8::gemm_phase<EpiUp, MoeOrder<true>>(F.lds, D, S, E, F.wave);
    }
    xcd_barrier(bar);
    {
        const LAS int* cnt = (const LAS int*)(F.lds + XTRA_OFF + 4096); const LAS int* tstart = cnt + 32;
        MoeOrder<false> S{(const bf16_t*)(F.ws + WS_ACT), (const bf16_t*)(F.ws + WS_WDN), DE, DE, 4, F.G, F.vcu, (size_t)D * DE, cnt, tstart, nullptr};
        EpiDown E{(bf16_t*)(F.ws + WS_YS), (const float*)args.in[20], (const float*)(F.ws + WS_LGATE), cnt, tstart};
        pg8::gemm_phase<EpiDown, MoeOrder<false>>(F.lds, DE, S, E, F.wave);
    }
    xcd_barrier(bar);
    p9_final(F, args);
#if DBG_STAGE >= 3
    xcd_barrier(bar);
    dbg_check_router(F, args);
    dbg_check_moe(F, args);
    dbg_check_final(F, args);
    F.refresh(); if (F.vcu == 100 && F.tid == 0) dbg_fail(F, 20);
    xcd_barrier(bar);
    dbg_emit(F, args.out);
#endif
}

extern "C" void kernel_launch(void* const* d_in, const int* in_sizes, int n_in, void* d_out, int out_size, void* d_ws, size_t ws_size, hipStream_t stream) {
    static int grid = 0;
    if (grid == 0) {
        if (n_in != 23 || out_size != T * D || ws_size < WS_END_A) { fprintf(stderr, "kernel_launch: unexpected shapes (n_in %d out %d ws %zu)\n", n_in, out_size, ws_size); grid = -1; return; }
        int dev = 0, cus = 0, per_cu = 0;
        if (hipGetDevice(&dev) != hipSuccess || hipDeviceGetAttribute(&cus, hipDeviceAttributeMultiprocessorCount, dev) != hipSuccess) { grid = -1; return; }
        if (hipFuncSetAttribute((const void*)fwd_kernel, hipFuncAttributeMaxDynamicSharedMemorySize, LDS_BYTES) != hipSuccess) { fprintf(stderr, "kernel_launch: hipFuncSetAttribute failed\n"); grid = -1; return; }
        if (hipOccupancyMaxActiveBlocksPerMultiprocessor(&per_cu, (const void*)fwd_kernel, 512, LDS_BYTES) != hipSuccess || per_cu < 1) fprintf(stderr, "kernel_launch: occupancy query says %d\n", per_cu);
        (void)hipGetLastError();
        grid = cus;
    }
    if (grid < 0) return;
    if (hipMemsetAsync((char*)d_ws + WS_CTL, 0, CTL_ZERO_BYTES, stream) != hipSuccess) return;
    Args a{};
    for (int i = 0; i < 23; ++i) a.in[i] = d_in[i];
    a.out = (float*)d_out; a.ws = (unsigned char*)d_ws;
    hipLaunchKernelGGL(fwd_kernel, dim3(grid), dim3(512), LDS_BYTES, stream, a);
}
```

```cpp
#include <hip/hip_runtime.h>
#include <cstdio>
#include <cstdint>

#ifndef DBG_STAGE
#define DBG_STAGE 0
#endif

#ifndef DUP_PHASE
#define DUP_PHASE -1
#endif
#ifndef TPROBE
#define TPROBE 0
#endif
#define GAS __attribute__((address_space(1)))
#define LAS __attribute__((address_space(3)))
typedef unsigned short bf16_t;
typedef short bf16x8 __attribute__((ext_vector_type(8)));
typedef float f32x4 __attribute__((ext_vector_type(4)));
typedef float f32x2 __attribute__((ext_vector_type(2)));
typedef unsigned u32x4 __attribute__((ext_vector_type(4)));
typedef unsigned u32x2 __attribute__((ext_vector_type(2)));
typedef GAS unsigned gu32;

constexpr int T = 16384, SEQ = 2048, NB = 8, D = 1024;
constexpr int IN_COLS = 2720, NPROJ = 2816;
constexpr int QL = 384, KVL = 256;
constexpr int NE = 32, DE = 1024;
constexpr float LN_EPS = 1e-5f, RMS_EPS = 1e-6f;
constexpr float DN_ALPHA = 1.189207115002721f;
constexpr int PC_KVA = 0, PC_QA = 256, PC_KR = 640, PC_HQ = 768, PC_HF = 1280, PC_HI = 1792, PC_HG = 2304;

constexpr size_t MiB = 1u << 20;
constexpr size_t WS_CTL = 0, CTL_ZERO_BYTES = 1 * MiB;
constexpr size_t WS_COS = 1 * MiB, WS_SIN = 2 * MiB, WS_LB = 3 * MiB;
constexpr size_t WS_WRH = 3 * MiB + 65536, WS_WRL = 3 * MiB + 131072;
constexpr size_t WS_WIN = 4 * MiB;
constexpr size_t WS_WQB = 10 * MiB, WS_WKVB = 11 * MiB, WS_WO = 12 * MiB;
constexpr size_t WS_WUP = 14 * MiB;
constexpr size_t WS_WDN = 142 * MiB;
constexpr size_t WS_H0 = 206 * MiB;
constexpr size_t WS_PROJ = 238 * MiB;
constexpr size_t WS_Q = 326 * MiB;
constexpr size_t WS_KV = 350 * MiB;
constexpr size_t WS_MIX = 382 * MiB;
constexpr size_t WS_SSQ = 414 * MiB;
constexpr size_t WS_LT = 416 * MiB;
constexpr size_t WS_SST = 480 * MiB;
constexpr size_t WS_DEC = 512 * MiB;
constexpr size_t WS_Y = 514 * MiB;
constexpr size_t WS_H1 = 578 * MiB;
constexpr size_t WS_LTOK = 610 * MiB, WS_LGATE = 612 * MiB, WS_TSLOT = 614 * MiB;
constexpr size_t WS_ACT = 616 * MiB;
constexpr size_t WS_YS = 760 * MiB;
constexpr size_t WS_END_A = 904 * MiB;
constexpr int CW_CNT = 1024;
constexpr int CW_TS = 2048;
constexpr int CW_DBG = 8;
constexpr int CW_BAR = 4096;

constexpr int RING_BYTES = 131072;
constexpr int XTRA_OFF = RING_BYTES, XTRA_BYTES = 20480;
constexpr int MISC_OFF = XTRA_OFF + XTRA_BYTES;
constexpr int LDS_BYTES = MISC_OFF + 256;

#define RLX_AGENT __ATOMIC_RELAXED, __HIP_MEMORY_SCOPE_AGENT
#define LDS_WAIT() asm volatile("s_waitcnt lgkmcnt(0)" ::: "memory")
#define VM_WAIT() asm volatile("s_waitcnt vmcnt(0)" ::: "memory")
__device__ __forceinline__ unsigned f2bf(float f) { unsigned u = __builtin_bit_cast(unsigned, f); return (u + 0x7fffu + ((u >> 16) & 1u)) >> 16; }
__device__ __forceinline__ unsigned pk2(float lo, float hi) { return f2bf(lo) | (f2bf(hi) << 16); }
__device__ __forceinline__ float bf2f(bf16_t h) { return __builtin_bit_cast(float, (unsigned)h << 16); }
__device__ __forceinline__ float wave_sum(float v) {
#pragma unroll
    for (int o = 1; o < 64; o <<= 1) v += __shfl_xor(v, o);
    return v;
}
__device__ __forceinline__ int fresh_lane() { int l; asm volatile("v_mbcnt_lo_u32_b32 %0, -1, 0\n\tv_mbcnt_hi_u32_b32 %0, -1, %0" : "=v"(l)); return l; }
__device__ __forceinline__ float silu_f(float x) { return x * __builtin_amdgcn_rcpf(1.f + __expf(-x)); }

namespace pg8 {
constexpr int BM = 256, BK = 64, HALF = 128, HTB = HALF * BK * 2, STAGE_BYTES = 8 * HTB, NXCD = 8, WGM = 8;
__host__ __device__ __forceinline__ int lds_byte(int r, int c) { const int st = (r >> 4) * 2 + (c >> 5), rr = r & 15, cc = c & 31, ob = rr * 64 + cc * 2; return st * 1024 + (ob ^ (((ob >> 9) & 1) << 5)); }
__host__ __device__ __forceinline__ void stage_rc(int b, int& R, int& C) { const int st = b / 1024, sb = b % 1024, swz = sb ^ (((sb >> 9) & 1) << 5); R = (st >> 1) * 16 + swz / 64; C = (st & 1) * 32 + (swz % 64) / 2; }
__host__ __device__ __forceinline__ int perm32(int rho) { const int n = rho >> 4, i = rho & 15; return 8 * (i >> 2) + 4 * n + (i & 3); }

struct Unit { int pm, pn, e; };

struct DenseOrder {
    const bf16_t* A; const bf16_t* Bt; int lda, K;
    int nM, nN, nwg, G, c;
    __device__ __forceinline__ void init(const bf16_t* A_, int lda_, const bf16_t* Bt_, int K_, int M, int N, int G_, int c_) { A = A_; Bt = Bt_; lda = lda_; K = K_; nM = M / BM; nN = N / BM; nwg = nM * nN; G = G_; c = c_; }
    __device__ __forceinline__ bool next(int i, Unit& u) const {
        const long L = (long)i * G + c; if (L >= nwg) return false;
        int wgid = (int)L; { const int q = nwg / NXCD, r = nwg % NXCD, xcd = wgid % NXCD, off = wgid / NXCD; wgid = (xcd < r ? xcd * (q + 1) : r * (q + 1) + (xcd - r) * q) + off; }
        const int nig = WGM * nN, gid = wgid / nig, fm = gid * WGM, gsz = (nM - fm) < WGM ? (nM - fm) : WGM;
        u.pm = fm + ((wgid % nig) % gsz); u.pn = (wgid % nig) / gsz; u.e = 0; return true;
    }
    __device__ __forceinline__ const char* a_base(const Unit& u) const { return (const char*)A + (size_t)u.pm * BM * lda * 2; }
    __device__ __forceinline__ const char* b_base(const Unit& u) const { return (const char*)Bt + (size_t)u.pn * BM * K * 2; }
    __device__ __forceinline__ void a_offs(const Unit&, const int (&R)[2], const int (&C)[2], unsigned (&v)[2][2]) const {
#pragma unroll
        for (int h = 0; h < 2; ++h)
#pragma unroll
            for (int i = 0; i < 2; ++i) v[h][i] = (unsigned)((h * HALF + R[i]) * lda + C[i]) * 2u;
    }
    static constexpr bool GATHER = false;
};

template <class Epi, class Sched>
__device__ __forceinline__ void gemm_phase(LAS unsigned char* lds, const int K, const Sched& S, const Epi& E, const int wave) {
    const int lane = fresh_lane(), wid = wave, tid = wid * 64 + lane, wr = wid >> 2, wc = wid & 3, fr = lane & 15, fq = lane >> 4;
    const int nt = K / BK;
    int RA[2], CA[2]; unsigned voffB[2];
#pragma unroll
    for (int i = 0; i < 2; ++i) { int R, C; stage_rc(tid * 16 + i * 8192, R, C); const int Rb = Epi::PERM ? ((R & ~31) + perm32(R & 31)) : R;
        RA[i] = R; CA[i] = C; voffB[i] = (unsigned)(Rb * K + C) * 2u; }
    const size_t kstep = (size_t)(BK * 2);
    const size_t hstepB = (size_t)HALF * K * 2;
    const unsigned ldsw = (unsigned)wid * 1024u;
    const int aoff = lds_byte(wr * 64 + fr, fq * 8), boff = lds_byte(wc * 32 + fr, fq * 8);
#define PG8_SA(b, h) (((b) * 2 + (h)) * HTB)
#define PG8_SB(b, h) ((4 + (b) * 2 + (h)) * HTB)
#define PG8_STAGE(bufoff, gbase, voff) do { _Pragma("unroll") for (int _i = 0; _i < 2; ++_i) \
        __builtin_amdgcn_global_load_lds((const unsigned*)((const char*)(gbase) + (voff)[_i]), (LAS unsigned*)(lds + (bufoff) + ldsw + _i * 8192), 16, 0, 0); } while (0)
#define PG8_LDA(dst, b, h) do { _Pragma("unroll") for (int m = 0; m < 4; ++m) _Pragma("unroll") for (int k = 0; k < 2; ++k) dst[m][k] = *(const LAS bf16x8*)(lds + PG8_SA(b, h) + aoff + m * 2048 + k * 1024); } while (0)
#define PG8_LDB(dst, b, h) do { _Pragma("unroll") for (int n = 0; n < 2; ++n) _Pragma("unroll") for (int k = 0; k < 2; ++k) dst[n][k] = *(const LAS bf16x8*)(lds + PG8_SB(b, h) + boff + n * 2048 + k * 1024); } while (0)
#define PG8_MMA(ai, bj, At, Bt) do { __builtin_amdgcn_s_setprio(1); _Pragma("unroll") for (int m = 0; m < 4; ++m) _Pragma("unroll") for (int n = 0; n < 2; ++n) _Pragma("unroll") for (int k = 0; k < 2; ++k) \
        acc[ai][bj][m][n] = __builtin_amdgcn_mfma_f32_16x16x32_bf16(Bt[n][k], At[m][k], acc[ai][bj][m][n], 0, 0, 0); __builtin_amdgcn_s_setprio(0); } while (0)
#define PG8_WAIT_V(n) asm volatile("s_waitcnt vmcnt(" #n ")" ::: "memory")
#define PG8_WAIT_L(n) asm volatile("s_waitcnt lgkmcnt(" #n ")" ::: "memory")
#define PG8_BAR __builtin_amdgcn_s_barrier()
#define PG8_SCHED __builtin_amdgcn_sched_barrier(0)
    Unit cur, nxt; int ui = 0;
    if (!S.next(0, cur)) return;
    f32x4 acc[2][2][4][2];
#pragma unroll
    for (int a = 0; a < 2; ++a)
#pragma unroll
        for (int b = 0; b < 2; ++b)
#pragma unroll
            for (int m = 0; m < 4; ++m)
#pragma unroll
                for (int n = 0; n < 2; ++n) acc[a][b][m][n] = (f32x4){0.f, 0.f, 0.f, 0.f};
    bf16x8 At[4][2], B0[2][2], B1[2][2];
    const char* cA = S.a_base(cur); const char* cB = S.b_base(cur);
    unsigned vC[2][2], vN[2][2];
    S.a_offs(cur, RA, CA, vC);
#pragma unroll
    for (int h = 0; h < 2; ++h) { vN[h][0] = vC[h][0]; vN[h][1] = vC[h][1]; }
    PG8_STAGE(PG8_SB(0, 0), cB, voffB); PG8_STAGE(PG8_SB(0, 1), cB + hstepB, voffB); PG8_STAGE(PG8_SA(0, 0), cA, vC[0]); PG8_STAGE(PG8_SA(0, 1), cA, vC[1]);
    if (wr == 1) PG8_BAR;
    PG8_WAIT_V(2); PG8_BAR;
    PG8_STAGE(PG8_SB(1, 0), cB + kstep, voffB); PG8_STAGE(PG8_SA(1, 0), cA + kstep, vC[0]); PG8_STAGE(PG8_SB(1, 1), cB + hstepB + kstep, voffB);
    PG8_WAIT_V(6); PG8_BAR;
    for (;;) {
        const bool has_next = S.next(ui + 1, nxt);
        const char* nA = has_next ? S.a_base(nxt) : cA; const char* nB = has_next ? S.b_base(nxt) : cB;
        if (Sched::GATHER) { if (has_next) S.a_offs(nxt, RA, CA, vN); else {
#pragma unroll
            for (int h = 0; h < 2; ++h) { vN[h][0] = vC[h][0]; vN[h][1] = vC[h][1]; } } }
#pragma nounroll
        for (int t = 0; t < nt; t += 2) {
            const bool last = (t == nt - 2);
            const char* a1 = cA + (size_t)(t + 1) * kstep;
            const char* a2 = last ? nA : cA + (size_t)(t + 2) * kstep; const char* b2 = last ? nB : cB + (size_t)(t + 2) * kstep;
            const char* a3 = a2 + kstep; const char* b3 = b2 + kstep;
            unsigned v2[2][2];
#pragma unroll
            for (int h = 0; h < 2; ++h) { v2[h][0] = (Sched::GATHER && last) ? vN[h][0] : vC[h][0]; v2[h][1] = (Sched::GATHER && last) ? vN[h][1] : vC[h][1]; }
            PG8_LDB(B0, 0, 0); PG8_LDB(B1, 0, 1); PG8_SCHED; PG8_LDA(At, 0, 0); PG8_STAGE(PG8_SA(1, 1), a1, vC[1]);
            PG8_WAIT_V(8); PG8_WAIT_L(0); PG8_BAR; PG8_MMA(0, 0, At, B0); PG8_MMA(0, 1, At, B1); PG8_BAR; PG8_SCHED;
            PG8_LDA(At, 0, 1); PG8_STAGE(PG8_SB(0, 0), b2, voffB); PG8_STAGE(PG8_SB(0, 1), b2 + hstepB, voffB); PG8_STAGE(PG8_SA(0, 0), a2, v2[0]);
            PG8_WAIT_V(8); PG8_WAIT_L(0); PG8_BAR; PG8_MMA(1, 0, At, B0); PG8_MMA(1, 1, At, B1); PG8_BAR; PG8_SCHED;
            PG8_LDB(B0, 1, 0); PG8_LDB(B1, 1, 1); PG8_SCHED; PG8_LDA(At, 1, 0); PG8_STAGE(PG8_SA(0, 1), a2, v2[1]);
            PG8_WAIT_V(8); PG8_WAIT_L(0); PG8_BAR; PG8_MMA(0, 0, At, B0); PG8_MMA(0, 1, At, B1); PG8_BAR; PG8_SCHED;
            PG8_LDA(At, 1, 1); PG8_STAGE(PG8_SB(1, 0), b3, voffB); PG8_STAGE(PG8_SB(1, 1), b3 + hstepB, voffB); PG8_STAGE(PG8_SA(1, 0), a3, v2[0]);
            PG8_WAIT_V(8); PG8_WAIT_L(0); PG8_BAR; PG8_MMA(1, 0, At, B0); PG8_MMA(1, 1, At, B1); PG8_BAR; PG8_SCHED;
        }
        if (wr == 0) PG8_BAR;
        { int fr_e = fr, fq_e = fq; asm volatile("" : "+v"(fr_e), "+v"(fq_e));
          E(acc, cur, wr, wc, fr_e, fq_e); }
        if (!has_next) break;
#pragma unroll
        for (int a = 0; a < 2; ++a)
#pragma unroll
            for (int b = 0; b < 2; ++b)
#pragma unroll
                for (int m = 0; m < 4; ++m)
#pragma unroll
                    for (int n = 0; n < 2; ++n) acc[a][b][m][n] = (f32x4){0.f, 0.f, 0.f, 0.f};
        cur = nxt; cA = nA; cB = nB; ++ui;
#pragma unroll
        for (int h = 0; h < 2; ++h) { vC[h][0] = vN[h][0]; vC[h][1] = vN[h][1]; }
        if (wr == 1) PG8_BAR;
    }
    PG8_WAIT_V(0);
    PG8_BAR;
#undef PG8_SA
#undef PG8_SB
#undef PG8_STAGE
#undef PG8_LDA
#undef PG8_LDB
#undef PG8_MMA
#undef PG8_WAIT_V
#undef PG8_WAIT_L
#undef PG8_BAR
#undef PG8_SCHED
}
}

#define XB_TMO      128
#define XB_XCNT(j)  (256  + 64 * (j))
#define XB_XSUB(j)  (1280 + 64 * (j))
#define XB_XGEN(j)  (2304 + 64 * (j))
#define XB_TOP      3328
#define XB_TOPGEN   3392
#define XCD_BAR_WORDS 3456
#define XB_SPIN_CAP (1u << 18)
__device__ __forceinline__ unsigned xb_ld(unsigned* p)              { return __hip_atomic_load(p, __ATOMIC_RELAXED, __HIP_MEMORY_SCOPE_AGENT); }
__device__ __forceinline__ unsigned xb_add(unsigned* p, unsigned v) { return __hip_atomic_fetch_add(p, v, __ATOMIC_RELAXED, __HIP_MEMORY_SCOPE_AGENT); }
__device__ __forceinline__ unsigned xb_xcc_id() { return (unsigned)__builtin_amdgcn_s_getreg((3 << 11) | 20) & 0xFu; }
#define XB_SPIN(cond, bar) do { unsigned _sp = 0; while (cond) { __builtin_amdgcn_s_sleep(1); \
    if ((++_sp & 255u) == 0u) { if (xb_ld(&(bar)[XB_TMO])) break; if (_sp > XB_SPIN_CAP) { atomicAdd(&(bar)[XB_TMO], 1u); break; } } } } while (0)
struct XcdBarrier { unsigned* bar; unsigned x; volatile LAS unsigned* st; };
__device__ __forceinline__ XcdBarrier xcd_barrier_post(unsigned* bar, volatile LAS unsigned* st) {
    XcdBarrier b; b.bar = bar; b.x = xb_xcc_id(); b.st = st;
    if (threadIdx.x == 0) (void)xb_add(&bar[XB_XCNT(b.x)], 1u);
    return b;
}
__device__ __forceinline__ void xcd_barrier_complete(unsigned* bar, unsigned x, unsigned& nloc, unsigned& nx) {
    const unsigned G = gridDim.x * gridDim.y * gridDim.z;
    unsigned sum, cnt, mine, sp = 0u;
    for (;;) {
        sum = 0u; cnt = 0u; mine = 0u;
#pragma unroll
        for (unsigned j = 0; j < 16; ++j) { const unsigned c = xb_ld(&bar[XB_XCNT(j)]); sum += c; cnt += (c > 0u) ? 1u : 0u; mine = (j == x) ? c : mine; }
        if (sum == G) break;
        __builtin_amdgcn_s_sleep(1);
        if ((++sp & 255u) == 0u) { if (xb_ld(&bar[XB_TMO])) break; if (sp > XB_SPIN_CAP) { atomicAdd(&bar[XB_TMO], 1u); break; } }
    }
    nloc = mine > 0u ? mine : 1u; nx = cnt > 0u ? cnt : 1u;
}
__device__ __forceinline__ void xcd_barrier(const XcdBarrier& b) {
    asm volatile("s_waitcnt vmcnt(0)" ::: "memory");
    __syncthreads();
    if (threadIdx.x == 0) {
        unsigned* bar = b.bar;
        __builtin_amdgcn_s_waitcnt(0);
        unsigned nloc = b.st[0], nx = b.st[1];
        if (nloc == 0u) { xcd_barrier_complete(bar, b.x, nloc, nx); b.st[0] = nloc; b.st[1] = nx; }
        const unsigned old = xb_add(&bar[XB_XSUB(b.x)], 1u);
        const unsigned gen = old / nloc;
        if (old + 1u == (gen + 1u) * nloc) {
            __builtin_amdgcn_fence(__ATOMIC_RELEASE, "agent");
            asm volatile("s_waitcnt vmcnt(0)" ::: "memory");
            const unsigned og = xb_add(&bar[XB_TOP], 1u);
            const unsigned tg = og / nx;
            if (og + 1u == (tg + 1u) * nx) xb_add(&bar[XB_TOPGEN], 1u);
            else XB_SPIN(xb_ld(&bar[XB_TOPGEN]) == tg, bar);
            __builtin_amdgcn_fence(__ATOMIC_ACQUIRE, "agent");
            xb_add(&bar[XB_XGEN(b.x)], 1u);
            asm volatile("s_waitcnt vmcnt(0)" ::: "memory");
        } else {
            XB_SPIN(xb_ld(&bar[XB_XGEN(b.x)]) == gen, bar);
            __builtin_amdgcn_fence(__ATOMIC_ACQUIRE, "agent");
            asm volatile("s_waitcnt vmcnt(0)" ::: "memory");
        }
    }
    __syncthreads();
}

struct Args { const void* in[23]; float* out; unsigned char* ws; };
struct Frame {
    LAS unsigned char* lds;
    volatile LAS unsigned* MISC;
    gu32* ctl;
    int tid, lane, wave, vcu, G;
    unsigned char* ws;
    __device__ __forceinline__ void refresh() { lane = fresh_lane(); tid = wave * 64 + lane; }
};

__device__ __forceinline__ int srcmap(int kind, int r) {
    if (kind == 0) { if (r < 256) return 384 + r; if (r < 640) return r - 256; if (r < 672) { const int j = r - 640; return 640 + (j & 1) * 16 + (j >> 1); } if (r < 768) return -1; return r - 96; }
    if (kind == 1) { const int h = r / 96, d = r - h * 96; if (d < 64) return r; const int j = d - 64; return h * 96 + 64 + (j & 1) * 16 + (j >> 1); }
    if (kind == 3) { const int pn = r >> 8, j = r & 255; return j < 128 ? pn * 128 + j : 1024 + pn * 128 + (j - 128); }
    return r;
}
__device__ __forceinline__ void transpose_item(const float* W, int Nsrc, int Kd, bf16_t* WT, int kind, const float* kscale, int ndest, LAS float* scr, int item, int lane) {
    const int nblk = ndest >> 6, kb = item / nblk, nb = item - kb * nblk, k0 = 64 * kb, r0 = 64 * nb;
    const int n4 = lane & 15, kq = lane >> 4;
    const int s0 = srcmap(kind, r0 + 4 * n4), s1 = srcmap(kind, r0 + 4 * n4 + 1), s2 = srcmap(kind, r0 + 4 * n4 + 2), s3 = srcmap(kind, r0 + 4 * n4 + 3);
    const bool fast = (s0 >= 0) && ((s0 & 3) == 0) && (s1 == s0 + 1) && (s2 == s0 + 2) && (s3 == s0 + 3);
    if (fast) {
        f32x4 v[16];
#pragma unroll
        for (int i = 0; i < 16; ++i) v[i] = *(const GAS f32x4*)(W + (size_t)(k0 + kq + 4 * i) * Nsrc + s0);
#pragma unroll
        for (int i = 0; i < 16; ++i) { const int kk = kq + 4 * i; const float sc = kscale ? kscale[k0 + kk] : 1.f; LAS float* d = scr + kk * 65 + 4 * n4;
            d[0] = v[i].x * sc; d[1] = v[i].y * sc; d[2] = v[i].z * sc; d[3] = v[i].w * sc; }
    } else {
        for (int i = 0; i < 16; ++i) { const int kk = kq + 4 * i; const float sc = kscale ? kscale[k0 + kk] : 1.f; const float* wr_ = W + (size_t)(k0 + kk) * Nsrc; LAS float* d = scr + kk * 65 + 4 * n4;
            d[0] = s0 >= 0 ? wr_[s0] * sc : 0.f; d[1] = s1 >= 0 ? wr_[s1] * sc : 0.f; d[2] = s2 >= 0 ? wr_[s2] * sc : 0.f; d[3] = s3 >= 0 ? wr_[s3] * sc : 0.f; }
    }
    LDS_WAIT(); asm volatile("" ::: "memory");
    const int c = lane & 7;
#pragma unroll
    for (int j = 0; j < 8; ++j) { const int n = (lane >> 3) + 8 * j; const LAS float* s = scr + (8 * c) * 65 + n;
        u32x4 o; o.x = pk2(s[0 * 65], s[1 * 65]); o.y = pk2(s[2 * 65], s[3 * 65]); o.z = pk2(s[4 * 65], s[5 * 65]); o.w = pk2(s[6 * 65], s[7 * 65]);
        *(GAS u32x4*)(WT + (size_t)(r0 + n) * Kd + k0 + 8 * c) = o; }
    LDS_WAIT(); asm volatile("" ::: "memory");
}
__device__ __forceinline__ void ln_row_to_bf16(const float* xrow, const float* g, const float* b, bf16_t* orow, int lane, float eps) {
    const GAS f32x4* xr = (const GAS f32x4*)xrow + lane;
    f32x4 v[4]; float s = 0.f;
#pragma unroll
    for (int j = 0; j < 4; ++j) { v[j] = xr[64 * j]; s += (v[j].x + v[j].y) + (v[j].z + v[j].w); }
    const float mean = wave_sum(s) * (1.f / D); float s2 = 0.f;
#pragma unroll
    for (int j = 0; j < 4; ++j) { v[j] = v[j] - mean; s2 += (v[j].x * v[j].x + v[j].y * v[j].y) + (v[j].z * v[j].z + v[j].w * v[j].w); }
    const float rstd = 1.f / sqrtf(wave_sum(s2) * (1.f / D) + eps);
    GAS unsigned long long* o8 = (GAS unsigned long long*)orow + lane;
#pragma unroll
    for (int j = 0; j < 4; ++j) { const f32x4 gg = *((const GAS f32x4*)g + lane + 64 * j), bb = *((const GAS f32x4*)b + lane + 64 * j);
        const f32x4 o = v[j] * rstd * gg + bb;
        o8[64 * j] = (unsigned long long)pk2(o.x, o.y) | ((unsigned long long)pk2(o.z, o.w) << 32); }
}
__device__ __forceinline__ void p0_prologue(Frame& F, const Args& a) {
    F.refresh();
    LAS float* scr = (LAS float*)(F.lds + F.wave * 16640);
    const int gw = F.vcu * 8 + F.wave, NGW = F.G * 8;
    const float* w_in = (const float*)a.in[4]; const float* qg = (const float*)a.in[5]; const float* w_qb = (const float*)a.in[6];
    const float* kvg = (const float*)a.in[7]; const float* w_kvb = (const float*)a.in[8]; const float* w_o = (const float*)a.in[12];
    const float* w_up = (const float*)a.in[17]; const float* w_dn = (const float*)a.in[19];
    bf16_t* WinT = (bf16_t*)(F.ws + WS_WIN); bf16_t* WqbT = (bf16_t*)(F.ws + WS_WQB); bf16_t* WkvbT = (bf16_t*)(F.ws + WS_WKVB); bf16_t* WoT = (bf16_t*)(F.ws + WS_WO);
    bf16_t* WupT = (bf16_t*)(F.ws + WS_WUP); bf16_t* WdnT = (bf16_t*)(F.ws + WS_WDN);
    constexpr int I_IN = 16 * 44, I_QB = 6 * 12, I_KVB = 4 * 16, I_O = 16 * 16, I_UP1 = 16 * 32, I_DN1 = 16 * 16;
#if DBG_STAGE == 1
    constexpr int NITEMS = I_IN + I_QB + I_KVB + I_O;
#else
    constexpr int NITEMS = I_IN + I_QB + I_KVB + I_O + NE * I_UP1 + NE * I_DN1;
#endif
    for (int it = gw; it < NITEMS; it += NGW) {
        int r = it;
        if (r < I_IN) { transpose_item(w_in, IN_COLS, D, WinT, 0, nullptr, NPROJ, scr, r, F.lane); continue; } r -= I_IN;
        if (r < I_QB) { transpose_item(w_qb, 768, QL, WqbT, 1, qg, 768, scr, r, F.lane); continue; } r -= I_QB;
        if (r < I_KVB) { transpose_item(w_kvb, 1024, KVL, WkvbT, 2, kvg, 1024, scr, r, F.lane); continue; } r -= I_KVB;
        if (r < I_O) { transpose_item(w_o, 1024, 1024, WoT, 2, nullptr, 1024, scr, r, F.lane); continue; } r -= I_O;
        if (r < NE * I_UP1) { const int e = r / I_UP1; transpose_item(w_up + (size_t)e * D * 2048, 2048, D, WupT + (size_t)e * 2048 * D, 3, nullptr, 2048, scr, r - e * I_UP1, F.lane); continue; } r -= NE * I_UP1;
        { const int e = r / I_DN1; transpose_item(w_dn + (size_t)e * DE * D, D, DE, WdnT + (size_t)e * D * DE, 2, nullptr, D, scr, r - e * I_DN1, F.lane); }
    }
    const float* x = (const float*)a.in[0]; const float* g = (const float*)a.in[2]; const float* b = (const float*)a.in[3];
    bf16_t* H0 = (bf16_t*)(F.ws + WS_H0);
    for (int m = gw; m < T; m += NGW) ln_row_to_bf16(x + (size_t)m * D, g, b, H0 + (size_t)m * D, F.lane, LN_EPS);
    const int* pos = (const int*)a.in[1]; float* cs = (float*)(F.ws + WS_COS); float* sn = (float*)(F.ws + WS_SIN);
    for (int i = F.vcu * 512 + F.tid; i < T * 16; i += F.G * 512) {
        const int t = i >> 4, j = i & 15;
        const float inv = powf(10000.0f, -(float)(2 * j) / 32.0f);
        const float ang = (float)pos[t] * inv;
        double rev = (double)ang * 0.15915494309189535; rev -= floor(rev);
        const float rf = (float)rev;
        cs[i] = __builtin_amdgcn_cosf(rf); sn[i] = __builtin_amdgcn_sinf(rf);
    }
    { const float* wr_ = (const float*)a.in[15]; bf16_t* wh = (bf16_t*)(F.ws + WS_WRH); bf16_t* wl = (bf16_t*)(F.ws + WS_WRL);
      for (int i = F.vcu * 512 + F.tid; i < 32 * 1024; i += F.G * 512) { const int e = i >> 10, k = i & 1023; const float w = wr_[(size_t)k * 32 + e];
          const unsigned h = f2bf(w); wh[i] = (bf16_t)h; wl[i] = (bf16_t)f2bf(w - __builtin_bit_cast(float, h << 16)); } }
    if (F.vcu == 0) { const float* lbl = (const float*)a.in[9]; float* lb = (float*)(F.ws + WS_LB);
        for (int c = F.tid; c < 512; c += 512) lb[c] = 1.f / (1.f + expf(lbl[512 + c] - lbl[c])); }
}

struct EpiProj {
    static constexpr bool PERM = true;
    bf16_t* P; const float* cs; const float* sn; const float* lb;
    __device__ __forceinline__ void operator()(const f32x4 (&acc)[2][2][4][2], const pg8::Unit& u, int wr, int wc, int fr, int fq) const {
#pragma unroll
        for (int bj = 0; bj < 2; ++bj) {
            const int cb = u.pn * 256 + bj * 128 + wc * 32, c0 = cb + 8 * fq;
            const int kind = cb < PC_KR ? 0 : cb == PC_KR ? 1 : cb < PC_HQ ? 0 : cb < PC_HF ? 2 : cb < PC_HI ? 3 : cb < PC_HG ? 0 : 2;
            float lbv[8];
            if (kind == 3) {
#pragma unroll
                for (int j = 0; j < 8; ++j) lbv[j] = lb[c0 - PC_HF + j];
            }
#pragma unroll
            for (int ai = 0; ai < 2; ++ai)
#pragma unroll
                for (int m = 0; m < 4; ++m) {
                    const int row = u.pm * 256 + ai * 128 + wr * 64 + m * 16 + fr;
                    float v[8];
#pragma unroll
                    for (int j = 0; j < 4; ++j) { v[j] = acc[ai][bj][m][0][j]; v[4 + j] = acc[ai][bj][m][1][j]; }
                    if (kind == 1) {
                        const f32x4 cc = *(const f32x4*)(cs + (size_t)row * 16 + 4 * fq), ss = *(const f32x4*)(sn + (size_t)row * 16 + 4 * fq);
#pragma unroll
                        for (int p = 0; p < 4; ++p) { const float x1 = v[2 * p], x2 = v[2 * p + 1]; v[2 * p] = x1 * cc[p] - x2 * ss[p]; v[2 * p + 1] = x1 * ss[p] + x2 * cc[p]; }
                    } else if (kind == 2) {
#pragma unroll
                        for (int j = 0; j < 8; ++j) v[j] = silu_f(v[j]);
                    } else if (kind == 3) {
#pragma unroll
                        for (int j = 0; j < 8; ++j) { const float s = __builtin_amdgcn_rcpf(1.f + __expf(-v[j])); v[j] = __logf(lbv[j] + (1.f - lbv[j]) * s); }
                    }
                    u32x4 w; w.x = pk2(v[0], v[1]); w.y = pk2(v[2], v[3]); w.z = pk2(v[4], v[5]); w.w = pk2(v[6], v[7]);
                    *(u32x4*)(P + (size_t)row * NPROJ + c0) = w;
                }
        }
    }
};

constexpr float QSCALE = 0.10206207261596577f * 1.4426950408889634f;
__device__ __forceinline__ void rs_table(const bf16_t* P, int pm, int c0, int ncols, LAS float* tab, int tid) {
    const int r = tid >> 1, half = tid & 1, nh = ncols >> 1;
    const bf16_t* p = P + (size_t)(pm * 256 + r) * NPROJ + c0 + half * nh;
    float s = 0.f;
    for (int k = 0; k < nh; k += 8) { const u32x4 w = *(const GAS u32x4*)(p + k);
#pragma unroll
        for (int j = 0; j < 4; ++j) { const float a = __builtin_bit_cast(float, w[j] << 16), b = __builtin_bit_cast(float, w[j] & 0xffff0000u); s += a * a + b * b; } }
    s += __shfl_xor(s, 1);
    if (half == 0) tab[r] = 1.f / sqrtf(s / (float)ncols + RMS_EPS);
}
struct EpiQ {
    static constexpr bool PERM = true;
    bf16_t* Q; const float* cs; const float* sn; const LAS float* rs;
    __device__ __forceinline__ void operator()(const f32x4 (&acc)[2][2][4][2], const pg8::Unit& u, int wr, int wc, int fr, int fq) const {
#pragma unroll
        for (int bj = 0; bj < 2; ++bj) {
            const int c0 = u.pn * 256 + bj * 128 + wc * 32 + 8 * fq;
            const int hh = c0 / 96, d0 = c0 - hh * 96;
#pragma unroll
            for (int ai = 0; ai < 2; ++ai)
#pragma unroll
                for (int m = 0; m < 4; ++m) {
                    const int rl = ai * 128 + wr * 64 + m * 16 + fr, row = u.pm * 256 + rl;
                    const float sc = rs[rl] * QSCALE;
                    float v[8];
#pragma unroll
                    for (int j = 0; j < 4; ++j) { v[j] = acc[ai][bj][m][0][j] * sc; v[4 + j] = acc[ai][bj][m][1][j] * sc; }
                    if (d0 >= 64) {
                        const int i0 = (d0 - 64) >> 1;
                        const f32x4 cc = *(const f32x4*)(cs + (size_t)row * 16 + i0), ss = *(const f32x4*)(sn + (size_t)row * 16 + i0);
#pragma unroll
                        for (int p = 0; p < 4; ++p) { const float x1 = v[2 * p], x2 = v[2 * p + 1]; v[2 * p] = x1 * cc[p] - x2 * ss[p]; v[2 * p + 1] = x1 * ss[p] + x2 * cc[p]; }
                    }
                    u32x4 w; w.x = pk2(v[0], v[1]); w.y = pk2(v[2], v[3]); w.z = pk2(v[4], v[5]); w.w = pk2(v[6], v[7]);
                    *(u32x4*)(Q + (size_t)row * 768 + c0) = w;
                }
        }
    }
};
struct EpiKV {
    static constexpr bool PERM = true;
    bf16_t* KV; const LAS float* rs;
    __device__ __forceinline__ void operator()(const f32x4 (&acc)[2][2][4][2], const pg8::Unit& u, int wr, int wc, int fr, int fq) const {
#pragma unroll
        for (int bj = 0; bj < 2; ++bj) {
            const int c0 = u.pn * 256 + bj * 128 + wc * 32 + 8 * fq;
#pragma unroll
            for (int ai = 0; ai < 2; ++ai)
#pragma unroll
                for (int m = 0; m < 4; ++m) {
                    const int rl = ai * 128 + wr * 64 + m * 16 + fr, row = u.pm * 256 + rl;
                    const float sc = rs[rl];
                    u32x4 w; w.x = pk2(acc[ai][bj][m][0][0] * sc, acc[ai][bj][m][0][1] * sc); w.y = pk2(acc[ai][bj][m][0][2] * sc, acc[ai][bj][m][0][3] * sc);
                    w.z = pk2(acc[ai][bj][m][1][0] * sc, acc[ai][bj][m][1][1] * sc); w.w = pk2(acc[ai][bj][m][1][2] * sc, acc[ai][bj][m][1][3] * sc);
                    *(u32x4*)(KV + (size_t)row * 1024 + c0) = w;
                }
        }
    }
};

namespace att {
typedef float f32x16 __attribute__((ext_vector_type(16)));
typedef short s16x4 __attribute__((ext_vector_type(4)));
constexpr int KSLOT = 12288, VSLOT = 8192, BUFB = KSLOT + VSLOT;
constexpr int LDS_WS = 2 * BUFB, LDS_OST = LDS_WS + 2048, LDS_END = LDS_OST + 8 * 4096;
__device__ __forceinline__ int crow(int r, int hi) { return (r & 3) + 8 * (r >> 2) + 4 * hi; }
__device__ __forceinline__ unsigned cvtpk(float lo, float hi) { unsigned r; asm volatile("v_cvt_pk_bf16_f32 %0, %1, %2" : "=v"(r) : "v"(lo), "v"(hi)); return r; }
__device__ __forceinline__ void pv(f32x16* o, int vb, bf16x8 pa0, bf16x8 pa1, bf16x8 pa2, bf16x8 pa3) {
#pragma unroll
    for (int d0 = 0; d0 < 2; ++d0) { s16x4 lo[4], hi[4];
        asm volatile("ds_read_b64_tr_b16 %0,%8 offset:%c9\n\tds_read_b64_tr_b16 %1,%8 offset:%c10\n\tds_read_b64_tr_b16 %2,%8 offset:%c11\n\tds_read_b64_tr_b16 %3,%8 offset:%c12\n\t"
                     "ds_read_b64_tr_b16 %4,%8 offset:%c13\n\tds_read_b64_tr_b16 %5,%8 offset:%c14\n\tds_read_b64_tr_b16 %6,%8 offset:%c15\n\tds_read_b64_tr_b16 %7,%8 offset:%c16\n\ts_waitcnt lgkmcnt(0)"
                     : "=&v"(lo[0]), "=&v"(hi[0]), "=&v"(lo[1]), "=&v"(hi[1]), "=&v"(lo[2]), "=&v"(hi[2]), "=&v"(lo[3]), "=&v"(hi[3])
                     : "v"(vb), "i"(d0 * 4096), "i"(d0 * 4096 + 512), "i"(d0 * 4096 + 1024), "i"(d0 * 4096 + 1536), "i"(d0 * 4096 + 2048), "i"(d0 * 4096 + 2560), "i"(d0 * 4096 + 3072), "i"(d0 * 4096 + 3584) : "memory");
#define PK(k) (bf16x8){lo[k][0], lo[k][1], lo[k][2], lo[k][3], hi[k][0], hi[k][1], hi[k][2], hi[k][3]}
        o[d0] = __builtin_amdgcn_mfma_f32_32x32x16_bf16(pa0, PK(0), o[d0], 0, 0, 0);
        o[d0] = __builtin_amdgcn_mfma_f32_32x32x16_bf16(pa1, PK(1), o[d0], 0, 0, 0);
        o[d0] = __builtin_amdgcn_mfma_f32_32x32x16_bf16(pa2, PK(2), o[d0], 0, 0, 0);
        o[d0] = __builtin_amdgcn_mfma_f32_32x32x16_bf16(pa3, PK(3), o[d0], 0, 0, 0);
#undef PK
    }
}
__device__ __forceinline__ void unit(int b, int h, int qb, const bf16_t* Q, const bf16_t* KV, const bf16_t* PROJ, bf16_t* MIX, float* SSQ, LAS unsigned char* lds, const int wid) {
    const int lane = fresh_lane(), r32 = lane & 31, hi = lane >> 5;
    const size_t rowbase = (size_t)b * SEQ; const int q0 = qb * 256;
    const bf16_t* Qw = Q + (rowbase + q0 + wid * 32) * 768 + h * 96;
    bf16x8 qr[6];
#pragma unroll
    for (int d0 = 0; d0 < 6; ++d0) qr[d0] = *(const GAS bf16x8*)(Qw + (size_t)r32 * 768 + d0 * 16 + hi * 8);
    const int cw = (q0 + 32 * wid) >> 6, NT = 4 * qb + 4;
    LAS float* wsf = (LAS float*)(lds + LDS_WS) + wid * 64;
    const bf16_t* ksrc = KV + (rowbase + lane) * 1024 + h * 128 + wid * 8;
    const bf16_t* rsrc = PROJ + (rowbase + lane) * NPROJ + PC_KR + (wid & 3) * 8;
    const bf16_t* vsrc = KV + (rowbase + 16 * (wid & 3) + (lane >> 2)) * 1024 + h * 128 + 64 + (wid >> 2) * 32 + (lane & 3) * 8;
#define ATT_DMA(t, buf) do { \
        __builtin_amdgcn_global_load_lds((const unsigned*)(ksrc + (size_t)(t) * 64 * 1024), (LAS unsigned*)(lds + (buf) * BUFB + wid * 1024), 16, 0, 0); \
        if (wid < 4) __builtin_amdgcn_global_load_lds((const unsigned*)(rsrc + (size_t)(t) * 64 * NPROJ), (LAS unsigned*)(lds + (buf) * BUFB + (8 + wid) * 1024), 16, 0, 0); \
        __builtin_amdgcn_global_load_lds((const unsigned*)(vsrc + (size_t)(t) * 64 * 1024), (LAS unsigned*)(lds + (buf) * BUFB + KSLOT + wid * 1024), 16, 0, 0); } while (0)
    float m_run = -INFINITY, l_run = 0.f; f32x16 o[2]; o[0] = f32x16{}; o[1] = f32x16{};
    const int vb0 = (int)(unsigned)(size_t)(lds + KSLOT) + ((lane >> 4) & 1) * 32 + (lane & 3) * 8 + (4 * hi + ((lane & 15) >> 2)) * 64;
    asm volatile("s_waitcnt vmcnt(0)" ::: "memory");
    ATT_DMA(0, 0);
    for (int t = 0; t < NT; ++t) {
        const int buf = t & 1;
        if (t + 1 < NT) { ATT_DMA(t + 1, buf ^ 1); if (wid < 4) asm volatile("s_waitcnt vmcnt(3)" ::: "memory"); else asm volatile("s_waitcnt vmcnt(2)" ::: "memory"); }
        else asm volatile("s_waitcnt vmcnt(0)" ::: "memory");
        __builtin_amdgcn_s_barrier(); asm volatile("" ::: "memory");
        if (t <= cw) {
            f32x16 p0 = f32x16{}, p1 = f32x16{};
            const LAS unsigned char* kb = lds + buf * BUFB + hi * 1024 + r32 * 16;
#pragma unroll
            for (int d0 = 0; d0 < 6; ++d0) {
                const bf16x8 b0 = *(const LAS bf16x8*)(kb + d0 * 2048), b1 = *(const LAS bf16x8*)(kb + d0 * 2048 + 512);
                p0 = __builtin_amdgcn_mfma_f32_32x32x16_bf16(b0, qr[d0], p0, 0, 0, 0); p1 = __builtin_amdgcn_mfma_f32_32x32x16_bf16(b1, qr[d0], p1, 0, 0, 0); }
            float rm = p0[0];
#pragma unroll
            for (int r = 1; r < 16; ++r) rm = fmaxf(rm, p0[r]);
#pragma unroll
            for (int r = 0; r < 16; ++r) rm = fmaxf(rm, p1[r]);
            { auto rr = __builtin_amdgcn_permlane32_swap(__float_as_uint(rm), __float_as_uint(rm), false, false); rm = fmaxf(__uint_as_float(rr[0]), __uint_as_float(rr[1])); }
            const float m_new = fmaxf(m_run, rm), sc = __builtin_amdgcn_exp2f(m_run - m_new); m_run = m_new;
            float ls = 0.f;
#pragma unroll
            for (int r = 0; r < 16; ++r) { p0[r] = __builtin_amdgcn_exp2f(p0[r] - m_new); p1[r] = __builtin_amdgcn_exp2f(p1[r] - m_new); ls += p0[r] + p1[r]; }
            l_run = l_run * sc + ls;
            if (hi == 0) wsf[r32] = sc;
            asm volatile("s_waitcnt lgkmcnt(0)" ::: "memory");
#pragma unroll
            for (int r = 0; r < 16; ++r) { const float f = wsf[crow(r, hi)]; o[0][r] *= f; o[1][r] *= f; }
            u32x4 pw0, pw1, pw2, pw3;
            pw0 = (u32x4){cvtpk(p0[0], p0[1]), cvtpk(p0[2], p0[3]), cvtpk(p0[4], p0[5]), cvtpk(p0[6], p0[7])};
            pw1 = (u32x4){cvtpk(p0[8], p0[9]), cvtpk(p0[10], p0[11]), cvtpk(p0[12], p0[13]), cvtpk(p0[14], p0[15])};
            pw2 = (u32x4){cvtpk(p1[0], p1[1]), cvtpk(p1[2], p1[3]), cvtpk(p1[4], p1[5]), cvtpk(p1[6], p1[7])};
            pw3 = (u32x4){cvtpk(p1[8], p1[9]), cvtpk(p1[10], p1[11]), cvtpk(p1[12], p1[13]), cvtpk(p1[14], p1[15])};
            pv(o, vb0 + buf * BUFB, __builtin_bit_cast(bf16x8, pw0), __builtin_bit_cast(bf16x8, pw1), __builtin_bit_cast(bf16x8, pw2), __builtin_bit_cast(bf16x8, pw3));
        }
        asm volatile("s_waitcnt lgkmcnt(0)" ::: "memory"); __builtin_amdgcn_s_barrier(); asm volatile("" ::: "memory");
    }
#undef ATT_DMA
    { auto rr = __builtin_amdgcn_permlane32_swap(__float_as_uint(l_run), __float_as_uint(l_run), false, false); l_run = __uint_as_float(rr[0]) + __uint_as_float(rr[1]); }
    if (hi == 0) wsf[32 + r32] = l_run;
    asm volatile("s_waitcnt lgkmcnt(0)" ::: "memory");
    LAS bf16_t* stg = (LAS bf16_t*)(lds + LDS_OST) + wid * 2048;
#pragma unroll
    for (int r = 0; r < 16; ++r) { const int orow = crow(r, hi); const float rl = __builtin_amdgcn_rcpf(wsf[32 + orow]);
        stg[orow * 64 + r32] = (bf16_t)f2bf(o[0][r] * rl); stg[orow * 64 + 32 + r32] = (bf16_t)f2bf(o[1][r] * rl); }
    asm volatile("s_waitcnt lgkmcnt(0)" ::: "memory");
    bf16_t* Ow = MIX + (rowbase + q0 + wid * 32) * 1024 + h * 64;
#pragma unroll
    for (int i = 0; i < 4; ++i) { const int row = i * 8 + (lane >> 3), ch = lane & 7; const u32x4 v = *(const LAS u32x4*)(stg + row * 64 + ch * 8);
        *(GAS u32x4*)(Ow + (size_t)row * 1024 + ch * 8) = v;
        float s = 0.f;
#pragma unroll
        for (int j = 0; j < 4; ++j) { const float a = __builtin_bit_cast(float, v[j] << 16), bb = __builtin_bit_cast(float, v[j] & 0xffff0000u); s += a * a + bb * bb; }
        s += __shfl_xor(s, 1); s += __shfl_xor(s, 2); s += __shfl_xor(s, 4);
        if (ch == 0) SSQ[(rowbase + q0 + wid * 32 + row) * 8 + h] = s; }
    asm volatile("s_waitcnt lgkmcnt(0)" ::: "memory"); __builtin_amdgcn_s_barrier(); asm volatile("" ::: "memory");
}
}

__device__ __forceinline__ void attn_normalise(Frame& F, const float* g) {
    F.refresh();
    bf16_t* MIX = (bf16_t*)(F.ws + WS_MIX); const float* SSQ = (const float*)(F.ws + WS_SSQ);
    const int gw = F.vcu * 8 + F.wave, NGW = F.G * 8;
    f32x4 g0 = *((const GAS f32x4*)g + 2 * F.lane), g1 = *((const GAS f32x4*)g + 2 * F.lane + 1);
    for (int m = gw; m < T; m += NGW) {
        const f32x4 s0 = *(const GAS f32x4*)(SSQ + (size_t)m * 8), s1 = *(const GAS f32x4*)(SSQ + (size_t)m * 8 + 4);
        const float tot = ((s0.x + s0.y) + (s0.z + s0.w)) + ((s1.x + s1.y) + (s1.z + s1.w));
        const float rs = 1.f / sqrtf(tot * (1.f / 512.f) + RMS_EPS);
        GAS u32x4* p = (GAS u32x4*)(MIX + (size_t)m * 1024) + F.lane;
        const u32x4 v = *p; u32x4 w;
        w.x = pk2(__builtin_bit_cast(float, v.x << 16) * rs * g0.x, __builtin_bit_cast(float, v.x & 0xffff0000u) * rs * g0.y);
        w.y = pk2(__builtin_bit_cast(float, v.y << 16) * rs * g0.z, __builtin_bit_cast(float, v.y & 0xffff0000u) * rs * g0.w);
        w.z = pk2(__builtin_bit_cast(float, v.z << 16) * rs * g1.x, __builtin_bit_cast(float, v.z & 0xffff0000u) * rs * g1.y);
        w.w = pk2(__builtin_bit_cast(float, v.w << 16) * rs * g1.z, __builtin_bit_cast(float, v.w & 0xffff0000u) * rs * g1.w);
        *p = w;
    }
}

namespace hg {
typedef float f32x16 __attribute__((ext_vector_type(16)));
typedef short s16x4 __attribute__((ext_vector_type(4)));
constexpr int OFF_QDEC = 0, OFF_QD1 = 16384, OFF_KD0 = 24576, OFF_KD1 = 32768, OFF_V = 49152, OFF_S = 65536, OFF_O = 98304, OFF_TOT = 132096;
constexpr int OPITCH = 132;
__device__ __forceinline__ int crow(int r, int hi) { return (r & 3) + 8 * (r >> 2) + 4 * hi; }
__device__ __forceinline__ bf16x8 trfrag(int base, int off) {
    s16x4 lo, hi;
    asm volatile("ds_read_b64_tr_b16 %0,%2\n\tds_read_b64_tr_b16 %1,%2 offset:512\n\ts_waitcnt lgkmcnt(0)" : "=&v"(lo), "=&v"(hi) : "v"(base + off) : "memory");
    return (bf16x8){lo[0], lo[1], lo[2], lo[3], hi[0], hi[1], hi[2], hi[3]};
}
__device__ __forceinline__ void dma_tl(const bf16_t* src, LAS unsigned char* img, int wid, int lane) {
#pragma unroll
    for (int i = 0; i < 2; ++i) { const int p = wid * 2 + i, cb = p >> 2, tg = p & 3;
        __builtin_amdgcn_global_load_lds((const unsigned*)(src + (size_t)(tg * 16 + (lane >> 2)) * NPROJ + cb * 32 + (lane & 3) * 8), (LAS unsigned*)(img + p * 1024), 16, 0, 0); }
}
__device__ __forceinline__ void cumsum16(const bf16_t* gsrc, int kcol, int seg, float (&g)[16], float (&b)[16], LAS float* tot, float& r1, float& blast) {
#pragma unroll
    for (int i = 0; i < 16; ++i) g[i] = bf2f(gsrc[(size_t)(seg * 16 + i) * NPROJ + kcol]);
    float run = 0.f;
#pragma unroll
    for (int i = 0; i < 16; ++i) { run += g[i]; b[i] = run; }
    tot[seg * 128 + kcol] = run;
    LDS_WAIT(); __syncthreads();
    const float t0 = tot[kcol], t1 = tot[128 + kcol], t2 = tot[256 + kcol], t3 = tot[384 + kcol];
    const float off = seg == 0 ? 0.f : seg == 1 ? t0 : seg == 2 ? t0 + t1 : t0 + t1 + t2;
    r1 = t0 + t1; blast = (t0 + t1) + (t2 + t3);
#pragma unroll
    for (int i = 0; i < 16; ++i) b[i] += off;
}
__device__ __forceinline__ void pass_a(int unit, const bf16_t* PROJ, float* LT, float* DEC, LAS unsigned char* lds, const int wid) {
    const int lane = fresh_lane(), tid = wid * 64 + lane, r32 = lane & 31, hi = lane >> 5;
    const int bh = unit >> 5, n = unit & 31, b_ = bh >> 2, h = bh & 3;
    const size_t tok0 = (size_t)b_ * SEQ + n * 64;
    LAS unsigned char* kimg = lds; LAS unsigned char* vimg = lds + 16384; LAS float* tot = (LAS float*)(lds + OFF_TOT);
    __syncthreads();
    dma_tl(PROJ + tok0 * NPROJ + PC_HI + h * 128, vimg, wid, lane);
    const int kcol = tid & 127, seg = tid >> 7;
    float g[16], b[16], r1, blast;
    cumsum16(PROJ + tok0 * NPROJ + PC_HF + h * 128, kcol, seg, g, b, tot, r1, blast);
#pragma unroll
    for (int i = 0; i < 16; ++i) { const float kd = (1.f - __expf(g[i])) * __expf(blast - b[i]);
        *(LAS bf16_t*)(kimg + ((kcol >> 5) * 4 + seg) * 1024 + i * 64 + (kcol & 31) * 2) = (bf16_t)f2bf(kd); }
    if (seg == 0) DEC[(size_t)unit * 128 + kcol] = __expf(blast);
    asm volatile("s_waitcnt vmcnt(0) lgkmcnt(0)" ::: "memory"); __syncthreads();
    const int lo_ = ((lane >> 4) & 1) * 32 + (lane & 3) * 8 + (4 * hi + ((lane & 15) >> 2)) * 64;
    const int vbase = (int)(unsigned)(size_t)vimg + lo_, kbase = (int)(unsigned)(size_t)kimg + lo_;
    const int vb = wid & 3;
    bf16x8 af[4];
#pragma unroll
    for (int ks = 0; ks < 4; ++ks) af[ks] = trfrag(vbase, vb * 4096 + ks * 1024);
#pragma unroll
    for (int j = 0; j < 2; ++j) { const int kb = (wid >> 2) * 2 + j; f32x16 acc = f32x16{};
#pragma unroll
        for (int ks = 0; ks < 4; ++ks) { const bf16x8 bfr = trfrag(kbase, kb * 4096 + ks * 1024); acc = __builtin_amdgcn_mfma_f32_32x32x16_bf16(af[ks], bfr, acc, 0, 0, 0); }
        float* dst = LT + (size_t)unit * 16384 + kb * 32 + r32;
#pragma unroll
        for (int r = 0; r < 16; ++r) dst[(size_t)(vb * 32 + crow(r, hi)) * 128] = acc[r]; }
}
__device__ __forceinline__ void pass_b(const float* LT, const float* DEC, bf16_t* SST, int gtid, int gthreads) {
    for (int i = gtid; i < 32 * 4096; i += gthreads) {
        const int bh = i >> 12, e4 = i & 4095, k4 = (e4 & 31) * 4;
        f32x4 S = (f32x4){0.f, 0.f, 0.f, 0.f};
#pragma unroll 4
        for (int n = 0; n < 32; ++n) { const size_t u = (size_t)bh * 32 + n;
            u32x2 w; w.x = pk2(S.x, S.y); w.y = pk2(S.z, S.w);
            *(GAS u32x2*)(SST + u * 16384 + (size_t)e4 * 4) = w;
            const f32x4 L = *(const GAS f32x4*)(LT + u * 16384 + (size_t)e4 * 4), Dv = *(const GAS f32x4*)(DEC + u * 128 + k4);
            S = Dv * S + L; }
    }
}
__device__ __forceinline__ void pass_c(int unit, const bf16_t* PROJ, const bf16_t* SST, const float* gout, bf16_t* MIX, LAS unsigned char* lds, const int wid) {
    const int lane = fresh_lane(), tid = wid * 64 + lane, r32 = lane & 31, hi = lane >> 5;
    const int bh = unit >> 5, n = unit & 31, b_ = bh >> 2, h = bh & 3;
    const size_t tok0 = (size_t)b_ * SEQ + n * 64;
    LAS float* tot = (LAS float*)(lds + OFF_TOT);
    __syncthreads();
    dma_tl(PROJ + tok0 * NPROJ + PC_HI + h * 128, lds + OFF_V, wid, lane);
    { const bf16_t* S = SST + (size_t)unit * 16384;
#pragma unroll
        for (int i = 0; i < 4; ++i) { const int p = wid * 4 + i, c = p >> 1, rh = p & 1;
            __builtin_amdgcn_global_load_lds((const unsigned*)(S + (size_t)(rh * 64 + lane) * 128 + c * 8), (LAS unsigned*)(lds + OFF_S + c * 2048 + rh * 1024), 16, 0, 0); } }
    const int kcol = tid & 127, seg = tid >> 7;
    float g[16], b[16], r1, blast;
    cumsum16(PROJ + tok0 * NPROJ + PC_HF + h * 128, kcol, seg, g, b, tot, r1, blast);
    { const bf16_t* qsrc = PROJ + tok0 * NPROJ + PC_HQ + h * 128 + kcol;
      const int cl = (kcol >> 3), ce = (kcol & 7) * 2;
#pragma unroll
      for (int i = 0; i < 16; ++i) { const int t = seg * 16 + i;
        const float q = bf2f(qsrc[(size_t)t * NPROJ]), kk = 1.f - __expf(g[i]);
        *(LAS bf16_t*)(lds + OFF_QDEC + cl * 1024 + t * 16 + ce) = (bf16_t)f2bf(q * __expf(b[i]));
        *(LAS bf16_t*)(lds + OFF_KD1 + cl * 1024 + t * 16 + ce) = (bf16_t)f2bf(kk * __expf(r1 - b[i]));
        if (seg < 2) *(LAS bf16_t*)(lds + OFF_KD0 + cl * 512 + t * 16 + ce) = (bf16_t)f2bf(kk * __expf(-b[i]));
        else *(LAS bf16_t*)(lds + OFF_QD1 + cl * 512 + (t - 32) * 16 + ce) = (bf16_t)f2bf(q * __expf(b[i] - r1)); } }
    asm volatile("s_waitcnt vmcnt(0) lgkmcnt(0)" ::: "memory"); __syncthreads();
    const int I = wid & 1, vb = wid >> 1;
    f32x16 o = f32x16{};
#pragma unroll
    for (int kk = 0; kk < 8; ++kk) {
        const bf16x8 a = *(const LAS bf16x8*)(lds + OFF_QDEC + (2 * kk + hi) * 1024 + (I * 32 + r32) * 16);
        const bf16x8 bb = *(const LAS bf16x8*)(lds + OFF_S + (2 * kk + hi) * 2048 + (vb * 32 + r32) * 16);
        o = __builtin_amdgcn_mfma_f32_32x32x16_bf16(a, bb, o, 0, 0, 0); }
    const int vbase = (int)(unsigned)(size_t)(lds + OFF_V) + ((lane >> 4) & 1) * 32 + (lane & 3) * 8 + (4 * hi + ((lane & 15) >> 2)) * 64;
    for (int J = 0; J <= I; ++J) {
        f32x16 st = f32x16{};
#pragma unroll
        for (int kk = 0; kk < 8; ++kk) {
            const bf16x8 a = (I == 0) ? *(const LAS bf16x8*)(lds + OFF_KD0 + (2 * kk + hi) * 512 + r32 * 16) : *(const LAS bf16x8*)(lds + OFF_KD1 + (2 * kk + hi) * 1024 + (J * 32 + r32) * 16);
            const bf16x8 bq = (I == 0) ? *(const LAS bf16x8*)(lds + OFF_QDEC + (2 * kk + hi) * 1024 + r32 * 16) : *(const LAS bf16x8*)(lds + OFF_QD1 + (2 * kk + hi) * 512 + r32 * 16);
            st = __builtin_amdgcn_mfma_f32_32x32x16_bf16(a, bq, st, 0, 0, 0); }
        if (J == I) {
#pragma unroll
            for (int r = 0; r < 16; ++r) if (crow(r, hi) > r32) st[r] = 0.f; }
        u32x4 pw0, pw1;
        pw0 = (u32x4){pk2(st[0], st[1]), pk2(st[2], st[3]), pk2(st[4], st[5]), pk2(st[6], st[7])};
        pw1 = (u32x4){pk2(st[8], st[9]), pk2(st[10], st[11]), pk2(st[12], st[13]), pk2(st[14], st[15])};
        const bf16x8 v0 = trfrag(vbase, vb * 4096 + (2 * J) * 1024), v1 = trfrag(vbase, vb * 4096 + (2 * J + 1) * 1024);
        o = __builtin_amdgcn_mfma_f32_32x32x16_bf16(__builtin_bit_cast(bf16x8, pw0), v0, o, 0, 0, 0);
        o = __builtin_amdgcn_mfma_f32_32x32x16_bf16(__builtin_bit_cast(bf16x8, pw1), v1, o, 0, 0, 0);
    }
    LAS float* ot = (LAS float*)(lds + OFF_O);
#pragma unroll
    for (int r = 0; r < 16; ++r) ot[(I * 32 + crow(r, hi)) * OPITCH + vb * 32 + r32] = o[r];
    LDS_WAIT(); __syncthreads();
#pragma unroll
    for (int it = 0; it < 2; ++it) { const int task = it * 512 + tid, t = task >> 4, c8 = (task & 15) * 8;
        const f32x4 x0 = *(const LAS f32x4*)(ot + t * OPITCH + c8), x1 = *(const LAS f32x4*)(ot + t * OPITCH + c8 + 4);
        float s = (x0.x * x0.x + x0.y * x0.y) + (x0.z * x0.z + x0.w * x0.w) + (x1.x * x1.x + x1.y * x1.y) + (x1.z * x1.z + x1.w * x1.w);
        s += __shfl_xor(s, 1); s += __shfl_xor(s, 2); s += __shfl_xor(s, 4); s += __shfl_xor(s, 8);
        const float rs = 1.f / sqrtf(s * (1.f / 128.f) + RMS_EPS);
        const f32x4 g0 = *(const GAS f32x4*)(gout + h * 128 + c8), g1 = *(const GAS f32x4*)(gout + h * 128 + c8 + 4);
        const u32x4 gt = *(const GAS u32x4*)(PROJ + (tok0 + t) * NPROJ + PC_HG + h * 128 + c8);
        u32x4 w;
        w.x = pk2(x0.x * rs * g0.x * __builtin_bit_cast(float, gt.x << 16), x0.y * rs * g0.y * __builtin_bit_cast(float, gt.x & 0xffff0000u));
        w.y = pk2(x0.z * rs * g0.z * __builtin_bit_cast(float, gt.y << 16), x0.w * rs * g0.w * __builtin_bit_cast(float, gt.y & 0xffff0000u));
        w.z = pk2(x1.x * rs * g1.x * __builtin_bit_cast(float, gt.z << 16), x1.y * rs * g1.y * __builtin_bit_cast(float, gt.z & 0xffff0000u));
        w.w = pk2(x1.z * rs * g1.z * __builtin_bit_cast(float, gt.w << 16), x1.w * rs * g1.w * __builtin_bit_cast(float, gt.w & 0xffff0000u));
        *(GAS u32x4*)(MIX + (tok0 + t) * 1024 + 512 + h * 128 + c8) = w; }
}
}

struct EpiY {
    static constexpr bool PERM = false;
    float* Y; const bf16_t* H0;
    __device__ __forceinline__ void operator()(const f32x4 (&acc)[2][2][4][2], const pg8::Unit& u, int wr, int wc, int fr, int fq) const {
#pragma unroll
        for (int ai = 0; ai < 2; ++ai)
#pragma unroll
            for (int m = 0; m < 4; ++m) { const size_t row = (size_t)u.pm * 256 + ai * 128 + wr * 64 + m * 16 + fr;
#pragma unroll
                for (int bj = 0; bj < 2; ++bj)
#pragma unroll
                    for (int n = 0; n < 2; ++n) { const int c = u.pn * 256 + bj * 128 + wc * 32 + 16 * n + 4 * fq;
                        const u32x2 hv = *(const u32x2*)(H0 + row * 1024 + c);
                        f32x4 o = acc[ai][bj][m][n];
                        o.x += DN_ALPHA * __builtin_bit_cast(float, hv.x << 16); o.y += DN_ALPHA * __builtin_bit_cast(float, hv.x & 0xffff0000u);
                        o.z += DN_ALPHA * __builtin_bit_cast(float, hv.y << 16); o.w += DN_ALPHA * __builtin_bit_cast(float, hv.y & 0xffff0000u);
                        *(f32x4*)(Y + row * 1024 + c) = o; } }
    }
};

__device__ __forceinline__ void p6_router(Frame& F, const Args& a) {
    F.refresh();
    typedef float f32x16 __attribute__((ext_vector_type(16)));
    const float* Y = (const float*)(F.ws + WS_Y); bf16_t* H1 = (bf16_t*)(F.ws + WS_H1);
    const float* g = (const float*)a.in[13]; const float* bta = (const float*)a.in[14]; const float* br = (const float*)a.in[16];
    constexpr int APITCH = 2064, A_LO = 32 * APITCH;
    LAS unsigned* cnt = (LAS unsigned*)(F.lds + XTRA_OFF + 2048); LAS unsigned* base = cnt + 32;
    LAS int* asg_e = (LAS int*)(cnt + 64); LAS int* asg_r = asg_e + 256; LAS float* asg_g = (LAS float*)(asg_r + 256);
    LAS float* part = (LAS float*)F.lds; LAS float* logit = part + 8 * 1024;
    if (F.tid < 32) cnt[F.tid] = 0u;
    const int e = F.lane & 31, hi = F.lane >> 5, r32 = e, k0 = F.wave * 128;
    bf16x8 Bh[8], Bl[8];
    { const bf16_t* wh = (const bf16_t*)(F.ws + WS_WRH) + (size_t)e * 1024 + k0 + 8 * hi; const bf16_t* wl = (const bf16_t*)(F.ws + WS_WRL) + (size_t)e * 1024 + k0 + 8 * hi;
#pragma unroll
      for (int kk = 0; kk < 8; ++kk) { Bh[kk] = *(const GAS bf16x8*)(wh + 16 * kk); Bl[kk] = *(const GAS bf16x8*)(wl + 16 * kk); } }
    const float be = br[e];
    for (int p = 0; p < 2; ++p) {
        __syncthreads();
#pragma unroll
        for (int r = 0; r < 4; ++r) {
            const int rb = F.wave * 4 + r; const size_t row = (size_t)F.vcu * 64 + p * 32 + rb;
            const GAS f32x4* yr = (const GAS f32x4*)(Y + row * 1024) + F.lane;
            f32x4 v[4]; float s = 0.f;
#pragma unroll
            for (int j = 0; j < 4; ++j) { v[j] = yr[64 * j]; s += (v[j].x + v[j].y) + (v[j].z + v[j].w); }
            const float mean = wave_sum(s) * (1.f / D); float s2 = 0.f;
#pragma unroll
            for (int j = 0; j < 4; ++j) { v[j] = v[j] - mean; s2 += (v[j].x * v[j].x + v[j].y * v[j].y) + (v[j].z * v[j].z + v[j].w * v[j].w); }
            const float rstd = 1.f / sqrtf(wave_sum(s2) * (1.f / D) + LN_EPS);
            GAS unsigned long long* o8 = (GAS unsigned long long*)(H1 + row * 1024) + F.lane;
#pragma unroll
            for (int j = 0; j < 4; ++j) { const f32x4 gg = *((const GAS f32x4*)g + F.lane + 64 * j), bb = *((const GAS f32x4*)bta + F.lane + 64 * j);
                const f32x4 o = v[j] * rstd * gg + bb;
                const unsigned h0 = f2bf(o.x), h1_ = f2bf(o.y), h2 = f2bf(o.z), h3 = f2bf(o.w);
                const unsigned long long hw = (unsigned long long)(h0 | (h1_ << 16)) | ((unsigned long long)(h2 | (h3 << 16)) << 32);
                o8[64 * j] = hw;
                const unsigned l0 = pk2(o.x - __builtin_bit_cast(float, h0 << 16), o.y - __builtin_bit_cast(float, h1_ << 16)), l1 = pk2(o.z - __builtin_bit_cast(float, h2 << 16), o.w - __builtin_bit_cast(float, h3 << 16));
                *(LAS unsigned long long*)(F.lds + rb * APITCH + 8 * (F.lane + 64 * j)) = hw;
                *(LAS unsigned long long*)(F.lds + A_LO + rb * APITCH + 8 * (F.lane + 64 * j)) = (unsigned long long)l0 | ((unsigned long long)l1 << 32); }
        }
        LDS_WAIT(); __syncthreads();
        f32x16 acc = f32x16{};
#pragma unroll
        for (int kk = 0; kk < 8; ++kk) {
            const bf16x8 ah = *(const LAS bf16x8*)(F.lds + r32 * APITCH + (k0 + 16 * kk + 8 * hi) * 2), al = *(const LAS bf16x8*)(F.lds + A_LO + r32 * APITCH + (k0 + 16 * kk + 8 * hi) * 2);
            acc = __builtin_amdgcn_mfma_f32_32x32x16_bf16(ah, Bh[kk], acc, 0, 0, 0);
            acc = __builtin_amdgcn_mfma_f32_32x32x16_bf16(ah, Bl[kk], acc, 0, 0, 0);
            acc = __builtin_amdgcn_mfma_f32_32x32x16_bf16(al, Bh[kk], acc, 0, 0, 0); }
        LDS_WAIT(); __syncthreads();
#pragma unroll
        for (int r = 0; r < 16; ++r) part[F.wave * 1024 + ((r & 3) + 8 * (r >> 2) + 4 * hi) * 32 + r32] = acc[r];
        LDS_WAIT(); __syncthreads();
#pragma unroll
        for (int q = 0; q < 2; ++q) { const int o = q * 512 + F.tid; float s = 0.f;
#pragma unroll
            for (int w = 0; w < 8; ++w) s += part[w * 1024 + o];
            logit[o] = s; }
        LDS_WAIT(); __syncthreads();
#pragma unroll
        for (int r = 0; r < 4; ++r) {
            const int rb = F.wave * 4 + r;
            float val = logit[rb * 32 + e] + be;
            int se[4]; float sl[4];
#pragma unroll
            for (int k = 0; k < 4; ++k) { float bv = val; int bi = e;
#pragma unroll
                for (int o = 1; o < 32; o <<= 1) { const float ov = __shfl_xor(bv, o); const int oi = __shfl_xor(bi, o); if (ov > bv || (ov == bv && oi < bi)) { bv = ov; bi = oi; } }
                se[k] = bi; sl[k] = bv; if (e == bi) val = -INFINITY; }
            const float e1 = __expf(sl[1] - sl[0]), e2 = __expf(sl[2] - sl[0]), e3 = __expf(sl[3] - sl[0]); const float inv = 1.f / (1.f + e1 + e2 + e3);
            const float gk[4] = {inv, e1 * inv, e2 * inv, e3 * inv};
            if (F.lane < 4) { const int k = F.lane; const int ee = k == 0 ? se[0] : k == 1 ? se[1] : k == 2 ? se[2] : se[3]; const float gg = k == 0 ? gk[0] : k == 1 ? gk[1] : k == 2 ? gk[2] : gk[3];
                const unsigned rank = __hip_atomic_fetch_add(&cnt[ee], 1u, __ATOMIC_RELAXED, __HIP_MEMORY_SCOPE_WORKGROUP); const int ai = (p * 32 + rb) * 4 + k;
                asg_e[ai] = ee; asg_r[ai] = (int)rank; asg_g[ai] = gg; }
        }
    }
    LDS_WAIT(); __syncthreads();
    F.refresh();
    if (F.tid < 32) base[F.tid] = __hip_atomic_fetch_add((unsigned*)(F.ctl + CW_CNT) + F.tid, cnt[F.tid], __ATOMIC_RELAXED, __HIP_MEMORY_SCOPE_AGENT);
    __syncthreads();
    if (F.tid < 256) { const int ee = asg_e[F.tid]; const int pos = (int)base[ee] + asg_r[F.tid]; const int tok = F.vcu * 64 + (F.tid >> 2);
        ((int*)(F.ws + WS_LTOK))[(size_t)ee * T + pos] = tok; ((float*)(F.ws + WS_LGATE))[(size_t)ee * T + pos] = asg_g[F.tid];
        ((int*)(F.ws + WS_TSLOT))[(size_t)tok * 4 + (F.tid & 3)] = (ee << 16) | pos; }
}
__device__ __forceinline__ void moe_table(Frame& F) {
    F.refresh();
    LAS int* cnt = (LAS int*)(F.lds + XTRA_OFF + 4096); LAS int* tstart = cnt + 32;
    if (F.tid < 32) cnt[F.tid] = (int)__hip_atomic_load(F.ctl + CW_CNT + F.tid, RLX_AGENT);
    __syncthreads();
    if (F.tid == 0) { int s = 0; for (int e = 0; e < 32; ++e) { tstart[e] = s; s += (cnt[e] + 255) >> 8; } tstart[32] = s; }
    __syncthreads();
}
template <bool GATH>
struct MoeOrder {
    const bf16_t* A; const bf16_t* Bt; int lda, K, npn, G, c; size_t bstride; const LAS int* cnt; const LAS int* tstart; const int* list;
    static constexpr bool GATHER = GATH;
    __device__ __forceinline__ bool next(int i, pg8::Unit& u) const {
        const int L = i * G + c; const int rt = L / npn;
        if (rt >= tstart[32]) return false;
        int e = 0; while (rt >= tstart[e + 1]) ++e;
        u.pm = rt; u.pn = L - rt * npn; u.e = e; return true;
    }
    __device__ __forceinline__ const char* a_base(const pg8::Unit& u) const { return GATH ? (const char*)A : (const char*)A + (size_t)u.pm * 256 * lda * 2; }
    __device__ __forceinline__ const char* b_base(const pg8::Unit& u) const { return (const char*)Bt + ((size_t)u.e * bstride + (size_t)u.pn * 256 * K) * 2; }
    __device__ __forceinline__ void a_offs(const pg8::Unit& u, const int (&R)[2], const int (&C)[2], unsigned (&v)[2][2]) const {
#pragma unroll
        for (int h = 0; h < 2; ++h)
#pragma unroll
            for (int i = 0; i < 2; ++i) {
                if (GATH) { const int slot = (u.pm - tstart[u.e]) * 256 + h * 128 + R[i]; const int tok = slot < cnt[u.e] ? list[(size_t)u.e * T + slot] : 0; v[h][i] = (unsigned)(tok * lda + C[i]) * 2u; }
                else v[h][i] = (unsigned)((h * 128 + R[i]) * lda + C[i]) * 2u; }
    }
};
constexpr float SW_LIMIT = 7.0f, SW_ALPHA = 1.702f;
struct EpiUp {
    static constexpr bool PERM = true;
    bf16_t* ACT; const float* bup;
    __device__ __forceinline__ void operator()(const f32x4 (&acc)[2][2][4][2], const pg8::Unit& u, int wr, int wc, int fr, int fq) const {
        const int c8 = wc * 32 + 8 * fq; const float* bg = bup + (size_t)u.e * 2048 + u.pn * 128 + c8; const float* bl = bg + 1024;
        const f32x4 bg0 = *(const f32x4*)bg, bg1 = *(const f32x4*)(bg + 4), bl0 = *(const f32x4*)bl, bl1 = *(const f32x4*)(bl + 4);
#pragma unroll
        for (int ai = 0; ai < 2; ++ai)
#pragma unroll
            for (int m = 0; m < 4; ++m) { const size_t row = (size_t)u.pm * 256 + ai * 128 + wr * 64 + m * 16 + fr;
                float v[8];
#pragma unroll
                for (int j = 0; j < 8; ++j) { float gl = (j < 4 ? acc[ai][0][m][0][j] + bg0[j] : acc[ai][0][m][1][j - 4] + bg1[j - 4]), li = (j < 4 ? acc[ai][1][m][0][j] + bl0[j] : acc[ai][1][m][1][j - 4] + bl1[j - 4]);
                    gl = fminf(gl, SW_LIMIT); li = fminf(fmaxf(li, -SW_LIMIT), SW_LIMIT);
                    v[j] = gl * __builtin_amdgcn_rcpf(1.f + __expf(-SW_ALPHA * gl)) * (li + 1.f); }
                u32x4 w; w.x = pk2(v[0], v[1]); w.y = pk2(v[2], v[3]); w.z = pk2(v[4], v[5]); w.w = pk2(v[6], v[7]);
                *(u32x4*)(ACT + row * 1024 + u.pn * 128 + c8) = w; }
    }
};
struct EpiDown {
    static constexpr bool PERM = true;
    bf16_t* YS; const float* bdn; const float* lgate; const LAS int* cnt; const LAS int* tstart;
    __device__ __forceinline__ void operator()(const f32x4 (&acc)[2][2][4][2], const pg8::Unit& u, int wr, int wc, int fr, int fq) const {
        const int nvalid = cnt[u.e] - (u.pm - tstart[u.e]) * 256;
#pragma unroll
        for (int ai = 0; ai < 2; ++ai)
#pragma unroll
            for (int m = 0; m < 4; ++m) { const int rl = ai * 128 + wr * 64 + m * 16 + fr; const size_t row = (size_t)u.pm * 256 + rl;
                const float gt = rl < nvalid ? lgate[(size_t)u.e * T + (u.pm - tstart[u.e]) * 256 + rl] : 0.f;
#pragma unroll
                for (int bj = 0; bj < 2; ++bj) { const int c0 = u.pn * 256 + bj * 128 + wc * 32 + 8 * fq; const float* bp = bdn + (size_t)u.e * 1024 + c0;
                    const f32x4 b0 = *(const f32x4*)bp, b1 = *(const f32x4*)(bp + 4);
                    u32x4 w; w.x = pk2((acc[ai][bj][m][0][0] + b0.x) * gt, (acc[ai][bj][m][0][1] + b0.y) * gt); w.y = pk2((acc[ai][bj][m][0][2] + b0.z) * gt, (acc[ai][bj][m][0][3] + b0.w) * gt);
                    w.z = pk2((acc[ai][bj][m][1][0] + b1.x) * gt, (acc[ai][bj][m][1][1] + b1.y) * gt); w.w = pk2((acc[ai][bj][m][1][2] + b1.z) * gt, (acc[ai][bj][m][1][3] + b1.w) * gt);
                    *(u32x4*)(YS + row * 1024 + c0) = w; } }
    }
};
__device__ __forceinline__ void p9_final(Frame& F, const Args& a) {
    F.refresh();
    const LAS int* tstart = (const LAS int*)(F.lds + XTRA_OFF + 4096) + 32;
    const bf16_t* H1 = (const bf16_t*)(F.ws + WS_H1); const bf16_t* YS = (const bf16_t*)(F.ws + WS_YS); const int* ts = (const int*)(F.ws + WS_TSLOT);
    const float* g = (const float*)a.in[21]; const float* bta = (const float*)a.in[22];
    const int gw = F.vcu * 8 + F.wave, NGW = F.G * 8;
    for (int m = gw; m < T; m += NGW) {
        float v[16];
#pragma unroll
        for (int j = 0; j < 2; ++j) { const u32x4 h = *(const GAS u32x4*)(H1 + (size_t)m * 1024 + 512 * j + 8 * F.lane);
#pragma unroll
            for (int q = 0; q < 4; ++q) { v[8 * j + 2 * q] = DN_ALPHA * __builtin_bit_cast(float, h[q] << 16); v[8 * j + 2 * q + 1] = DN_ALPHA * __builtin_bit_cast(float, h[q] & 0xffff0000u); } }
#pragma unroll
        for (int k = 0; k < 4; ++k) { const int sl = ts[(size_t)m * 4 + k]; const size_t row = (size_t)tstart[sl >> 16] * 256 + (sl & 0xffff);
#pragma unroll
            for (int j = 0; j < 2; ++j) { const u32x4 y = *(const GAS u32x4*)(YS + row * 1024 + 512 * j + 8 * F.lane);
#pragma unroll
                for (int q = 0; q < 4; ++q) { v[8 * j + 2 * q] += __builtin_bit_cast(float, y[q] << 16); v[8 * j + 2 * q + 1] += __builtin_bit_cast(float, y[q] & 0xffff0000u); } } }
        float s = 0.f;
#pragma unroll
        for (int i = 0; i < 16; ++i) s += v[i];
        const float mean = wave_sum(s) * (1.f / D); float s2 = 0.f;
#pragma unroll
        for (int i = 0; i < 16; ++i) { v[i] -= mean; s2 += v[i] * v[i]; }
        const float rstd = 1.f / sqrtf(wave_sum(s2) * (1.f / D) + LN_EPS);
#pragma unroll
        for (int j = 0; j < 2; ++j)
#pragma unroll
            for (int q = 0; q < 2; ++q) { const int c = 512 * j + 8 * F.lane + 4 * q; const f32x4 gg = *(const GAS f32x4*)(g + c), bb = *(const GAS f32x4*)(bta + c);
                f32x4 o; o.x = v[8 * j + 4 * q] * rstd * gg.x + bb.x; o.y = v[8 * j + 4 * q + 1] * rstd * gg.y + bb.y; o.z = v[8 * j + 4 * q + 2] * rstd * gg.z + bb.z; o.w = v[8 * j + 4 * q + 3] * rstd * gg.w + bb.w;
                *(GAS f32x4*)(a.out + (size_t)m * 1024 + c) = o; }
    }
}

__device__ __forceinline__ void dbg_fail(Frame& F, int id) { atomicOr((unsigned*)(F.ctl + CW_DBG), 1u << id); }
__device__ __forceinline__ bool close_enough(float got, float want, float atol, float rtol) { const float d = fabsf(got - want); return d <= atol + rtol * fabsf(want); }
__device__ __forceinline__ void dbg_check_proj(Frame& F, const Args& a) {
    F.refresh();
    const int NS = 16;
    if (F.vcu >= NS) return;
    const int row = (F.vcu * 1093 + 7) % T;
    const float* x = (const float*)a.in[0] + (size_t)row * D; const float* g = (const float*)a.in[2]; const float* b = (const float*)a.in[3];
    const float* w_in = (const float*)a.in[4]; const int* pos = (const int*)a.in[1]; const float* lbl = (const float*)a.in[9];
    LAS float* h = (LAS float*)F.lds; LAS float* red = h + 1024;
    float s = 0.f; for (int k = F.tid; k < D; k += 512) s += x[k];
    s = wave_sum(s); if (F.lane == 0) red[F.wave] = s; __syncthreads();
    float mean = 0.f; for (int w = 0; w < 8; ++w) mean += red[w]; mean *= (1.f / D); __syncthreads();
    float q = 0.f; for (int k = F.tid; k < D; k += 512) { const float d = x[k] - mean; q += d * d; }
    q = wave_sum(q); if (F.lane == 0) red[F.wave] = q; __syncthreads();
    float var = 0.f; for (int w = 0; w < 8; ++w) var += red[w]; var *= (1.f / D);
    const float rstd = 1.f / sqrtf(var + LN_EPS);
    const bf16_t* H0 = (const bf16_t*)(F.ws + WS_H0) + (size_t)row * D;
    for (int k = F.tid; k < D; k += 512) { const float hv = (x[k] - mean) * rstd * g[k] + b[k]; h[k] = hv; if (!close_enough(bf2f(H0[k]), hv, 0.02f, 0.01f)) dbg_fail(F, 1); }
    __syncthreads();
    const bf16_t* P = (const bf16_t*)(F.ws + WS_PROJ) + (size_t)row * NPROJ;
    for (int n = F.tid; n < IN_COLS; n += 512) {
        float acc = 0.f; for (int k = 0; k < D; ++k) acc += h[k] * w_in[(size_t)k * IN_COLS + n];
        float want; int c;
        if (n < 384) { c = PC_QA + n; want = acc; }
        else if (n < 640) { c = PC_KVA + (n - 384); want = acc; }
        else if (n < 672) {
            const int j = n - 640, i = j & 15, half = j >> 4; const int n2 = 640 + (1 - half) * 16 + i;
            float acc2 = 0.f; for (int k = 0; k < D; ++k) acc2 += h[k] * w_in[(size_t)k * IN_COLS + n2];
            const float inv = powf(10000.0f, -(float)(2 * i) / 32.0f); const float ang = (float)pos[row] * inv;
            const float cc = cosf(ang), ss = sinf(ang);
            const float x1 = half == 0 ? acc : acc2, x2 = half == 0 ? acc2 : acc;
            want = half == 0 ? x1 * cc - x2 * ss : x1 * ss + x2 * cc; c = PC_KR + 2 * i + half; }
        else if (n < 1184) { c = PC_HQ + (n - 672); want = acc / (1.f + expf(-acc)); }
        else if (n < 1696) { const int cc_ = n - 1184; c = PC_HF + cc_; const float lb = 1.f / (1.f + expf(lbl[512 + cc_] - lbl[cc_])); const float sg = 1.f / (1.f + expf(-acc)); want = logf(lb + (1.f - lb) * sg); }
        else if (n < 2208) { c = PC_HI + (n - 1696); want = acc; }
        else { c = PC_HG + (n - 2208); want = acc / (1.f + expf(-acc)); }
        if (!close_enough(bf2f(P[c]), want, 0.03f, 0.02f)) dbg_fail(F, 2);
    }
    for (int c = 672 + F.tid; c < 768; c += 512) if (bf2f(P[c]) != 0.f) dbg_fail(F, 3);
}
__device__ __forceinline__ void dbg_check_qkv(Frame& F, const Args& a) {
    F.refresh();
    const int NS = 16;
    if (F.vcu >= NS) return;
    const int row = (F.vcu * 2731 + 11) % T;
    const bf16_t* P = (const bf16_t*)(F.ws + WS_PROJ) + (size_t)row * NPROJ;
    const float* qg = (const float*)a.in[5]; const float* w_qb = (const float*)a.in[6]; const float* kvg = (const float*)a.in[7]; const float* w_kvb = (const float*)a.in[8];
    const int* pos = (const int*)a.in[1];
    LAS float* qa = (LAS float*)F.lds; LAS float* kva = qa + 384; LAS float* qraw = kva + 256;
    float sq = 0.f, sk = 0.f;
    for (int k = 0; k < 384; ++k) { const float v = bf2f(P[PC_QA + k]); sq += v * v; }
    for (int k = 0; k < 256; ++k) { const float v = bf2f(P[PC_KVA + k]); sk += v * v; }
    const float rq = 1.f / sqrtf(sq / 384.f + RMS_EPS), rk = 1.f / sqrtf(sk / 256.f + RMS_EPS);
    for (int k = F.tid; k < 384; k += 512) qa[k] = bf2f(P[PC_QA + k]) * rq * qg[k];
    for (int k = F.tid; k < 256; k += 512) kva[k] = bf2f(P[PC_KVA + k]) * rk * kvg[k];
    __syncthreads();
    for (int n = F.tid; n < 768; n += 512) { float acc = 0.f; for (int k = 0; k < 384; ++k) acc += qa[k] * w_qb[(size_t)k * 768 + n]; qraw[n] = acc; }
    __syncthreads();
    const bf16_t* Qb = (const bf16_t*)(F.ws + WS_Q) + (size_t)row * 768;
    for (int n = F.tid; n < 768; n += 512) {
        const int h = n / 96, d = n % 96; float want; int c;
        if (d < 64) { want = qraw[n]; c = n; }
        else { const int j = d - 64, i = j & 15, half = j >> 4; const float x1 = qraw[h * 96 + 64 + i], x2 = qraw[h * 96 + 80 + i];
            const float inv = powf(10000.0f, -(float)(2 * i) / 32.0f); const float ang = (float)pos[row] * inv; const float cc = cosf(ang), ss = sinf(ang);
            want = half == 0 ? x1 * cc - x2 * ss : x1 * ss + x2 * cc; c = h * 96 + 64 + 2 * i + half; }
        want *= QSCALE;
        if (!close_enough(bf2f(Qb[c]), want, 0.006f, 0.02f)) dbg_fail(F, 4);
    }
    const bf16_t* KVb = (const bf16_t*)(F.ws + WS_KV) + (size_t)row * 1024;
    for (int n = F.tid; n < 1024; n += 512) { float acc = 0.f; for (int k = 0; k < 256; ++k) acc += kva[k] * w_kvb[(size_t)k * 1024 + n];
        if (!close_enough(bf2f(KVb[n]), acc, 0.03f, 0.02f)) dbg_fail(F, 5); }
    __syncthreads();
}
__device__ __forceinline__ void dbg_check_attn(Frame& F) {
    F.refresh();
    const int NS = 64;
    if (F.vcu >= NS) return;
    const int t = (F.vcu * 4099 + 5 * F.vcu * F.vcu + 63) % T, h = F.vcu & 7;
    const int b = t / SEQ, tl = t % SEQ, nk = ((tl >> 6) + 1) * 64;
    const bf16_t* Q = (const bf16_t*)(F.ws + WS_Q) + (size_t)t * 768 + h * 96;
    const bf16_t* KV = (const bf16_t*)(F.ws + WS_KV) + (size_t)b * SEQ * 1024 + h * 128;
    const bf16_t* PR = (const bf16_t*)(F.ws + WS_PROJ) + (size_t)b * SEQ * NPROJ + PC_KR;
    LAS float* sc = (LAS float*)F.lds; LAS float* red = sc + 2048; LAS float* ov = red + 16;
    float mx = -INFINITY;
    for (int j = F.tid; j < nk; j += 512) { float s = 0.f;
        for (int d = 0; d < 64; ++d) s += bf2f(Q[d]) * bf2f(KV[(size_t)j * 1024 + d]);
        for (int d = 0; d < 32; ++d) s += bf2f(Q[64 + d]) * bf2f(PR[(size_t)j * NPROJ + d]);
        sc[j] = s; mx = fmaxf(mx, s); }
    for (int o = 1; o < 64; o <<= 1) mx = fmaxf(mx, __shfl_xor(mx, o));
    if (F.lane == 0) red[F.wave] = mx; __syncthreads();
    mx = red[0]; for (int w = 1; w < 8; ++w) mx = fmaxf(mx, red[w]); __syncthreads();
    float sm = 0.f;
    for (int j = F.tid; j < nk; j += 512) { const float p = exp2f(sc[j] - mx); sc[j] = p; sm += p; }
    sm = wave_sum(sm); if (F.lane == 0) red[F.wave] = sm; __syncthreads();
    float tot = 0.f; for (int w = 0; w < 8; ++w) tot += red[w];
    const bf16_t* M = (const bf16_t*)(F.ws + WS_MIX) + (size_t)t * 1024 + h * 64;
    if (F.tid < 64) { float acc = 0.f; for (int j = 0; j < nk; ++j) acc += sc[j] * bf2f(KV[(size_t)j * 1024 + 64 + F.tid]); acc /= tot; ov[F.tid] = acc;
        if (!close_enough(bf2f(M[F.tid]), acc, 0.01f, 0.03f)) dbg_fail(F, 6); }
    __syncthreads();
    if (F.tid == 0) { float s = 0.f; for (int d = 0; d < 64; ++d) s += ov[d] * ov[d]; const float got = ((const float*)(F.ws + WS_SSQ))[(size_t)t * 8 + h];
        if (!close_enough(got, s, 0.002f, 0.05f)) dbg_fail(F, 7); }
    __syncthreads();
}
__device__ __forceinline__ void dbg_check_norm(Frame& F, const float* g) {
    F.refresh();
    if (F.vcu >= 16 || F.tid != 0) return;
    const int t = (F.vcu * 1021 + 3) % T; const bf16_t* M = (const bf16_t*)(F.ws + WS_MIX) + (size_t)t * 1024;
    float s = 0.f; for (int c = 0; c < 512; ++c) { const float v = bf2f(M[c]) / g[c]; s += v * v; }
    if (!close_enough(s / 512.f, 1.f, 0.02f, 0.f)) dbg_fail(F, 8);
}
__device__ __forceinline__ void dbg_check_hgrn(Frame& F, const float* gout) {
    F.refresh();
    if (F.vcu >= 8) return;
    const int sidx = F.vcu * 8 + F.wave;
    const int tl = (sidx * 397 + 61 * (sidx & 7) + 5) % SEQ, b = sidx & 7, h = (sidx >> 3) & 3;
    const bf16_t* P = (const bf16_t*)(F.ws + WS_PROJ) + (size_t)b * SEQ * NPROJ;
    const int k0 = F.lane, k1 = F.lane + 64;
    const float q0 = bf2f(P[(size_t)tl * NPROJ + PC_HQ + h * 128 + k0]), q1 = bf2f(P[(size_t)tl * NPROJ + PC_HQ + h * 128 + k1]);
    float dec0 = 1.f, dec1 = 1.f, o0 = 0.f, o1 = 0.f;
    for (int s = tl; s >= 0; --s) {
        const bf16_t* ps = P + (size_t)s * NPROJ;
        const float g0 = bf2f(ps[PC_HF + h * 128 + k0]), g1 = bf2f(ps[PC_HF + h * 128 + k1]);
        float c = q0 * (1.f - expf(g0)) * dec0 + q1 * (1.f - expf(g1)) * dec1;
        c = wave_sum(c);
        o0 += c * bf2f(ps[PC_HI + h * 128 + k0]); o1 += c * bf2f(ps[PC_HI + h * 128 + k1]);
        dec0 *= expf(g0); dec1 *= expf(g1);
    }
    const float ss = wave_sum(o0 * o0 + o1 * o1), rs = 1.f / sqrtf(ss / 128.f + RMS_EPS);
    const bf16_t* pt = P + (size_t)tl * NPROJ;
    const float w0 = o0 * rs * gout[h * 128 + k0] * bf2f(pt[PC_HG + h * 128 + k0]), w1 = o1 * rs * gout[h * 128 + k1] * bf2f(pt[PC_HG + h * 128 + k1]);
    const bf16_t* M = (const bf16_t*)(F.ws + WS_MIX) + ((size_t)b * SEQ + tl) * 1024 + 512 + h * 128;
    if (!close_enough(bf2f(M[k0]), w0, 0.03f, 0.04f) || !close_enough(bf2f(M[k1]), w1, 0.03f, 0.04f)) dbg_fail(F, 9);
}
__device__ __forceinline__ void dbg_check_router(Frame& F, const Args& a) {
    F.refresh();
    if (F.vcu >= 16) return;
    const int row = (F.vcu * 3079 + 17) % T;
    const float* w_o = (const float*)a.in[12]; const float* g = (const float*)a.in[13]; const float* bta = (const float*)a.in[14]; const float* wr_ = (const float*)a.in[15]; const float* br = (const float*)a.in[16];
    const bf16_t* MIX = (const bf16_t*)(F.ws + WS_MIX) + (size_t)row * 1024; const bf16_t* H0 = (const bf16_t*)(F.ws + WS_H0) + (size_t)row * 1024;
    const float* Y = (const float*)(F.ws + WS_Y) + (size_t)row * 1024; const bf16_t* H1 = (const bf16_t*)(F.ws + WS_H1) + (size_t)row * 1024;
    LAS float* mx = (LAS float*)F.lds; LAS float* h1 = mx + 1024; LAS float* red = h1 + 1024; LAS float* lg = red + 16;
    for (int k = F.tid; k < 1024; k += 512) mx[k] = bf2f(MIX[k]);
    __syncthreads();
    for (int n = F.tid; n < 1024; n += 512) { float acc = 0.f; for (int k = 0; k < 1024; ++k) acc += mx[k] * w_o[(size_t)k * 1024 + n];
        const float want = DN_ALPHA * bf2f(H0[n]) + acc; if (!close_enough(Y[n], want, 0.03f, 0.02f)) dbg_fail(F, 10); }
    float s = 0.f; for (int k = F.tid; k < 1024; k += 512) s += Y[k];
    s = wave_sum(s); if (F.lane == 0) red[F.wave] = s; __syncthreads();
    float mean = 0.f; for (int w = 0; w < 8; ++w) mean += red[w]; mean *= (1.f / D); __syncthreads();
    float q = 0.f; for (int k = F.tid; k < 1024; k += 512) { const float d = Y[k] - mean; q += d * d; }
    q = wave_sum(q); if (F.lane == 0) red[F.wave] = q; __syncthreads();
    float var = 0.f; for (int w = 0; w < 8; ++w) var += red[w]; var *= (1.f / D);
    const float rstd = 1.f / sqrtf(var + LN_EPS);
    for (int k = F.tid; k < 1024; k += 512) { const float hv = (Y[k] - mean) * rstd * g[k] + bta[k]; h1[k] = hv; if (!close_enough(bf2f(H1[k]), hv, 0.02f, 0.01f)) dbg_fail(F, 11); }
    __syncthreads();
    if (F.tid < 32) { float acc = 0.f; for (int k = 0; k < 1024; ++k) acc += h1[k] * wr_[(size_t)k * 32 + F.tid]; lg[F.tid] = acc + br[F.tid]; }
    __syncthreads();
    if (F.tid == 0) {
        const int* ts = (const int*)(F.ws + WS_TSLOT) + (size_t)row * 4; float l[32]; for (int e = 0; e < 32; ++e) l[e] = lg[e];
        int se[4]; float sl[4];
        for (int k = 0; k < 4; ++k) { int bi = 0; for (int e = 1; e < 32; ++e) if (l[e] > l[bi]) bi = e; se[k] = bi; sl[k] = l[bi]; l[bi] = -INFINITY; }
        float den = 0.f; for (int k = 0; k < 4; ++k) den += expf(sl[k] - sl[0]);
        for (int k = 0; k < 4; ++k) { const int e = ts[k] >> 16, pos = ts[k] & 0xffff;
            if (e != se[k] && fabsf(lg[e] - sl[k]) > 1e-4f) dbg_fail(F, 12);
            const float gt = ((const float*)(F.ws + WS_LGATE))[(size_t)e * T + pos];
            if (!close_enough(gt, expf(sl[k] - sl[0]) / den, 1e-3f, 1e-3f)) dbg_fail(F, 12);
            if (((const int*)(F.ws + WS_LTOK))[(size_t)e * T + pos] != row) dbg_fail(F, 13);
            if (pos >= (int)__hip_atomic_load(F.ctl + CW_CNT + e, RLX_AGENT)) dbg_fail(F, 13); }
    }
    __syncthreads();
}
__device__ __forceinline__ void dbg_check_moe(Frame& F, const Args& a) {
    F.refresh();
    if (F.vcu >= 32) return;
    const LAS int* cnt = (const LAS int*)(F.lds + XTRA_OFF + 4096); const LAS int* tstart = cnt + 32;
    const int e = F.vcu; if (cnt[e] == 0) return;
    const int slot = (F.vcu * 997 + 13) % cnt[e];
    const size_t prow = (size_t)tstart[e] * 256 + slot;
    const int tok = ((const int*)(F.ws + WS_LTOK))[(size_t)e * T + slot]; const float gt = ((const float*)(F.ws + WS_LGATE))[(size_t)e * T + slot];
    const float* w_up = (const float*)a.in[17] + (size_t)e * 1024 * 2048; const float* b_up = (const float*)a.in[18] + (size_t)e * 2048;
    const float* w_dn = (const float*)a.in[19] + (size_t)e * 1024 * 1024; const float* b_dn = (const float*)a.in[20] + (size_t)e * 1024;
    const bf16_t* H1 = (const bf16_t*)(F.ws + WS_H1) + (size_t)tok * 1024; const bf16_t* ACT = (const bf16_t*)(F.ws + WS_ACT) + prow * 1024; const bf16_t* YS = (const bf16_t*)(F.ws + WS_YS) + prow * 1024;
    LAS float* hx = (LAS float*)F.lds + 4096; LAS float* ac = hx + 1024;
    __syncthreads();
    for (int k = F.tid; k < 1024; k += 512) { hx[k] = bf2f(H1[k]); ac[k] = bf2f(ACT[k]); }
    __syncthreads();
    for (int j = F.tid; j < 1024; j += 512) { float gl = 0.f, li = 0.f; for (int k = 0; k < 1024; ++k) { gl += hx[k] * w_up[(size_t)k * 2048 + j]; li += hx[k] * w_up[(size_t)k * 2048 + 1024 + j]; }
        gl += b_up[j]; li += b_up[1024 + j]; gl = fminf(gl, 7.f); li = fminf(fmaxf(li, -7.f), 7.f);
        const float want = gl / (1.f + expf(-1.702f * gl)) * (li + 1.f);
        if (!close_enough(ac[j], want, 0.03f, 0.03f)) dbg_fail(F, 14); }
    for (int n = F.tid; n < 1024; n += 512) { float acc = 0.f; for (int j = 0; j < 1024; ++j) acc += ac[j] * w_dn[(size_t)j * 1024 + n];
        const float want = (acc + b_dn[n]) * gt; if (!close_enough(bf2f(YS[n]), want, 0.01f, 0.03f)) dbg_fail(F, 15); }
    __syncthreads();
}
__device__ __forceinline__ void dbg_check_final(Frame& F, const Args& a) {
    F.refresh();
    if (F.vcu >= 16) return;
    const LAS int* tstart = (const LAS int*)(F.lds + XTRA_OFF + 4096) + 32;
    const int row = (F.vcu * 1789 + 29) % T; const int* ts = (const int*)(F.ws + WS_TSLOT) + (size_t)row * 4;
    const bf16_t* H1 = (const bf16_t*)(F.ws + WS_H1) + (size_t)row * 1024; const bf16_t* YS = (const bf16_t*)(F.ws + WS_YS);
    LAS float* vv = (LAS float*)F.lds + 8192; LAS float* red = vv + 1024;
    __syncthreads();
    float s = 0.f;
    for (int c = F.tid; c < 1024; c += 512) { float v = DN_ALPHA * bf2f(H1[c]); for (int k = 0; k < 4; ++k) v += bf2f(YS[((size_t)tstart[ts[k] >> 16] * 256 + (ts[k] & 0xffff)) * 1024 + c]); vv[c] = v; s += v; }
    s = wave_sum(s); if (F.lane == 0) red[F.wave] = s; __syncthreads();
    float mean = 0.f; for (int w = 0; w < 8; ++w) mean += red[w]; mean *= (1.f / D); __syncthreads();
    float q = 0.f; for (int c = F.tid; c < 1024; c += 512) { const float d = vv[c] - mean; q += d * d; }
    q = wave_sum(q); if (F.lane == 0) red[F.wave] = q; __syncthreads();
    float var = 0.f; for (int w = 0; w < 8; ++w) var += red[w]; var *= (1.f / D);
    const float rstd = 1.f / sqrtf(var + LN_EPS); const float* g = (const float*)a.in[21]; const float* bta = (const float*)a.in[22];
    for (int c = F.tid; c < 1024; c += 512) { const float want = (vv[c] - mean) * rstd * g[c] + bta[c]; if (!close_enough(a.out[(size_t)row * 1024 + c], want, 0.01f, 0.01f)) dbg_fail(F, 16); }
    __syncthreads();
}
__device__ __forceinline__ void dbg_emit(Frame& F, float* out) {
    F.refresh();
    const unsigned m = __hip_atomic_load(F.ctl + CW_DBG, RLX_AGENT);
    const unsigned tm = __hip_atomic_load(F.ctl + CW_BAR + XB_TMO, RLX_AGENT);
    float C = 0.f;
    if (tm) C = 1e15f;
    else if (m) { const int id = __builtin_ctz(m); C = sqrtf(powf(10.f, (float)id) - 1.f); }
    const f32x4 v = (f32x4){C, C, C, C};
    for (size_t i = (size_t)F.vcu * 512 + F.tid; i < (size_t)T * D / 4; i += (size_t)F.G * 512) ((GAS f32x4*)out)[i] = v;
}

__global__ void __launch_bounds__(512, 2) fwd_kernel(Args args) {
    extern __shared__ __attribute__((aligned(16))) unsigned char lds[];
    Frame F;
    F.lds = (LAS unsigned char*)lds;
    F.MISC = (volatile LAS unsigned*)(F.lds + MISC_OFF);
    F.wave = __builtin_amdgcn_readfirstlane((int)threadIdx.x >> 6); F.refresh();
    F.G = gridDim.x; { const int bx = blockIdx.x; F.vcu = (F.G % 8 == 0) ? (bx % 8) * (F.G / 8) + bx / 8 : bx; }
    F.ws = args.ws; F.ctl = (gu32*)(args.ws + WS_CTL);
    for (int u = F.tid; u < 64; u += 512) ((LAS unsigned*)(F.lds + MISC_OFF))[u] = 0u;
    __syncthreads();
    XcdBarrier bar = xcd_barrier_post((unsigned*)(F.ctl + CW_BAR), F.MISC + 8);

#if TPROBE > 0
    int n_stamp = 0;
#define STAMP() do { F.refresh(); if (blockIdx.x == 0 && F.tid == 0) { const unsigned long long t_ = __builtin_amdgcn_s_memrealtime(); __hip_atomic_store(F.ctl + CW_TS + 2 * n_stamp, (unsigned)t_, RLX_AGENT); __hip_atomic_store(F.ctl + CW_TS + 2 * n_stamp + 1, (unsigned)(t_ >> 32), RLX_AGENT); } ++n_stamp; } while (0)
#else
#define STAMP() do {} while (0)
#endif
#define RUN_PHASE(k, ...) { __VA_ARGS__ } if (DUP_PHASE == (k)) { __VA_ARGS__ }
    STAMP();
    RUN_PHASE(0,
    p0_prologue(F, args);
    xcd_barrier(bar); STAMP();
    )
    RUN_PHASE(1,
    {
        pg8::DenseOrder S; S.init((const bf16_t*)(F.ws + WS_H0), D, (const bf16_t*)(F.ws + WS_WIN), D, T, NPROJ, F.G, (int)blockIdx.x);
        EpiProj E{(bf16_t*)(F.ws + WS_PROJ), (const float*)(F.ws + WS_COS), (const float*)(F.ws + WS_SIN), (const float*)(F.ws + WS_LB)};
        pg8::gemm_phase<EpiProj, pg8::DenseOrder>(F.lds, D, S, E, F.wave);
    }
    xcd_barrier(bar); STAMP();
    )
#if DBG_STAGE == 1
    dbg_check_proj(F, args);
    xcd_barrier(bar);
    dbg_emit(F, args.out);
    return;
#endif
    RUN_PHASE(2,
    {
        const bf16_t* PROJ = (const bf16_t*)(F.ws + WS_PROJ);
        LAS float* tabkv = (LAS float*)(F.lds + XTRA_OFF); LAS float* tabq = tabkv + 256;
        pg8::DenseOrder Skv; Skv.init(PROJ + PC_KVA, NPROJ, (const bf16_t*)(F.ws + WS_WKVB), KVL, T, 1024, F.G, (int)blockIdx.x);
        pg8::DenseOrder Sq; Sq.init(PROJ + PC_QA, NPROJ, (const bf16_t*)(F.ws + WS_WQB), QL, T, 768, F.G, (int)blockIdx.x);
        pg8::Unit u; F.refresh();
        if (Skv.next(0, u)) rs_table(PROJ, u.pm, PC_KVA, KVL, tabkv, F.tid);
        if (Sq.next(0, u)) rs_table(PROJ, u.pm, PC_QA, QL, tabq, F.tid);
        LDS_WAIT(); __syncthreads();
        EpiKV Ekv{(bf16_t*)(F.ws + WS_KV), tabkv};
        pg8::gemm_phase<EpiKV, pg8::DenseOrder>(F.lds, KVL, Skv, Ekv, F.wave);
        EpiQ Eq{(bf16_t*)(F.ws + WS_Q), (const float*)(F.ws + WS_COS), (const float*)(F.ws + WS_SIN), tabq};
        pg8::gemm_phase<EpiQ, pg8::DenseOrder>(F.lds, QL, Sq, Eq, F.wave);
        for (int j = 0; j < 4; ++j) { const int unit = F.vcu * 4 + j; if (unit < 1024) hg::pass_a(unit, PROJ, (float*)(F.ws + WS_LT), (float*)(F.ws + WS_DEC), F.lds, F.wave); }
    }
    xcd_barrier(bar); STAMP();
    )
    RUN_PHASE(3,
    {
        F.refresh();
        hg::pass_b((const float*)(F.ws + WS_LT), (const float*)(F.ws + WS_DEC), (bf16_t*)(F.ws + WS_SST), F.vcu * 512 + F.tid, F.G * 512);
        const int bh = F.vcu >> 2, s = F.vcu & 3;
        if (bh < NB * 8) {
            att::unit(bh >> 3, bh & 7, 7 - s, (const bf16_t*)(F.ws + WS_Q), (const bf16_t*)(F.ws + WS_KV), (const bf16_t*)(F.ws + WS_PROJ), (bf16_t*)(F.ws + WS_MIX), (float*)(F.ws + WS_SSQ), F.lds, F.wave);
            att::unit(bh >> 3, bh & 7, s, (const bf16_t*)(F.ws + WS_Q), (const bf16_t*)(F.ws + WS_KV), (const bf16_t*)(F.ws + WS_PROJ), (bf16_t*)(F.ws + WS_MIX), (float*)(F.ws + WS_SSQ), F.lds, F.wave);
        }
    }
    xcd_barrier(bar); STAMP();
    )
#if DBG_STAGE >= 2
    dbg_check_proj(F, args);
    __syncthreads();
    dbg_check_qkv(F, args);
    dbg_check_attn(F);
    xcd_barrier(bar);
#endif
    attn_normalise(F, (const float*)args.in[10]);
    for (int j = 0; j < 4; ++j) { const int unit = F.vcu * 4 + j; if (unit < 1024) hg::pass_c(unit, (const bf16_t*)(F.ws + WS_PROJ), (const bf16_t*)(F.ws + WS_SST), (const float*)args.in[11], (bf16_t*)(F.ws + WS_MIX), F.lds, F.wave); }
    xcd_barrier(bar); STAMP();
    if (DUP_PHASE == 4) { for (int j = 0; j < 4; ++j) { const int unit = F.vcu * 4 + j; if (unit < 1024) hg::pass_c(unit, (const bf16_t*)(F.ws + WS_PROJ), (const bf16_t*)(F.ws + WS_SST), (const float*)args.in[11], (bf16_t*)(F.ws + WS_MIX), F.lds, F.wave); } xcd_barrier(bar); }
#if DBG_STAGE >= 3
    dbg_check_norm(F, (const float*)args.in[10]);
    dbg_check_hgrn(F, (const float*)args.in[11]);
    __syncthreads();
#endif
    RUN_PHASE(5,
    {
        pg8::DenseOrder S; S.init((const bf16_t*)(F.ws + WS_MIX), D, (const bf16_t*)(F.ws + WS_WO), D, T, D, F.G, (int)blockIdx.x);
        EpiY E{(float*)(F.ws + WS_Y), (const bf16_t*)(F.ws + WS_H0)};
        pg8::gemm_phase<EpiY, pg8::DenseOrder>(F.lds, D, S, E, F.wave);
    }
    xcd_barrier(bar); STAMP();
    )
    p6_router(F, args);
    xcd_barrier(bar); STAMP();
    moe_table(F);
    RUN_PHASE(7,
    {
        const LAS int* cnt = (const LAS int*)(F.lds + XTRA_OFF + 4096); const LAS int* tstart = cnt + 32;
        MoeOrder<true> S{(const bf16_t*)(F.ws + WS_H1), (const bf16_t*)(F.ws + WS_WUP), D, D, 8, F.G, F.vcu, (size_t)2048 * D, cnt, tstart, (const int*)(F.ws + WS_LTOK)};
        EpiUp E{(bf16_t*)(F.ws + WS_ACT), (const float*)args.in[18]};
        pg8::gemm_phase<EpiUp, MoeOrder<true>>(F.lds, D, S, E, F.wave);
    }
    xcd_barrier(bar); STAMP();
    )
    RUN_PHASE(8,
    {
        const LAS int* cnt = (const LAS int*)(F.lds + XTRA_OFF + 4096); const LAS int* tstart = cnt + 32;
        MoeOrder<false> S{(const bf16_t*)(F.ws + WS_ACT), (const bf16_t*)(F.ws + WS_WDN), DE, DE, 4, F.G, F.vcu, (size_t)D * DE, cnt, tstart, nullptr};
        EpiDown E{(bf16_t*)(F.ws + WS_YS), (const float*)args.in[20], (const float*)(F.ws + WS_LGATE), cnt, tstart};
        pg8::gemm_phase<EpiDown, MoeOrder<false>>(F.lds, DE, S, E, F.wave);
    }
    xcd_barrier(bar); STAMP();
    )
    p9_final(F, args);
    if (DUP_PHASE == 9) { xcd_barrier(bar); p9_final(F, args); }
#if TPROBE > 0
    xcd_barrier(bar); STAMP();
    {
        F.refresh();
        const int pa = 2 * (TPROBE - 1), pb = pa + 1;
        unsigned long long t[4];
        for (int j = 0; j < 4; ++j) { const int idx = (j < 2 ? pa + j : pb + (j - 2)); t[j] = (unsigned long long)__hip_atomic_load(F.ctl + CW_TS + 2 * idx, RLX_AGENT) | ((unsigned long long)__hip_atomic_load(F.ctl + CW_TS + 2 * idx + 1, RLX_AGENT) << 32); }
        const float ua = (float)(t[1] - t[0]) * 0.01f, ub = (float)(t[3] - t[2]) * 0.01f;
        const float Bv = sqrtf(ub); const f32x4 v = (f32x4){Bv, Bv, Bv, Bv};
        for (size_t i = (size_t)F.vcu * 512 + F.tid; i < (size_t)T * D / 4; i += (size_t)F.G * 512) ((GAS f32x4*)args.out)[i] = v;
        VM_WAIT(); xcd_barrier(bar);
        if (blockIdx.x == 0 && F.tid == 0) args.out[0] = ua;
    }
#endif
#if DBG_STAGE >= 3
    xcd_barrier(bar);
    dbg_check_router(F, args);
    dbg_check_moe(F, args);
    dbg_check_final(F, args);
    F.refresh(); if (F.vcu == 100 && F.tid == 0) dbg_fail(F, 20);
    xcd_barrier(bar);
    dbg_emit(F, args.out);
#endif
}

extern "C" void kernel_launch(void* const* d_in, const int* in_sizes, int n_in, void* d_out, int out_size, void* d_ws, size_t ws_size, hipStream_t stream) {
    static int grid = 0;
    if (grid == 0) {
        if (n_in != 23 || out_size != T * D || ws_size < WS_END_A) { fprintf(stderr, "kernel_launch: unexpected shapes (n_in %d out %d ws %zu)\n", n_in, out_size, ws_size); grid = -1; return; }
        int dev = 0, cus = 0, per_cu = 0;
        if (hipGetDevice(&dev) != hipSuccess || hipDeviceGetAttribute(&cus, hipDeviceAttributeMultiprocessorCount, dev) != hipSuccess) { grid = -1; return; }
        if (hipFuncSetAttribute((const void*)fwd_kernel, hipFuncAttributeMaxDynamicSharedMemorySize, LDS_BYTES) != hipSuccess) { fprintf(stderr, "kernel_launch: hipFuncSetAttribute failed\n"); grid = -1; return; }
        if (hipOccupancyMaxActiveBlocksPerMultiprocessor(&per_cu, (const void*)fwd_kernel, 512, LDS_BYTES) != hipSuccess || per_cu < 1) fprintf(stderr, "kernel_launch: occupancy query says %d\n", per_cu);
        (void)hipGetLastError();
        grid = cus;
    }
    if (grid < 0) return;
    if (hipMemsetAsync((char*)d_ws + WS_CTL, 0, CTL_ZERO_BYTES, stream) != hipSuccess) return;
    Args a{};
    for (int i = 0; i < 23; ++i) a.in[i] = d_in[i];
    a.out = (float*)d_out; a.ws = (unsigned char*)d_ws;
    hipLaunchKernelGGL(fwd_kernel, dim3(grid), dim3(512), LDS_BYTES, stream, a);
}
```

```cpp
#include <hip/hip_runtime.h>
#include <cstdio>
#include <cstdint>

#ifndef DBG_STAGE
#define DBG_STAGE 0
#endif

#ifndef MOE_FP8
#define MOE_FP8 1
#endif
#ifndef DUP_PHASE
#define DUP_PHASE -1
#endif
#ifndef TPROBE
#define TPROBE 0
#endif
#define GAS __attribute__((address_space(1)))
#define LAS __attribute__((address_space(3)))
typedef unsigned short bf16_t;
typedef short bf16x8 __attribute__((ext_vector_type(8)));
typedef float f32x4 __attribute__((ext_vector_type(4)));
typedef float f32x2 __attribute__((ext_vector_type(2)));
typedef unsigned u32x4 __attribute__((ext_vector_type(4)));
typedef unsigned u32x2 __attribute__((ext_vector_type(2)));
typedef GAS unsigned gu32;

constexpr int T = 16384, SEQ = 2048, NB = 8, D = 1024;
constexpr int IN_COLS = 2720, NPROJ = 2816;
constexpr int QL = 384, KVL = 256;
constexpr int NE = 32, DE = 1024;
constexpr float LN_EPS = 1e-5f, RMS_EPS = 1e-6f;
constexpr float DN_ALPHA = 1.189207115002721f;
constexpr int PC_KVA = 0, PC_QA = 256, PC_KR = 640, PC_HQ = 768, PC_HF = 1280, PC_HI = 1792, PC_HG = 2304;

constexpr size_t MiB = 1u << 20;
constexpr size_t WS_CTL = 0, CTL_ZERO_BYTES = 1 * MiB;
constexpr size_t WS_COS = 1 * MiB, WS_SIN = 2 * MiB, WS_LB = 3 * MiB;
constexpr size_t WS_WRH = 3 * MiB + 65536, WS_WRL = 3 * MiB + 131072;
constexpr size_t WS_WIN = 4 * MiB;
constexpr size_t WS_WQB = 10 * MiB, WS_WKVB = 11 * MiB, WS_WO = 12 * MiB;
constexpr size_t WS_WUP = 14 * MiB;
constexpr size_t WS_WDN = 142 * MiB;
constexpr size_t WS_H0 = 206 * MiB;
constexpr size_t WS_PROJ = 238 * MiB;
constexpr size_t WS_Q = 326 * MiB;
constexpr size_t WS_KV = 350 * MiB;
constexpr size_t WS_MIX = 382 * MiB;
constexpr size_t WS_SSQ = 414 * MiB;
constexpr size_t WS_LT = 416 * MiB;
constexpr size_t WS_SST = 480 * MiB;
constexpr size_t WS_DEC = 512 * MiB;
constexpr size_t WS_Y = 514 * MiB;
constexpr size_t WS_H1 = 578 * MiB;
constexpr size_t WS_LTOK = 610 * MiB, WS_LGATE = 612 * MiB, WS_TSLOT = 614 * MiB;
constexpr size_t WS_ACT = 616 * MiB;
constexpr size_t WS_YS = 760 * MiB;
constexpr size_t WS_END_A = 920 * MiB;
constexpr size_t WS_H1F8 = 904 * MiB;
constexpr float W8_SCALE = 256.f, ACT8_SCALE = 4.f;
constexpr int CW_CNT = 1024;
constexpr int CW_TS = 2048;
constexpr int CW_DBG = 8;
constexpr int CW_BAR = 4096;

constexpr int RING_BYTES = 131072;
constexpr int XTRA_OFF = RING_BYTES, XTRA_BYTES = 20480;
constexpr int MISC_OFF = XTRA_OFF + XTRA_BYTES;
constexpr int LDS_BYTES = MISC_OFF + 256;

#define RLX_AGENT __ATOMIC_RELAXED, __HIP_MEMORY_SCOPE_AGENT
#define LDS_WAIT() asm volatile("s_waitcnt lgkmcnt(0)" ::: "memory")
#define VM_WAIT() asm volatile("s_waitcnt vmcnt(0)" ::: "memory")
__device__ __forceinline__ unsigned f2bf(float f) { unsigned u = __builtin_bit_cast(unsigned, f); return (u + 0x7fffu + ((u >> 16) & 1u)) >> 16; }
__device__ __forceinline__ unsigned pk2(float lo, float hi) { return f2bf(lo) | (f2bf(hi) << 16); }
__device__ __forceinline__ float bf2f(bf16_t h) { return __builtin_bit_cast(float, (unsigned)h << 16); }
__device__ __forceinline__ float wave_sum(float v) {
#pragma unroll
    for (int o = 1; o < 64; o <<= 1) v += __shfl_xor(v, o);
    return v;
}
__device__ __forceinline__ int fresh_lane() { int l; asm volatile("v_mbcnt_lo_u32_b32 %0, -1, 0\n\tv_mbcnt_hi_u32_b32 %0, -1, %0" : "=v"(l)); return l; }
__device__ __forceinline__ unsigned pk4_fp8(float a, float b, float c, float d) { int w = __builtin_amdgcn_cvt_pk_fp8_f32(a, b, 0, false); w = __builtin_amdgcn_cvt_pk_fp8_f32(c, d, w, true); return (unsigned)w; }
__device__ __forceinline__ float silu_f(float x) { return x * __builtin_amdgcn_rcpf(1.f + __expf(-x)); }

namespace pg8 {
constexpr int BM = 256, BK = 64, HALF = 128, HTB = HALF * BK * 2, STAGE_BYTES = 8 * HTB, NXCD = 8, WGM = 8;
__host__ __device__ __forceinline__ int lds_byte(int r, int c) { const int st = (r >> 4) * 2 + (c >> 5), rr = r & 15, cc = c & 31, ob = rr * 64 + cc * 2; return st * 1024 + (ob ^ (((ob >> 9) & 1) << 5)); }
__host__ __device__ __forceinline__ void stage_rc(int b, int& R, int& C) { const int st = b / 1024, sb = b % 1024, swz = sb ^ (((sb >> 9) & 1) << 5); R = (st >> 1) * 16 + swz / 64; C = (st & 1) * 32 + (swz % 64) / 2; }
__host__ __device__ __forceinline__ int perm32(int rho) { const int n = rho >> 4, i = rho & 15; return 8 * (i >> 2) + 4 * n + (i & 3); }

struct Unit { int pm, pn, e; };

struct DenseOrder {
    const bf16_t* A; const bf16_t* Bt; int lda, K;
    int nM, nN, nwg, G, c;
    __device__ __forceinline__ void init(const bf16_t* A_, int lda_, const bf16_t* Bt_, int K_, int M, int N, int G_, int c_) { A = A_; Bt = Bt_; lda = lda_; K = K_; nM = M / BM; nN = N / BM; nwg = nM * nN; G = G_; c = c_; }
    __device__ __forceinline__ bool next(int i, Unit& u) const {
        const long L = (long)i * G + c; if (L >= nwg) return false;
        int wgid = (int)L; { const int q = nwg / NXCD, r = nwg % NXCD, xcd = wgid % NXCD, off = wgid / NXCD; wgid = (xcd < r ? xcd * (q + 1) : r * (q + 1) + (xcd - r) * q) + off; }
        const int nig = WGM * nN, gid = wgid / nig, fm = gid * WGM, gsz = (nM - fm) < WGM ? (nM - fm) : WGM;
        u.pm = fm + ((wgid % nig) % gsz); u.pn = (wgid % nig) / gsz; u.e = 0; return true;
    }
    __device__ __forceinline__ const char* a_base(const Unit& u) const { return (const char*)A + (size_t)u.pm * BM * lda * 2; }
    __device__ __forceinline__ const char* b_base(const Unit& u) const { return (const char*)Bt + (size_t)u.pn * BM * K * 2; }
    __device__ __forceinline__ void a_offs(const Unit&, const int (&R)[2], const int (&C)[2], unsigned (&v)[2][2]) const {
#pragma unroll
        for (int h = 0; h < 2; ++h)
#pragma unroll
            for (int i = 0; i < 2; ++i) v[h][i] = (unsigned)((h * HALF + R[i]) * lda + C[i]) * 2u;
    }
    static constexpr bool GATHER = false;
};

template <class Epi, class Sched, bool FP8 = false>
__device__ __forceinline__ void gemm_phase(LAS unsigned char* lds, const int K, const Sched& S, const Epi& E, const int wave) {
    typedef int v8i32 __attribute__((ext_vector_type(8)));
    constexpr int ESZ = FP8 ? 1 : 2;
    const int lane = fresh_lane(), wid = wave, tid = wid * 64 + lane, wr = wid >> 2, wc = wid & 3, fr = lane & 15, fq = lane >> 4;
    const int nt = K * ESZ / 128;
    int RA[2], CA[2]; unsigned voffB[2];
#pragma unroll
    for (int i = 0; i < 2; ++i) { int R, C; stage_rc(tid * 16 + i * 8192, R, C); const int Rb = Epi::PERM ? ((R & ~31) + perm32(R & 31)) : R;
        RA[i] = R; CA[i] = C; voffB[i] = (unsigned)(Rb * K * ESZ + C * 2); }
    const size_t kstep = (size_t)(BK * 2);
    const size_t hstepB = (size_t)HALF * K * ESZ;
    const unsigned ldsw = (unsigned)wid * 1024u;
    const int aoff = lds_byte(wr * 64 + fr, fq * 8), boff = lds_byte(wc * 32 + fr, fq * 8);
#define PG8_SA(b, h) (((b) * 2 + (h)) * HTB)
#define PG8_SB(b, h) ((4 + (b) * 2 + (h)) * HTB)
#define PG8_STAGE(bufoff, gbase, voff) do { _Pragma("unroll") for (int _i = 0; _i < 2; ++_i) \
        __builtin_amdgcn_global_load_lds((const unsigned*)((const char*)(gbase) + (voff)[_i]), (LAS unsigned*)(lds + (bufoff) + ldsw + _i * 8192), 16, 0, 0); } while (0)
#define PG8_LDA(dst, b, h) do { _Pragma("unroll") for (int m = 0; m < 4; ++m) _Pragma("unroll") for (int k = 0; k < 2; ++k) dst[m][k] = *(const LAS bf16x8*)(lds + PG8_SA(b, h) + aoff + m * 2048 + k * 1024); } while (0)
#define PG8_LDB(dst, b, h) do { _Pragma("unroll") for (int n = 0; n < 2; ++n) _Pragma("unroll") for (int k = 0; k < 2; ++k) dst[n][k] = *(const LAS bf16x8*)(lds + PG8_SB(b, h) + boff + n * 2048 + k * 1024); } while (0)
#define PG8_CAT(x) __builtin_shufflevector(__builtin_bit_cast(__attribute__((ext_vector_type(4))) int, (x)[0]), __builtin_bit_cast(__attribute__((ext_vector_type(4))) int, (x)[1]), 0, 1, 2, 3, 4, 5, 6, 7)
#define PG8_MMA(ai, bj, At, Bt) do { __builtin_amdgcn_s_setprio(1); _Pragma("unroll") for (int m = 0; m < 4; ++m) _Pragma("unroll") for (int n = 0; n < 2; ++n) { \
        if constexpr (FP8) { const v8i32 b_ = (v8i32)PG8_CAT(Bt[n]), a_ = (v8i32)PG8_CAT(At[m]); asm volatile("v_mfma_f32_16x16x128_f8f6f4 %0, %1, %2, %0" : "+v"(acc[ai][bj][m][n]) : "v"(b_), "v"(a_)); } \
        else { _Pragma("unroll") for (int k = 0; k < 2; ++k) acc[ai][bj][m][n] = __builtin_amdgcn_mfma_f32_16x16x32_bf16(Bt[n][k], At[m][k], acc[ai][bj][m][n], 0, 0, 0); } } __builtin_amdgcn_s_setprio(0); } while (0)
#define PG8_WAIT_V(n) asm volatile("s_waitcnt vmcnt(" #n ")" ::: "memory")
#define PG8_WAIT_L(n) asm volatile("s_waitcnt lgkmcnt(" #n ")" ::: "memory")
#define PG8_BAR __builtin_amdgcn_s_barrier()
#define PG8_SCHED __builtin_amdgcn_sched_barrier(0)
    Unit cur, nxt; int ui = 0;
    if (!S.next(0, cur)) return;
    f32x4 acc[2][2][4][2];
#pragma unroll
    for (int a = 0; a < 2; ++a)
#pragma unroll
        for (int b = 0; b < 2; ++b)
#pragma unroll
            for (int m = 0; m < 4; ++m)
#pragma unroll
                for (int n = 0; n < 2; ++n) acc[a][b][m][n] = (f32x4){0.f, 0.f, 0.f, 0.f};
    bf16x8 At[4][2], B0[2][2], B1[2][2];
    const char* cA = S.a_base(cur); const char* cB = S.b_base(cur);
    unsigned vC[2][2], vN[2][2];
    S.a_offs(cur, RA, CA, vC);
#pragma unroll
    for (int h = 0; h < 2; ++h) { vN[h][0] = vC[h][0]; vN[h][1] = vC[h][1]; }
    PG8_STAGE(PG8_SB(0, 0), cB, voffB); PG8_STAGE(PG8_SB(0, 1), cB + hstepB, voffB); PG8_STAGE(PG8_SA(0, 0), cA, vC[0]); PG8_STAGE(PG8_SA(0, 1), cA, vC[1]);
    if (wr == 1) PG8_BAR;
    PG8_WAIT_V(2); PG8_BAR;
    PG8_STAGE(PG8_SB(1, 0), cB + kstep, voffB); PG8_STAGE(PG8_SA(1, 0), cA + kstep, vC[0]); PG8_STAGE(PG8_SB(1, 1), cB + hstepB + kstep, voffB);
    PG8_WAIT_V(6); PG8_BAR;
    for (;;) {
        const bool has_next = S.next(ui + 1, nxt);
        const char* nA = has_next ? S.a_base(nxt) : cA; const char* nB = has_next ? S.b_base(nxt) : cB;
        if (Sched::GATHER) { if (has_next) S.a_offs(nxt, RA, CA, vN); else {
#pragma unroll
            for (int h = 0; h < 2; ++h) { vN[h][0] = vC[h][0]; vN[h][1] = vC[h][1]; } } }
#pragma nounroll
        for (int t = 0; t < nt; t += 2) {
            const bool last = (t == nt - 2);
            const char* a1 = cA + (size_t)(t + 1) * kstep;
            const char* a2 = last ? nA : cA + (size_t)(t + 2) * kstep; const char* b2 = last ? nB : cB + (size_t)(t + 2) * kstep;
            const char* a3 = a2 + kstep; const char* b3 = b2 + kstep;
            unsigned v2[2][2];
#pragma unroll
            for (int h = 0; h < 2; ++h) { v2[h][0] = (Sched::GATHER && last) ? vN[h][0] : vC[h][0]; v2[h][1] = (Sched::GATHER && last) ? vN[h][1] : vC[h][1]; }
            PG8_LDB(B0, 0, 0); PG8_LDB(B1, 0, 1); PG8_SCHED; PG8_LDA(At, 0, 0); PG8_STAGE(PG8_SA(1, 1), a1, vC[1]);
            PG8_WAIT_V(8); PG8_WAIT_L(0); PG8_BAR; PG8_MMA(0, 0, At, B0); PG8_MMA(0, 1, At, B1); PG8_BAR; PG8_SCHED;
            PG8_LDA(At, 0, 1); PG8_STAGE(PG8_SB(0, 0), b2, voffB); PG8_STAGE(PG8_SB(0, 1), b2 + hstepB, voffB); PG8_STAGE(PG8_SA(0, 0), a2, v2[0]);
            PG8_WAIT_V(8); PG8_WAIT_L(0); PG8_BAR; PG8_MMA(1, 0, At, B0); PG8_MMA(1, 1, At, B1); PG8_BAR; PG8_SCHED;
            PG8_LDB(B0, 1, 0); PG8_LDB(B1, 1, 1); PG8_SCHED; PG8_LDA(At, 1, 0); PG8_STAGE(PG8_SA(0, 1), a2, v2[1]);
            PG8_WAIT_V(8); PG8_WAIT_L(0); PG8_BAR; PG8_MMA(0, 0, At, B0); PG8_MMA(0, 1, At, B1); PG8_BAR; PG8_SCHED;
            PG8_LDA(At, 1, 1); PG8_STAGE(PG8_SB(1, 0), b3, voffB); PG8_STAGE(PG8_SB(1, 1), b3 + hstepB, voffB); PG8_STAGE(PG8_SA(1, 0), a3, v2[0]);
            PG8_WAIT_V(8); PG8_WAIT_L(0); PG8_BAR; PG8_MMA(1, 0, At, B0); PG8_MMA(1, 1, At, B1); PG8_BAR; PG8_SCHED;
        }
        if constexpr (FP8) asm volatile("s_nop 15\n\ts_nop 15" ::: "memory");
        if (wr == 0) PG8_BAR;
        { int fr_e = fr, fq_e = fq; asm volatile("" : "+v"(fr_e), "+v"(fq_e));
          E(acc, cur, wr, wc, fr_e, fq_e); }
        if (!has_next) break;
#pragma unroll
        for (int a = 0; a < 2; ++a)
#pragma unroll
            for (int b = 0; b < 2; ++b)
#pragma unroll
                for (int m = 0; m < 4; ++m)
#pragma unroll
                    for (int n = 0; n < 2; ++n) acc[a][b][m][n] = (f32x4){0.f, 0.f, 0.f, 0.f};
        cur = nxt; cA = nA; cB = nB; ++ui;
#pragma unroll
        for (int h = 0; h < 2; ++h) { vC[h][0] = vN[h][0]; vC[h][1] = vN[h][1]; }
        if (wr == 1) PG8_BAR;
    }
    PG8_WAIT_V(0);
    PG8_BAR;
#undef PG8_SA
#undef PG8_SB
#undef PG8_STAGE
#undef PG8_LDA
#undef PG8_LDB
#undef PG8_MMA
#undef PG8_CAT
#undef PG8_WAIT_V
#undef PG8_WAIT_L
#undef PG8_BAR
#undef PG8_SCHED
}
}

#define XB_TMO      128
#define XB_XCNT(j)  (256  + 64 * (j))
#define XB_XSUB(j)  (1280 + 64 * (j))
#define XB_XGEN(j)  (2304 + 64 * (j))
#define XB_TOP      3328
#define XB_TOPGEN   3392
#define XCD_BAR_WORDS 3456
#define XB_SPIN_CAP (1u << 18)
__device__ __forceinline__ unsigned xb_ld(unsigned* p)              { return __hip_atomic_load(p, __ATOMIC_RELAXED, __HIP_MEMORY_SCOPE_AGENT); }
__device__ __forceinline__ unsigned xb_add(unsigned* p, unsigned v) { return __hip_atomic_fetch_add(p, v, __ATOMIC_RELAXED, __HIP_MEMORY_SCOPE_AGENT); }
__device__ __forceinline__ unsigned xb_xcc_id() { return (unsigned)__builtin_amdgcn_s_getreg((3 << 11) | 20) & 0xFu; }
#define XB_SPIN(cond, bar) do { unsigned _sp = 0; while (cond) { __builtin_amdgcn_s_sleep(1); \
    if ((++_sp & 255u) == 0u) { if (xb_ld(&(bar)[XB_TMO])) break; if (_sp > XB_SPIN_CAP) { atomicAdd(&(bar)[XB_TMO], 1u); break; } } } } while (0)
struct XcdBarrier { unsigned* bar; unsigned x; volatile LAS unsigned* st; };
__device__ __forceinline__ XcdBarrier xcd_barrier_post(unsigned* bar, volatile LAS unsigned* st) {
    XcdBarrier b; b.bar = bar; b.x = xb_xcc_id(); b.st = st;
    if (threadIdx.x == 0) (void)xb_add(&bar[XB_XCNT(b.x)], 1u);
    return b;
}
__device__ __forceinline__ void xcd_barrier_complete(unsigned* bar, unsigned x, unsigned& nloc, unsigned& nx) {
    const unsigned G = gridDim.x * gridDim.y * gridDim.z;
    unsigned sum, cnt, mine, sp = 0u;
    for (;;) {
        sum = 0u; cnt = 0u; mine = 0u;
#pragma unroll
        for (unsigned j = 0; j < 16; ++j) { const unsigned c = xb_ld(&bar[XB_XCNT(j)]); sum += c; cnt += (c > 0u) ? 1u : 0u; mine = (j == x) ? c : mine; }
        if (sum == G) break;
        __builtin_amdgcn_s_sleep(1);
        if ((++sp & 255u) == 0u) { if (xb_ld(&bar[XB_TMO])) break; if (sp > XB_SPIN_CAP) { atomicAdd(&bar[XB_TMO], 1u); break; } }
    }
    nloc = mine > 0u ? mine : 1u; nx = cnt > 0u ? cnt : 1u;
}
__device__ __forceinline__ void xcd_barrier(const XcdBarrier& b) {
    asm volatile("s_waitcnt vmcnt(0)" ::: "memory");
    __syncthreads();
    if (threadIdx.x == 0) {
        unsigned* bar = b.bar;
        __builtin_amdgcn_s_waitcnt(0);
        unsigned nloc = b.st[0], nx = b.st[1];
        if (nloc == 0u) { xcd_barrier_complete(bar, b.x, nloc, nx); b.st[0] = nloc; b.st[1] = nx; }
        const unsigned old = xb_add(&bar[XB_XSUB(b.x)], 1u);
        const unsigned gen = old / nloc;
        if (old + 1u == (gen + 1u) * nloc) {
            __builtin_amdgcn_fence(__ATOMIC_RELEASE, "agent");
            asm volatile("s_waitcnt vmcnt(0)" ::: "memory");
            const unsigned og = xb_add(&bar[XB_TOP], 1u);
            const unsigned tg = og / nx;
            if (og + 1u == (tg + 1u) * nx) xb_add(&bar[XB_TOPGEN], 1u);
            else XB_SPIN(xb_ld(&bar[XB_TOPGEN]) == tg, bar);
            __builtin_amdgcn_fence(__ATOMIC_ACQUIRE, "agent");
            xb_add(&bar[XB_XGEN(b.x)], 1u);
            asm volatile("s_waitcnt vmcnt(0)" ::: "memory");
        } else {
            XB_SPIN(xb_ld(&bar[XB_XGEN(b.x)]) == gen, bar);
            __builtin_amdgcn_fence(__ATOMIC_ACQUIRE, "agent");
            asm volatile("s_waitcnt vmcnt(0)" ::: "memory");
        }
    }
    __syncthreads();
}

struct Args { const void* in[23]; float* out; unsigned char* ws; };
struct Frame {
    LAS unsigned char* lds;
    volatile LAS unsigned* MISC;
    gu32* ctl;
    int tid, lane, wave, vcu, G;
    unsigned char* ws;
    __device__ __forceinline__ void refresh() { lane = fresh_lane(); tid = wave * 64 + lane; }
};

__device__ __forceinline__ int srcmap(int kind, int r) {
    if (kind == 0) { if (r < 256) return 384 + r; if (r < 640) return r - 256; if (r < 672) { const int j = r - 640; return 640 + (j & 1) * 16 + (j >> 1); } if (r < 768) return -1; return r - 96; }
    if (kind == 1) { const int h = r / 96, d = r - h * 96; if (d < 64) return r; const int j = d - 64; return h * 96 + 64 + (j & 1) * 16 + (j >> 1); }
    if (kind == 3) { const int pn = r >> 8, j = r & 255; return j < 128 ? pn * 128 + j : 1024 + pn * 128 + (j - 128); }
    return r;
}
__device__ __forceinline__ void transpose_item(const float* W, int Nsrc, int Kd, bf16_t* WT, int kind, const float* kscale, int ndest, LAS float* scr, int item, int lane) {
    const int nblk = ndest >> 6, kb = item / nblk, nb = item - kb * nblk, k0 = 64 * kb, r0 = 64 * nb;
    const int n4 = lane & 15, kq = lane >> 4;
    const int s0 = srcmap(kind, r0 + 4 * n4), s1 = srcmap(kind, r0 + 4 * n4 + 1), s2 = srcmap(kind, r0 + 4 * n4 + 2), s3 = srcmap(kind, r0 + 4 * n4 + 3);
    const bool fast = (s0 >= 0) && ((s0 & 3) == 0) && (s1 == s0 + 1) && (s2 == s0 + 2) && (s3 == s0 + 3);
    if (fast) {
        f32x4 v[16];
#pragma unroll
        for (int i = 0; i < 16; ++i) v[i] = *(const GAS f32x4*)(W + (size_t)(k0 + kq + 4 * i) * Nsrc + s0);
#pragma unroll
        for (int i = 0; i < 16; ++i) { const int kk = kq + 4 * i; const float sc = kscale ? kscale[k0 + kk] : 1.f; LAS float* d = scr + kk * 65 + 4 * n4;
            d[0] = v[i].x * sc; d[1] = v[i].y * sc; d[2] = v[i].z * sc; d[3] = v[i].w * sc; }
    } else {
        for (int i = 0; i < 16; ++i) { const int kk = kq + 4 * i; const float sc = kscale ? kscale[k0 + kk] : 1.f; const float* wr_ = W + (size_t)(k0 + kk) * Nsrc; LAS float* d = scr + kk * 65 + 4 * n4;
            d[0] = s0 >= 0 ? wr_[s0] * sc : 0.f; d[1] = s1 >= 0 ? wr_[s1] * sc : 0.f; d[2] = s2 >= 0 ? wr_[s2] * sc : 0.f; d[3] = s3 >= 0 ? wr_[s3] * sc : 0.f; }
    }
    LDS_WAIT(); asm volatile("" ::: "memory");
    const int c = lane & 7;
#pragma unroll
    for (int j = 0; j < 8; ++j) { const int n = (lane >> 3) + 8 * j; const LAS float* s = scr + (8 * c) * 65 + n;
        u32x4 o; o.x = pk2(s[0 * 65], s[1 * 65]); o.y = pk2(s[2 * 65], s[3 * 65]); o.z = pk2(s[4 * 65], s[5 * 65]); o.w = pk2(s[6 * 65], s[7 * 65]);
        *(GAS u32x4*)(WT + (size_t)(r0 + n) * Kd + k0 + 8 * c) = o; }
    LDS_WAIT(); asm volatile("" ::: "memory");
}
__device__ __forceinline__ void transpose_item_f8(const float* W, int Nsrc, int Kd, unsigned char* WT8, int kind, float scale, int ndest, LAS float* scr, int item, int lane) {
    const int nblk = ndest >> 6, kb = item / nblk, nb = item - kb * nblk, k0 = 64 * kb, r0 = 64 * nb;
    const int n4 = lane & 15, kq = lane >> 4;
    const int s0 = srcmap(kind, r0 + 4 * n4);
    f32x4 v[16];
#pragma unroll
    for (int i = 0; i < 16; ++i) v[i] = *(const GAS f32x4*)(W + (size_t)(k0 + kq + 4 * i) * Nsrc + s0);
#pragma unroll
    for (int i = 0; i < 16; ++i) { const int kk = kq + 4 * i; LAS float* d = scr + kk * 65 + 4 * n4;
        d[0] = v[i].x * scale; d[1] = v[i].y * scale; d[2] = v[i].z * scale; d[3] = v[i].w * scale; }
    LDS_WAIT(); asm volatile("" ::: "memory");
    const int c = lane & 3;
#pragma unroll
    for (int j = 0; j < 4; ++j) { const int n = (lane >> 2) + 16 * j; const LAS float* s = scr + (16 * c) * 65 + n;
        u32x4 o; o.x = pk4_fp8(s[0 * 65], s[1 * 65], s[2 * 65], s[3 * 65]); o.y = pk4_fp8(s[4 * 65], s[5 * 65], s[6 * 65], s[7 * 65]);
        o.z = pk4_fp8(s[8 * 65], s[9 * 65], s[10 * 65], s[11 * 65]); o.w = pk4_fp8(s[12 * 65], s[13 * 65], s[14 * 65], s[15 * 65]);
        *(GAS u32x4*)(WT8 + (size_t)(r0 + n) * Kd + k0 + 16 * c) = o; }
    LDS_WAIT(); asm volatile("" ::: "memory");
}
__device__ __forceinline__ void ln_row_to_bf16(const float* xrow, const float* g, const float* b, bf16_t* orow, int lane, float eps) {
    const GAS f32x4* xr = (const GAS f32x4*)xrow + lane;
    f32x4 v[4]; float s = 0.f;
#pragma unroll
    for (int j = 0; j < 4; ++j) { v[j] = xr[64 * j]; s += (v[j].x + v[j].y) + (v[j].z + v[j].w); }
    const float mean = wave_sum(s) * (1.f / D); float s2 = 0.f;
#pragma unroll
    for (int j = 0; j < 4; ++j) { v[j] = v[j] - mean; s2 += (v[j].x * v[j].x + v[j].y * v[j].y) + (v[j].z * v[j].z + v[j].w * v[j].w); }
    const float rstd = 1.f / sqrtf(wave_sum(s2) * (1.f / D) + eps);
    GAS unsigned long long* o8 = (GAS unsigned long long*)orow + lane;
#pragma unroll
    for (int j = 0; j < 4; ++j) { const f32x4 gg = *((const GAS f32x4*)g + lane + 64 * j), bb = *((const GAS f32x4*)b + lane + 64 * j);
        const f32x4 o = v[j] * rstd * gg + bb;
        o8[64 * j] = (unsigned long long)pk2(o.x, o.y) | ((unsigned long long)pk2(o.z, o.w) << 32); }
}
__device__ __forceinline__ void p0_prologue(Frame& F, const Args& a) {
    F.refresh();
    LAS float* scr = (LAS float*)(F.lds + F.wave * 16640);
    const int gw = F.vcu * 8 + F.wave, NGW = F.G * 8;
    const float* w_in = (const float*)a.in[4]; const float* qg = (const float*)a.in[5]; const float* w_qb = (const float*)a.in[6];
    const float* kvg = (const float*)a.in[7]; const float* w_kvb = (const float*)a.in[8]; const float* w_o = (const float*)a.in[12];
    const float* w_up = (const float*)a.in[17]; const float* w_dn = (const float*)a.in[19];
    bf16_t* WinT = (bf16_t*)(F.ws + WS_WIN); bf16_t* WqbT = (bf16_t*)(F.ws + WS_WQB); bf16_t* WkvbT = (bf16_t*)(F.ws + WS_WKVB); bf16_t* WoT = (bf16_t*)(F.ws + WS_WO);
    bf16_t* WupT = (bf16_t*)(F.ws + WS_WUP); bf16_t* WdnT = (bf16_t*)(F.ws + WS_WDN);
    constexpr int I_IN = 16 * 44, I_QB = 6 * 12, I_KVB = 4 * 16, I_O = 16 * 16, I_UP1 = 16 * 32, I_DN1 = 16 * 16;
#if DBG_STAGE == 1
    constexpr int NITEMS = I_IN + I_QB + I_KVB + I_O;
#else
    constexpr int NITEMS = I_IN + I_QB + I_KVB + I_O + NE * I_UP1 + NE * I_DN1;
#endif
    for (int it = gw; it < NITEMS; it += NGW) {
        int r = it;
        if (r < I_IN) { transpose_item(w_in, IN_COLS, D, WinT, 0, nullptr, NPROJ, scr, r, F.lane); continue; } r -= I_IN;
        if (r < I_QB) { transpose_item(w_qb, 768, QL, WqbT, 1, qg, 768, scr, r, F.lane); continue; } r -= I_QB;
        if (r < I_KVB) { transpose_item(w_kvb, 1024, KVL, WkvbT, 2, kvg, 1024, scr, r, F.lane); continue; } r -= I_KVB;
        if (r < I_O) { transpose_item(w_o, 1024, 1024, WoT, 2, nullptr, 1024, scr, r, F.lane); continue; } r -= I_O;
#if MOE_FP8
        if (r < NE * I_UP1) { const int e = r / I_UP1; transpose_item_f8(w_up + (size_t)e * D * 2048, 2048, D, (unsigned char*)WupT + (size_t)e * 2048 * D, 3, W8_SCALE, 2048, scr, r - e * I_UP1, F.lane); continue; } r -= NE * I_UP1;
        { const int e = r / I_DN1; transpose_item_f8(w_dn + (size_t)e * DE * D, D, DE, (unsigned char*)WdnT + (size_t)e * D * DE, 2, W8_SCALE, D, scr, r - e * I_DN1, F.lane); }
#else
        if (r < NE * I_UP1) { const int e = r / I_UP1; transpose_item(w_up + (size_t)e * D * 2048, 2048, D, WupT + (size_t)e * 2048 * D, 3, nullptr, 2048, scr, r - e * I_UP1, F.lane); continue; } r -= NE * I_UP1;
        { const int e = r / I_DN1; transpose_item(w_dn + (size_t)e * DE * D, D, DE, WdnT + (size_t)e * D * DE, 2, nullptr, D, scr, r - e * I_DN1, F.lane); }
#endif
    }
    const float* x = (const float*)a.in[0]; const float* g = (const float*)a.in[2]; const float* b = (const float*)a.in[3];
    bf16_t* H0 = (bf16_t*)(F.ws + WS_H0);
    for (int m = gw; m < T; m += NGW) ln_row_to_bf16(x + (size_t)m * D, g, b, H0 + (size_t)m * D, F.lane, LN_EPS);
    const int* pos = (const int*)a.in[1]; float* cs = (float*)(F.ws + WS_COS); float* sn = (float*)(F.ws + WS_SIN);
    for (int i = F.vcu * 512 + F.tid; i < T * 16; i += F.G * 512) {
        const int t = i >> 4, j = i & 15;
        const float inv = powf(10000.0f, -(float)(2 * j) / 32.0f);
        const float ang = (float)pos[t] * inv;
        double rev = (double)ang * 0.15915494309189535; rev -= floor(rev);
        const float rf = (float)rev;
        cs[i] = __builtin_amdgcn_cosf(rf); sn[i] = __builtin_amdgcn_sinf(rf);
    }
    { const float* wr_ = (const float*)a.in[15]; bf16_t* wh = (bf16_t*)(F.ws + WS_WRH); bf16_t* wl = (bf16_t*)(F.ws + WS_WRL);
      for (int i = F.vcu * 512 + F.tid; i < 32 * 1024; i += F.G * 512) { const int e = i >> 10, k = i & 1023; const float w = wr_[(size_t)k * 32 + e];
          const unsigned h = f2bf(w); wh[i] = (bf16_t)h; wl[i] = (bf16_t)f2bf(w - __builtin_bit_cast(float, h << 16)); } }
    if (F.vcu == 0) { const float* lbl = (const float*)a.in[9]; float* lb = (float*)(F.ws + WS_LB);
        for (int c = F.tid; c < 512; c += 512) lb[c] = 1.f / (1.f + expf(lbl[512 + c] - lbl[c])); }
}

struct EpiProj {
    static constexpr bool PERM = true;
    bf16_t* P; const float* cs; const float* sn; const float* lb;
    __device__ __forceinline__ void operator()(const f32x4 (&acc)[2][2][4][2], const pg8::Unit& u, int wr, int wc, int fr, int fq) const {
#pragma unroll
        for (int bj = 0; bj < 2; ++bj) {
            const int cb = u.pn * 256 + bj * 128 + wc * 32, c0 = cb + 8 * fq;
            const int kind = cb < PC_KR ? 0 : cb == PC_KR ? 1 : cb < PC_HQ ? 0 : cb < PC_HF ? 2 : cb < PC_HI ? 3 : cb < PC_HG ? 0 : 2;
            float lbv[8];
            if (kind == 3) {
#pragma unroll
                for (int j = 0; j < 8; ++j) lbv[j] = lb[c0 - PC_HF + j];
            }
#pragma unroll
            for (int ai = 0; ai < 2; ++ai)
#pragma unroll
                for (int m = 0; m < 4; ++m) {
                    const int row = u.pm * 256 + ai * 128 + wr * 64 + m * 16 + fr;
                    float v[8];
#pragma unroll
                    for (int j = 0; j < 4; ++j) { v[j] = acc[ai][bj][m][0][j]; v[4 + j] = acc[ai][bj][m][1][j]; }
                    if (kind == 1) {
                        const f32x4 cc = *(const f32x4*)(cs + (size_t)row * 16 + 4 * fq), ss = *(const f32x4*)(sn + (size_t)row * 16 + 4 * fq);
#pragma unroll
                        for (int p = 0; p < 4; ++p) { const float x1 = v[2 * p], x2 = v[2 * p + 1]; v[2 * p] = x1 * cc[p] - x2 * ss[p]; v[2 * p + 1] = x1 * ss[p] + x2 * cc[p]; }
                    } else if (kind == 2) {
#pragma unroll
                        for (int j = 0; j < 8; ++j) v[j] = silu_f(v[j]);
                    } else if (kind == 3) {
#pragma unroll
                        for (int j = 0; j < 8; ++j) { const float s = __builtin_amdgcn_rcpf(1.f + __expf(-v[j])); v[j] = __logf(lbv[j] + (1.f - lbv[j]) * s); }
                    }
                    u32x4 w; w.x = pk2(v[0], v[1]); w.y = pk2(v[2], v[3]); w.z = pk2(v[4], v[5]); w.w = pk2(v[6], v[7]);
                    *(u32x4*)(P + (size_t)row * NPROJ + c0) = w;
                }
        }
    }
};

constexpr float QSCALE = 0.10206207261596577f * 1.4426950408889634f;
__device__ __forceinline__ void rs_table(const bf16_t* P, int pm, int c0, int ncols, LAS float* tab, int tid) {
    const int r = tid >> 1, half = tid & 1, nh = ncols >> 1;
    const bf16_t* p = P + (size_t)(pm * 256 + r) * NPROJ + c0 + half * nh;
    float s = 0.f;
    for (int k = 0; k < nh; k += 8) { const u32x4 w = *(const GAS u32x4*)(p + k);
#pragma unroll
        for (int j = 0; j < 4; ++j) { const float a = __builtin_bit_cast(float, w[j] << 16), b = __builtin_bit_cast(float, w[j] & 0xffff0000u); s += a * a + b * b; } }
    s += __shfl_xor(s, 1);
    if (half == 0) tab[r] = 1.f / sqrtf(s / (float)ncols + RMS_EPS);
}
struct EpiQ {
    static constexpr bool PERM = true;
    bf16_t* Q; const float* cs; const float* sn; const LAS float* rs;
    __device__ __forceinline__ void operator()(const f32x4 (&acc)[2][2][4][2], const pg8::Unit& u, int wr, int wc, int fr, int fq) const {
#pragma unroll
        for (int bj = 0; bj < 2; ++bj) {
            const int c0 = u.pn * 256 + bj * 128 + wc * 32 + 8 * fq;
            const int hh = c0 / 96, d0 = c0 - hh * 96;
#pragma unroll
            for (int ai = 0; ai < 2; ++ai)
#pragma unroll
                for (int m = 0; m < 4; ++m) {
                    const int rl = ai * 128 + wr * 64 + m * 16 + fr, row = u.pm * 256 + rl;
                    const float sc = rs[rl] * QSCALE;
                    float v[8];
#pragma unroll
                    for (int j = 0; j < 4; ++j) { v[j] = acc[ai][bj][m][0][j] * sc; v[4 + j] = acc[ai][bj][m][1][j] * sc; }
                    if (d0 >= 64) {
                        const int i0 = (d0 - 64) >> 1;
                        const f32x4 cc = *(const f32x4*)(cs + (size_t)row * 16 + i0), ss = *(const f32x4*)(sn + (size_t)row * 16 + i0);
#pragma unroll
                        for (int p = 0; p < 4; ++p) { const float x1 = v[2 * p], x2 = v[2 * p + 1]; v[2 * p] = x1 * cc[p] - x2 * ss[p]; v[2 * p + 1] = x1 * ss[p] + x2 * cc[p]; }
                    }
                    u32x4 w; w.x = pk2(v[0], v[1]); w.y = pk2(v[2], v[3]); w.z = pk2(v[4], v[5]); w.w = pk2(v[6], v[7]);
                    *(u32x4*)(Q + (size_t)row * 768 + c0) = w;
                }
        }
    }
};
struct EpiKV {
    static constexpr bool PERM = true;
    bf16_t* KV; const LAS float* rs;
    __device__ __forceinline__ void operator()(const f32x4 (&acc)[2][2][4][2], const pg8::Unit& u, int wr, int wc, int fr, int fq) const {
#pragma unroll
        for (int bj = 0; bj < 2; ++bj) {
            const int c0 = u.pn * 256 + bj * 128 + wc * 32 + 8 * fq;
#pragma unroll
            for (int ai = 0; ai < 2; ++ai)
#pragma unroll
                for (int m = 0; m < 4; ++m) {
                    const int rl = ai * 128 + wr * 64 + m * 16 + fr, row = u.pm * 256 + rl;
                    const float sc = rs[rl];
                    u32x4 w; w.x = pk2(acc[ai][bj][m][0][0] * sc, acc[ai][bj][m][0][1] * sc); w.y = pk2(acc[ai][bj][m][0][2] * sc, acc[ai][bj][m][0][3] * sc);
                    w.z = pk2(acc[ai][bj][m][1][0] * sc, acc[ai][bj][m][1][1] * sc); w.w = pk2(acc[ai][bj][m][1][2] * sc, acc[ai][bj][m][1][3] * sc);
                    *(u32x4*)(KV + (size_t)row * 1024 + c0) = w;
                }
        }
    }
};

namespace att {
typedef float f32x16 __attribute__((ext_vector_type(16)));
typedef short s16x4 __attribute__((ext_vector_type(4)));
constexpr int KSLOT = 12288, VSLOT = 8192, BUFB = KSLOT + VSLOT;
constexpr int LDS_WS = 2 * BUFB, LDS_OST = LDS_WS + 2048, LDS_END = LDS_OST + 8 * 4096;
__device__ __forceinline__ int crow(int r, int hi) { return (r & 3) + 8 * (r >> 2) + 4 * hi; }
__device__ __forceinline__ unsigned cvtpk(float lo, float hi) { unsigned r; asm volatile("v_cvt_pk_bf16_f32 %0, %1, %2" : "=v"(r) : "v"(lo), "v"(hi)); return r; }
__device__ __forceinline__ void pv(f32x16* o, int vb, bf16x8 pa0, bf16x8 pa1, bf16x8 pa2, bf16x8 pa3) {
#pragma unroll
    for (int d0 = 0; d0 < 2; ++d0) { s16x4 lo[4], hi[4];
        asm volatile("ds_read_b64_tr_b16 %0,%8 offset:%c9\n\tds_read_b64_tr_b16 %1,%8 offset:%c10\n\tds_read_b64_tr_b16 %2,%8 offset:%c11\n\tds_read_b64_tr_b16 %3,%8 offset:%c12\n\t"
                     "ds_read_b64_tr_b16 %4,%8 offset:%c13\n\tds_read_b64_tr_b16 %5,%8 offset:%c14\n\tds_read_b64_tr_b16 %6,%8 offset:%c15\n\tds_read_b64_tr_b16 %7,%8 offset:%c16\n\ts_waitcnt lgkmcnt(0)"
                     : "=&v"(lo[0]), "=&v"(hi[0]), "=&v"(lo[1]), "=&v"(hi[1]), "=&v"(lo[2]), "=&v"(hi[2]), "=&v"(lo[3]), "=&v"(hi[3])
                     : "v"(vb), "i"(d0 * 4096), "i"(d0 * 4096 + 512), "i"(d0 * 4096 + 1024), "i"(d0 * 4096 + 1536), "i"(d0 * 4096 + 2048), "i"(d0 * 4096 + 2560), "i"(d0 * 4096 + 3072), "i"(d0 * 4096 + 3584) : "memory");
#define PK(k) (bf16x8){lo[k][0], lo[k][1], lo[k][2], lo[k][3], hi[k][0], hi[k][1], hi[k][2], hi[k][3]}
        o[d0] = __builtin_amdgcn_mfma_f32_32x32x16_bf16(pa0, PK(0), o[d0], 0, 0, 0);
        o[d0] = __builtin_amdgcn_mfma_f32_32x32x16_bf16(pa1, PK(1), o[d0], 0, 0, 0);
        o[d0] = __builtin_amdgcn_mfma_f32_32x32x16_bf16(pa2, PK(2), o[d0], 0, 0, 0);
        o[d0] = __builtin_amdgcn_mfma_f32_32x32x16_bf16(pa3, PK(3), o[d0], 0, 0, 0);
#undef PK
    }
}
__device__ __forceinline__ void unit(int b, int h, int qb, const bf16_t* Q, const bf16_t* KV, const bf16_t* PROJ, bf16_t* MIX, float* SSQ, LAS unsigned char* lds, const int wid) {
    const int lane = fresh_lane(), r32 = lane & 31, hi = lane >> 5;
    const size_t rowbase = (size_t)b * SEQ; const int q0 = qb * 256;
    const bf16_t* Qw = Q + (rowbase + q0 + wid * 32) * 768 + h * 96;
    bf16x8 qr[6];
#pragma unroll
    for (int d0 = 0; d0 < 6; ++d0) qr[d0] = *(const GAS bf16x8*)(Qw + (size_t)r32 * 768 + d0 * 16 + hi * 8);
    const int cw = (q0 + 32 * wid) >> 6, NT = 4 * qb + 4;
    LAS float* wsf = (LAS float*)(lds + LDS_WS) + wid * 64;
    const bf16_t* ksrc = KV + (rowbase + lane) * 1024 + h * 128 + wid * 8;
    const bf16_t* rsrc = PROJ + (rowbase + lane) * NPROJ + PC_KR + (wid & 3) * 8;
    const bf16_t* vsrc = KV + (rowbase + 16 * (wid & 3) + (lane >> 2)) * 1024 + h * 128 + 64 + (wid >> 2) * 32 + (lane & 3) * 8;
#define ATT_DMA(t, buf) do { \
        __builtin_amdgcn_global_load_lds((const unsigned*)(ksrc + (size_t)(t) * 64 * 1024), (LAS unsigned*)(lds + (buf) * BUFB + wid * 1024), 16, 0, 0); \
        if (wid < 4) __builtin_amdgcn_global_load_lds((const unsigned*)(rsrc + (size_t)(t) * 64 * NPROJ), (LAS unsigned*)(lds + (buf) * BUFB + (8 + wid) * 1024), 16, 0, 0); \
        __builtin_amdgcn_global_load_lds((const unsigned*)(vsrc + (size_t)(t) * 64 * 1024), (LAS unsigned*)(lds + (buf) * BUFB + KSLOT + wid * 1024), 16, 0, 0); } while (0)
    float m_run = -INFINITY, l_run = 0.f; f32x16 o[2]; o[0] = f32x16{}; o[1] = f32x16{};
    const int vb0 = (int)(unsigned)(size_t)(lds + KSLOT) + ((lane >> 4) & 1) * 32 + (lane & 3) * 8 + (4 * hi + ((lane & 15) >> 2)) * 64;
    asm volatile("s_waitcnt vmcnt(0)" ::: "memory");
    ATT_DMA(0, 0);
    for (int t = 0; t < NT; ++t) {
        const int buf = t & 1;
        if (t + 1 < NT) { ATT_DMA(t + 1, buf ^ 1); if (wid < 4) asm volatile("s_waitcnt vmcnt(3)" ::: "memory"); else asm volatile("s_waitcnt vmcnt(2)" ::: "memory"); }
        else asm volatile("s_waitcnt vmcnt(0)" ::: "memory");
        __builtin_amdgcn_s_barrier(); asm volatile("" ::: "memory");
        if (t <= cw) {
            f32x16 p0 = f32x16{}, p1 = f32x16{};
            const LAS unsigned char* kb = lds + buf * BUFB + hi * 1024 + r32 * 16;
#pragma unroll
            for (int d0 = 0; d0 < 6; ++d0) {
                const bf16x8 b0 = *(const LAS bf16x8*)(kb + d0 * 2048), b1 = *(const LAS bf16x8*)(kb + d0 * 2048 + 512);
                p0 = __builtin_amdgcn_mfma_f32_32x32x16_bf16(b0, qr[d0], p0, 0, 0, 0); p1 = __builtin_amdgcn_mfma_f32_32x32x16_bf16(b1, qr[d0], p1, 0, 0, 0); }
            float rm = p0[0];
#pragma unroll
            for (int r = 1; r < 16; ++r) rm = fmaxf(rm, p0[r]);
#pragma unroll
            for (int r = 0; r < 16; ++r) rm = fmaxf(rm, p1[r]);
            { auto rr = __builtin_amdgcn_permlane32_swap(__float_as_uint(rm), __float_as_uint(rm), false, false); rm = fmaxf(__uint_as_float(rr[0]), __uint_as_float(rr[1])); }
            const float m_new = fmaxf(m_run, rm), sc = __builtin_amdgcn_exp2f(m_run - m_new); m_run = m_new;
            float ls = 0.f;
#pragma unroll
            for (int r = 0; r < 16; ++r) { p0[r] = __builtin_amdgcn_exp2f(p0[r] - m_new); p1[r] = __builtin_amdgcn_exp2f(p1[r] - m_new); ls += p0[r] + p1[r]; }
            l_run = l_run * sc + ls;
            if (hi == 0) wsf[r32] = sc;
            asm volatile("s_waitcnt lgkmcnt(0)" ::: "memory");
#pragma unroll
            for (int r = 0; r < 16; ++r) { const float f = wsf[crow(r, hi)]; o[0][r] *= f; o[1][r] *= f; }
            u32x4 pw0, pw1, pw2, pw3;
            pw0 = (u32x4){cvtpk(p0[0], p0[1]), cvtpk(p0[2], p0[3]), cvtpk(p0[4], p0[5]), cvtpk(p0[6], p0[7])};
            pw1 = (u32x4){cvtpk(p0[8], p0[9]), cvtpk(p0[10], p0[11]), cvtpk(p0[12], p0[13]), cvtpk(p0[14], p0[15])};
            pw2 = (u32x4){cvtpk(p1[0], p1[1]), cvtpk(p1[2], p1[3]), cvtpk(p1[4], p1[5]), cvtpk(p1[6], p1[7])};
            pw3 = (u32x4){cvtpk(p1[8], p1[9]), cvtpk(p1[10], p1[11]), cvtpk(p1[12], p1[13]), cvtpk(p1[14], p1[15])};
            pv(o, vb0 + buf * BUFB, __builtin_bit_cast(bf16x8, pw0), __builtin_bit_cast(bf16x8, pw1), __builtin_bit_cast(bf16x8, pw2), __builtin_bit_cast(bf16x8, pw3));
        }
        asm volatile("s_waitcnt lgkmcnt(0)" ::: "memory"); __builtin_amdgcn_s_barrier(); asm volatile("" ::: "memory");
    }
#undef ATT_DMA
    { auto rr = __builtin_amdgcn_permlane32_swap(__float_as_uint(l_run), __float_as_uint(l_run), false, false); l_run = __uint_as_float(rr[0]) + __uint_as_float(rr[1]); }
    if (hi == 0) wsf[32 + r32] = l_run;
    asm volatile("s_waitcnt lgkmcnt(0)" ::: "memory");
    LAS bf16_t* stg = (LAS bf16_t*)(lds + LDS_OST) + wid * 2048;
#pragma unroll
    for (int r = 0; r < 16; ++r) { const int orow = crow(r, hi); const float rl = __builtin_amdgcn_rcpf(wsf[32 + orow]);
        stg[orow * 64 + r32] = (bf16_t)f2bf(o[0][r] * rl); stg[orow * 64 + 32 + r32] = (bf16_t)f2bf(o[1][r] * rl); }
    asm volatile("s_waitcnt lgkmcnt(0)" ::: "memory");
    bf16_t* Ow = MIX + (rowbase + q0 + wid * 32) * 1024 + h * 64;
#pragma unroll
    for (int i = 0; i < 4; ++i) { const int row = i * 8 + (lane >> 3), ch = lane & 7; const u32x4 v = *(const LAS u32x4*)(stg + row * 64 + ch * 8);
        *(GAS u32x4*)(Ow + (size_t)row * 1024 + ch * 8) = v;
        float s = 0.f;
#pragma unroll
        for (int j = 0; j < 4; ++j) { const float a = __builtin_bit_cast(float, v[j] << 16), bb = __builtin_bit_cast(float, v[j] & 0xffff0000u); s += a * a + bb * bb; }
        s += __shfl_xor(s, 1); s += __shfl_xor(s, 2); s += __shfl_xor(s, 4);
        if (ch == 0) SSQ[(rowbase + q0 + wid * 32 + row) * 8 + h] = s; }
    asm volatile("s_waitcnt lgkmcnt(0)" ::: "memory"); __builtin_amdgcn_s_barrier(); asm volatile("" ::: "memory");
}
}

__device__ __forceinline__ void attn_normalise(Frame& F, const float* g) {
    F.refresh();
    bf16_t* MIX = (bf16_t*)(F.ws + WS_MIX); const float* SSQ = (const float*)(F.ws + WS_SSQ);
    const int gw = F.vcu * 8 + F.wave, NGW = F.G * 8;
    f32x4 g0 = *((const GAS f32x4*)g + 2 * F.lane), g1 = *((const GAS f32x4*)g + 2 * F.lane + 1);
    for (int m = gw; m < T; m += NGW) {
        const f32x4 s0 = *(const GAS f32x4*)(SSQ + (size_t)m * 8), s1 = *(const GAS f32x4*)(SSQ + (size_t)m * 8 + 4);
        const float tot = ((s0.x + s0.y) + (s0.z + s0.w)) + ((s1.x + s1.y) + (s1.z + s1.w));
        const float rs = 1.f / sqrtf(tot * (1.f / 512.f) + RMS_EPS);
        GAS u32x4* p = (GAS u32x4*)(MIX + (size_t)m * 1024) + F.lane;
        const u32x4 v = *p; u32x4 w;
        w.x = pk2(__builtin_bit_cast(float, v.x << 16) * rs * g0.x, __builtin_bit_cast(float, v.x & 0xffff0000u) * rs * g0.y);
        w.y = pk2(__builtin_bit_cast(float, v.y << 16) * rs * g0.z, __builtin_bit_cast(float, v.y & 0xffff0000u) * rs * g0.w);
        w.z = pk2(__builtin_bit_cast(float, v.z << 16) * rs * g1.x, __builtin_bit_cast(float, v.z & 0xffff0000u) * rs * g1.y);
        w.w = pk2(__builtin_bit_cast(float, v.w << 16) * rs * g1.z, __builtin_bit_cast(float, v.w & 0xffff0000u) * rs * g1.w);
        *p = w;
    }
}

namespace hg {
typedef float f32x16 __attribute__((ext_vector_type(16)));
typedef short s16x4 __attribute__((ext_vector_type(4)));
constexpr int OFF_QDEC = 0, OFF_QD1 = 16384, OFF_KD0 = 24576, OFF_KD1 = 32768, OFF_V = 49152, OFF_S = 65536, OFF_O = 98304, OFF_TOT = 132096;
constexpr int OPITCH = 132;
__device__ __forceinline__ int crow(int r, int hi) { return (r & 3) + 8 * (r >> 2) + 4 * hi; }
__device__ __forceinline__ bf16x8 trfrag(int base, int off) {
    s16x4 lo, hi;
    asm volatile("ds_read_b64_tr_b16 %0,%2\n\tds_read_b64_tr_b16 %1,%2 offset:512\n\ts_waitcnt lgkmcnt(0)" : "=&v"(lo), "=&v"(hi) : "v"(base + off) : "memory");
    return (bf16x8){lo[0], lo[1], lo[2], lo[3], hi[0], hi[1], hi[2], hi[3]};
}
__device__ __forceinline__ void dma_tl(const bf16_t* src, LAS unsigned char* img, int wid, int lane) {
#pragma unroll
    for (int i = 0; i < 2; ++i) { const int p = wid * 2 + i, cb = p >> 2, tg = p & 3;
        __builtin_amdgcn_global_load_lds((const unsigned*)(src + (size_t)(tg * 16 + (lane >> 2)) * NPROJ + cb * 32 + (lane & 3) * 8), (LAS unsigned*)(img + p * 1024), 16, 0, 0); }
}
__device__ __forceinline__ void cumsum16(const bf16_t* gsrc, int kcol, int seg, float (&g)[16], float (&b)[16], LAS float* tot, float& r1, float& blast) {
#pragma unroll
    for (int i = 0; i < 16; ++i) g[i] = bf2f(gsrc[(size_t)(seg * 16 + i) * NPROJ + kcol]);
    float run = 0.f;
#pragma unroll
    for (int i = 0; i < 16; ++i) { run += g[i]; b[i] = run; }
    tot[seg * 128 + kcol] = run;
    LDS_WAIT(); __syncthreads();
    const float t0 = tot[kcol], t1 = tot[128 + kcol], t2 = tot[256 + kcol], t3 = tot[384 + kcol];
    const float off = seg == 0 ? 0.f : seg == 1 ? t0 : seg == 2 ? t0 + t1 : t0 + t1 + t2;
    r1 = t0 + t1; blast = (t0 + t1) + (t2 + t3);
#pragma unroll
    for (int i = 0; i < 16; ++i) b[i] += off;
}
__device__ __forceinline__ void pass_a(int unit, const bf16_t* PROJ, float* LT, float* DEC, LAS unsigned char* lds, const int wid) {
    const int lane = fresh_lane(), tid = wid * 64 + lane, r32 = lane & 31, hi = lane >> 5;
    const int bh = unit >> 5, n = unit & 31, b_ = bh >> 2, h = bh & 3;
    const size_t tok0 = (size_t)b_ * SEQ + n * 64;
    LAS unsigned char* kimg = lds; LAS unsigned char* vimg = lds + 16384; LAS float* tot = (LAS float*)(lds + OFF_TOT);
    __syncthreads();
    dma_tl(PROJ + tok0 * NPROJ + PC_HI + h * 128, vimg, wid, lane);
    const int kcol = tid & 127, seg = tid >> 7;
    float g[16], b[16], r1, blast;
    cumsum16(PROJ + tok0 * NPROJ + PC_HF + h * 128, kcol, seg, g, b, tot, r1, blast);
#pragma unroll
    for (int i = 0; i < 16; ++i) { const float kd = (1.f - __expf(g[i])) * __expf(blast - b[i]);
        *(LAS bf16_t*)(kimg + ((kcol >> 5) * 4 + seg) * 1024 + i * 64 + (kcol & 31) * 2) = (bf16_t)f2bf(kd); }
    if (seg == 0) DEC[(size_t)unit * 128 + kcol] = __expf(blast);
    asm volatile("s_waitcnt vmcnt(0) lgkmcnt(0)" ::: "memory"); __syncthreads();
    const int lo_ = ((lane >> 4) & 1) * 32 + (lane & 3) * 8 + (4 * hi + ((lane & 15) >> 2)) * 64;
    const int vbase = (int)(unsigned)(size_t)vimg + lo_, kbase = (int)(unsigned)(size_t)kimg + lo_;
    const int vb = wid & 3;
    bf16x8 af[4];
#pragma unroll
    for (int ks = 0; ks < 4; ++ks) af[ks] = trfrag(vbase, vb * 4096 + ks * 1024);
#pragma unroll
    for (int j = 0; j < 2; ++j) { const int kb = (wid >> 2) * 2 + j; f32x16 acc = f32x16{};
#pragma unroll
        for (int ks = 0; ks < 4; ++ks) { const bf16x8 bfr = trfrag(kbase, kb * 4096 + ks * 1024); acc = __builtin_amdgcn_mfma_f32_32x32x16_bf16(af[ks], bfr, acc, 0, 0, 0); }
        float* dst = LT + (size_t)unit * 16384 + kb * 32 + r32;
#pragma unroll
        for (int r = 0; r < 16; ++r) dst[(size_t)(vb * 32 + crow(r, hi)) * 128] = acc[r]; }
}
__device__ __forceinline__ void pass_b(const float* LT, const float* DEC, bf16_t* SST, int gtid, int gthreads) {
    for (int i = gtid; i < 32 * 4096; i += gthreads) {
        const int bh = i >> 12, e4 = i & 4095, k4 = (e4 & 31) * 4;
        f32x4 S = (f32x4){0.f, 0.f, 0.f, 0.f};
#pragma unroll 4
        for (int n = 0; n < 32; ++n) { const size_t u = (size_t)bh * 32 + n;
            u32x2 w; w.x = pk2(S.x, S.y); w.y = pk2(S.z, S.w);
            *(GAS u32x2*)(SST + u * 16384 + (size_t)e4 * 4) = w;
            const f32x4 L = *(const GAS f32x4*)(LT + u * 16384 + (size_t)e4 * 4), Dv = *(const GAS f32x4*)(DEC + u * 128 + k4);
            S = Dv * S + L; }
    }
}
__device__ __forceinline__ void pass_c(int unit, const bf16_t* PROJ, const bf16_t* SST, const float* gout, bf16_t* MIX, LAS unsigned char* lds, const int wid) {
    const int lane = fresh_lane(), tid = wid * 64 + lane, r32 = lane & 31, hi = lane >> 5;
    const int bh = unit >> 5, n = unit & 31, b_ = bh >> 2, h = bh & 3;
    const size_t tok0 = (size_t)b_ * SEQ + n * 64;
    LAS float* tot = (LAS float*)(lds + OFF_TOT);
    __syncthreads();
    dma_tl(PROJ + tok0 * NPROJ + PC_HI + h * 128, lds + OFF_V, wid, lane);
    { const bf16_t* S = SST + (size_t)unit * 16384;
#pragma unroll
        for (int i = 0; i < 4; ++i) { const int p = wid * 4 + i, c = p >> 1, rh = p & 1;
            __builtin_amdgcn_global_load_lds((const unsigned*)(S + (size_t)(rh * 64 + lane) * 128 + c * 8), (LAS unsigned*)(lds + OFF_S + c * 2048 + rh * 1024), 16, 0, 0); } }
    const int kcol = tid & 127, seg = tid >> 7;
    float g[16], b[16], r1, blast;
    cumsum16(PROJ + tok0 * NPROJ + PC_HF + h * 128, kcol, seg, g, b, tot, r1, blast);
    { const bf16_t* qsrc = PROJ + tok0 * NPROJ + PC_HQ + h * 128 + kcol;
      const int cl = (kcol >> 3), ce = (kcol & 7) * 2;
#pragma unroll
      for (int i = 0; i < 16; ++i) { const int t = seg * 16 + i;
        const float q = bf2f(qsrc[(size_t)t * NPROJ]), kk = 1.f - __expf(g[i]);
        *(LAS bf16_t*)(lds + OFF_QDEC + cl * 1024 + t * 16 + ce) = (bf16_t)f2bf(q * __expf(b[i]));
        *(LAS bf16_t*)(lds + OFF_KD1 + cl * 1024 + t * 16 + ce) = (bf16_t)f2bf(kk * __expf(r1 - b[i]));
        if (seg < 2) *(LAS bf16_t*)(lds + OFF_KD0 + cl * 512 + t * 16 + ce) = (bf16_t)f2bf(kk * __expf(-b[i]));
        else *(LAS bf16_t*)(lds + OFF_QD1 + cl * 512 + (t - 32) * 16 + ce) = (bf16_t)f2bf(q * __expf(b[i] - r1)); } }
    asm volatile("s_waitcnt vmcnt(0) lgkmcnt(0)" ::: "memory"); __syncthreads();
    const int I = wid & 1, vb = wid >> 1;
    f32x16 o = f32x16{};
#pragma unroll
    for (int kk = 0; kk < 8; ++kk) {
        const bf16x8 a = *(const LAS bf16x8*)(lds + OFF_QDEC + (2 * kk + hi) * 1024 + (I * 32 + r32) * 16);
        const bf16x8 bb = *(const LAS bf16x8*)(lds + OFF_S + (2 * kk + hi) * 2048 + (vb * 32 + r32) * 16);
        o = __builtin_amdgcn_mfma_f32_32x32x16_bf16(a, bb, o, 0, 0, 0); }
    const int vbase = (int)(unsigned)(size_t)(lds + OFF_V) + ((lane >> 4) & 1) * 32 + (lane & 3) * 8 + (4 * hi + ((lane & 15) >> 2)) * 64;
    for (int J = 0; J <= I; ++J) {
        f32x16 st = f32x16{};
#pragma unroll
        for (int kk = 0; kk < 8; ++kk) {
            const bf16x8 a = (I == 0) ? *(const LAS bf16x8*)(lds + OFF_KD0 + (2 * kk + hi) * 512 + r32 * 16) : *(const LAS bf16x8*)(lds + OFF_KD1 + (2 * kk + hi) * 1024 + (J * 32 + r32) * 16);
            const bf16x8 bq = (I == 0) ? *(const LAS bf16x8*)(lds + OFF_QDEC + (2 * kk + hi) * 1024 + r32 * 16) : *(const LAS bf16x8*)(lds + OFF_QD1 + (2 * kk + hi) * 512 + r32 * 16);
            st = __builtin_amdgcn_mfma_f32_32x32x16_bf16(a, bq, st, 0, 0, 0); }
        if (J == I) {
#pragma unroll
            for (int r = 0; r < 16; ++r) if (crow(r, hi) > r32) st[r] = 0.f; }
        u32x4 pw0, pw1;
        pw0 = (u32x4){pk2(st[0], st[1]), pk2(st[2], st[3]), pk2(st[4], st[5]), pk2(st[6], st[7])};
        pw1 = (u32x4){pk2(st[8], st[9]), pk2(st[10], st[11]), pk2(st[12], st[13]), pk2(st[14], st[15])};
        const bf16x8 v0 = trfrag(vbase, vb * 4096 + (2 * J) * 1024), v1 = trfrag(vbase, vb * 4096 + (2 * J + 1) * 1024);
        o = __builtin_amdgcn_mfma_f32_32x32x16_bf16(__builtin_bit_cast(bf16x8, pw0), v0, o, 0, 0, 0);
        o = __builtin_amdgcn_mfma_f32_32x32x16_bf16(__builtin_bit_cast(bf16x8, pw1), v1, o, 0, 0, 0);
    }
    LAS float* ot = (LAS float*)(lds + OFF_O);
#pragma unroll
    for (int r = 0; r < 16; ++r) ot[(I * 32 + crow(r, hi)) * OPITCH + vb * 32 + r32] = o[r];
    LDS_WAIT(); __syncthreads();
#pragma unroll
    for (int it = 0; it < 2; ++it) { const int task = it * 512 + tid, t = task >> 4, c8 = (task & 15) * 8;
        const f32x4 x0 = *(const LAS f32x4*)(ot + t * OPITCH + c8), x1 = *(const LAS f32x4*)(ot + t * OPITCH + c8 + 4);
        float s = (x0.x * x0.x + x0.y * x0.y) + (x0.z * x0.z + x0.w * x0.w) + (x1.x * x1.x + x1.y * x1.y) + (x1.z * x1.z + x1.w * x1.w);
        s += __shfl_xor(s, 1); s += __shfl_xor(s, 2); s += __shfl_xor(s, 4); s += __shfl_xor(s, 8);
        const float rs = 1.f / sqrtf(s * (1.f / 128.f) + RMS_EPS);
        const f32x4 g0 = *(const GAS f32x4*)(gout + h * 128 + c8), g1 = *(const GAS f32x4*)(gout + h * 128 + c8 + 4);
        const u32x4 gt = *(const GAS u32x4*)(PROJ + (tok0 + t) * NPROJ + PC_HG + h * 128 + c8);
        u32x4 w;
        w.x = pk2(x0.x * rs * g0.x * __builtin_bit_cast(float, gt.x << 16), x0.y * rs * g0.y * __builtin_bit_cast(float, gt.x & 0xffff0000u));
        w.y = pk2(x0.z * rs * g0.z * __builtin_bit_cast(float, gt.y << 16), x0.w * rs * g0.w * __builtin_bit_cast(float, gt.y & 0xffff0000u));
        w.z = pk2(x1.x * rs * g1.x * __builtin_bit_cast(float, gt.z << 16), x1.y * rs * g1.y * __builtin_bit_cast(float, gt.z & 0xffff0000u));
        w.w = pk2(x1.z * rs * g1.z * __builtin_bit_cast(float, gt.w << 16), x1.w * rs * g1.w * __builtin_bit_cast(float, gt.w & 0xffff0000u));
        *(GAS u32x4*)(MIX + (tok0 + t) * 1024 + 512 + h * 128 + c8) = w; }
}
}

struct EpiY {
    static constexpr bool PERM = false;
    float* Y; const bf16_t* H0;
    __device__ __forceinline__ void operator()(const f32x4 (&acc)[2][2][4][2], const pg8::Unit& u, int wr, int wc, int fr, int fq) const {
#pragma unroll
        for (int ai = 0; ai < 2; ++ai)
#pragma unroll
            for (int m = 0; m < 4; ++m) { const size_t row = (size_t)u.pm * 256 + ai * 128 + wr * 64 + m * 16 + fr;
#pragma unroll
                for (int bj = 0; bj < 2; ++bj)
#pragma unroll
                    for (int n = 0; n < 2; ++n) { const int c = u.pn * 256 + bj * 128 + wc * 32 + 16 * n + 4 * fq;
                        const u32x2 hv = *(const u32x2*)(H0 + row * 1024 + c);
                        f32x4 o = acc[ai][bj][m][n];
                        o.x += DN_ALPHA * __builtin_bit_cast(float, hv.x << 16); o.y += DN_ALPHA * __builtin_bit_cast(float, hv.x & 0xffff0000u);
                        o.z += DN_ALPHA * __builtin_bit_cast(float, hv.y << 16); o.w += DN_ALPHA * __builtin_bit_cast(float, hv.y & 0xffff0000u);
                        *(f32x4*)(Y + row * 1024 + c) = o; } }
    }
};

__device__ __forceinline__ void p6_router(Frame& F, const Args& a) {
    F.refresh();
    typedef float f32x16 __attribute__((ext_vector_type(16)));
    const float* Y = (const float*)(F.ws + WS_Y); bf16_t* H1 = (bf16_t*)(F.ws + WS_H1);
    const float* g = (const float*)a.in[13]; const float* bta = (const float*)a.in[14]; const float* br = (const float*)a.in[16];
    constexpr int APITCH = 2064, A_LO = 32 * APITCH;
    LAS unsigned* cnt = (LAS unsigned*)(F.lds + XTRA_OFF + 2048); LAS unsigned* base = cnt + 32;
    LAS int* asg_e = (LAS int*)(cnt + 64); LAS int* asg_r = asg_e + 256; LAS float* asg_g = (LAS float*)(asg_r + 256);
    LAS float* part = (LAS float*)F.lds; LAS float* logit = part + 8 * 1024;
    if (F.tid < 32) cnt[F.tid] = 0u;
    const int e = F.lane & 31, hi = F.lane >> 5, r32 = e, k0 = F.wave * 128;
    bf16x8 Bh[8], Bl[8];
    { const bf16_t* wh = (const bf16_t*)(F.ws + WS_WRH) + (size_t)e * 1024 + k0 + 8 * hi; const bf16_t* wl = (const bf16_t*)(F.ws + WS_WRL) + (size_t)e * 1024 + k0 + 8 * hi;
#pragma unroll
      for (int kk = 0; kk < 8; ++kk) { Bh[kk] = *(const GAS bf16x8*)(wh + 16 * kk); Bl[kk] = *(const GAS bf16x8*)(wl + 16 * kk); } }
    const float be = br[e];
    for (int p = 0; p < 2; ++p) {
        __syncthreads();
#pragma unroll
        for (int r = 0; r < 4; ++r) {
            const int rb = F.wave * 4 + r; const size_t row = (size_t)F.vcu * 64 + p * 32 + rb;
            const GAS f32x4* yr = (const GAS f32x4*)(Y + row * 1024) + F.lane;
            f32x4 v[4]; float s = 0.f;
#pragma unroll
            for (int j = 0; j < 4; ++j) { v[j] = yr[64 * j]; s += (v[j].x + v[j].y) + (v[j].z + v[j].w); }
            const float mean = wave_sum(s) * (1.f / D); float s2 = 0.f;
#pragma unroll
            for (int j = 0; j < 4; ++j) { v[j] = v[j] - mean; s2 += (v[j].x * v[j].x + v[j].y * v[j].y) + (v[j].z * v[j].z + v[j].w * v[j].w); }
            const float rstd = 1.f / sqrtf(wave_sum(s2) * (1.f / D) + LN_EPS);
            GAS unsigned long long* o8 = (GAS unsigned long long*)(H1 + row * 1024) + F.lane;
#pragma unroll
            for (int j = 0; j < 4; ++j) { const f32x4 gg = *((const GAS f32x4*)g + F.lane + 64 * j), bb = *((const GAS f32x4*)bta + F.lane + 64 * j);
                const f32x4 o = v[j] * rstd * gg + bb;
                const unsigned h0 = f2bf(o.x), h1_ = f2bf(o.y), h2 = f2bf(o.z), h3 = f2bf(o.w);
                const unsigned long long hw = (unsigned long long)(h0 | (h1_ << 16)) | ((unsigned long long)(h2 | (h3 << 16)) << 32);
                o8[64 * j] = hw;
#if MOE_FP8
                *((GAS unsigned*)((unsigned char*)(F.ws + WS_H1F8) + row * 1024) + F.lane + 64 * j) = pk4_fp8(o.x, o.y, o.z, o.w);
#endif
                const unsigned l0 = pk2(o.x - __builtin_bit_cast(float, h0 << 16), o.y - __builtin_bit_cast(float, h1_ << 16)), l1 = pk2(o.z - __builtin_bit_cast(float, h2 << 16), o.w - __builtin_bit_cast(float, h3 << 16));
                *(LAS unsigned long long*)(F.lds + rb * APITCH + 8 * (F.lane + 64 * j)) = hw;
                *(LAS unsigned long long*)(F.lds + A_LO + rb * APITCH + 8 * (F.lane + 64 * j)) = (unsigned long long)l0 | ((unsigned long long)l1 << 32); }
        }
        LDS_WAIT(); __syncthreads();
        f32x16 acc = f32x16{};
#pragma unroll
        for (int kk = 0; kk < 8; ++kk) {
            const bf16x8 ah = *(const LAS bf16x8*)(F.lds + r32 * APITCH + (k0 + 16 * kk + 8 * hi) * 2), al = *(const LAS bf16x8*)(F.lds + A_LO + r32 * APITCH + (k0 + 16 * kk + 8 * hi) * 2);
            acc = __builtin_amdgcn_mfma_f32_32x32x16_bf16(ah, Bh[kk], acc, 0, 0, 0);
            acc = __builtin_amdgcn_mfma_f32_32x32x16_bf16(ah, Bl[kk], acc, 0, 0, 0);
            acc = __builtin_amdgcn_mfma_f32_32x32x16_bf16(al, Bh[kk], acc, 0, 0, 0); }
        LDS_WAIT(); __syncthreads();
#pragma unroll
        for (int r = 0; r < 16; ++r) part[F.wave * 1024 + ((r & 3) + 8 * (r >> 2) + 4 * hi) * 32 + r32] = acc[r];
        LDS_WAIT(); __syncthreads();
#pragma unroll
        for (int q = 0; q < 2; ++q) { const int o = q * 512 + F.tid; float s = 0.f;
#pragma unroll
            for (int w = 0; w < 8; ++w) s += part[w * 1024 + o];
            logit[o] = s; }
        LDS_WAIT(); __syncthreads();
#pragma unroll
        for (int r = 0; r < 4; ++r) {
            const int rb = F.wave * 4 + r;
            float val = logit[rb * 32 + e] + be;
            int se[4]; float sl[4];
#pragma unroll
            for (int k = 0; k < 4; ++k) { float bv = val; int bi = e;
#pragma unroll
                for (int o = 1; o < 32; o <<= 1) { const float ov = __shfl_xor(bv, o); const int oi = __shfl_xor(bi, o); if (ov > bv || (ov == bv && oi < bi)) { bv = ov; bi = oi; } }
                se[k] = bi; sl[k] = bv; if (e == bi) val = -INFINITY; }
            const float e1 = __expf(sl[1] - sl[0]), e2 = __expf(sl[2] - sl[0]), e3 = __expf(sl[3] - sl[0]); const float inv = 1.f / (1.f + e1 + e2 + e3);
            const float gk[4] = {inv, e1 * inv, e2 * inv, e3 * inv};
            if (F.lane < 4) { const int k = F.lane; const int ee = k == 0 ? se[0] : k == 1 ? se[1] : k == 2 ? se[2] : se[3]; const float gg = k == 0 ? gk[0] : k == 1 ? gk[1] : k == 2 ? gk[2] : gk[3];
                const unsigned rank = __hip_atomic_fetch_add(&cnt[ee], 1u, __ATOMIC_RELAXED, __HIP_MEMORY_SCOPE_WORKGROUP); const int ai = (p * 32 + rb) * 4 + k;
                asg_e[ai] = ee; asg_r[ai] = (int)rank; asg_g[ai] = gg; }
        }
    }
    LDS_WAIT(); __syncthreads();
    F.refresh();
    if (F.tid < 32) base[F.tid] = __hip_atomic_fetch_add((unsigned*)(F.ctl + CW_CNT) + F.tid, cnt[F.tid], __ATOMIC_RELAXED, __HIP_MEMORY_SCOPE_AGENT);
    __syncthreads();
    if (F.tid < 256) { const int ee = asg_e[F.tid]; const int pos = (int)base[ee] + asg_r[F.tid]; const int tok = F.vcu * 64 + (F.tid >> 2);
        ((int*)(F.ws + WS_LTOK))[(size_t)ee * T + pos] = tok; ((float*)(F.ws + WS_LGATE))[(size_t)ee * T + pos] = asg_g[F.tid];
        ((int*)(F.ws + WS_TSLOT))[(size_t)tok * 4 + (F.tid & 3)] = (ee << 16) | pos; }
}
__device__ __forceinline__ void moe_table(Frame& F) {
    F.refresh();
    LAS int* cnt = (LAS int*)(F.lds + XTRA_OFF + 4096); LAS int* tstart = cnt + 32;
    if (F.tid < 32) cnt[F.tid] = (int)__hip_atomic_load(F.ctl + CW_CNT + F.tid, RLX_AGENT);
    __syncthreads();
    if (F.tid == 0) { int s = 0; for (int e = 0; e < 32; ++e) { tstart[e] = s; s += (cnt[e] + 255) >> 8; } tstart[32] = s; }
    __syncthreads();
}
template <bool GATH>
struct MoeOrder {
    const void* A; const void* Bt; int lda, K, npn, G, c; size_t bstride; const LAS int* cnt; const LAS int* tstart; const int* list; int esz;
    static constexpr bool GATHER = GATH;
    __device__ __forceinline__ bool next(int i, pg8::Unit& u) const {
        const int L = i * G + c; const int rt = L / npn;
        if (rt >= tstart[32]) return false;
        int e = 0; while (rt >= tstart[e + 1]) ++e;
        u.pm = rt; u.pn = L - rt * npn; u.e = e; return true;
    }
    __device__ __forceinline__ const char* a_base(const pg8::Unit& u) const { return GATH ? (const char*)A : (const char*)A + (size_t)u.pm * 256 * lda * esz; }
    __device__ __forceinline__ const char* b_base(const pg8::Unit& u) const { return (const char*)Bt + ((size_t)u.e * bstride + (size_t)u.pn * 256 * K) * esz; }
    __device__ __forceinline__ void a_offs(const pg8::Unit& u, const int (&R)[2], const int (&C)[2], unsigned (&v)[2][2]) const {
#pragma unroll
        for (int h = 0; h < 2; ++h)
#pragma unroll
            for (int i = 0; i < 2; ++i) {
                if (GATH) { const int slot = (u.pm - tstart[u.e]) * 256 + h * 128 + R[i]; const int tok = slot < cnt[u.e] ? list[(size_t)u.e * T + slot] : 0; v[h][i] = (unsigned)(tok * lda * esz + C[i] * 2); }
                else v[h][i] = (unsigned)((h * 128 + R[i]) * lda * esz + C[i] * 2); }
    }
};
constexpr float SW_LIMIT = 7.0f, SW_ALPHA = 1.702f;
#if !MOE_FP8
struct EpiUp {
    static constexpr bool PERM = true;
    bf16_t* ACT; const float* bup;
    __device__ __forceinline__ void operator()(const f32x4 (&acc)[2][2][4][2], const pg8::Unit& u, int wr, int wc, int fr, int fq) const {
        const int c8 = wc * 32 + 8 * fq; const float* bg = bup + (size_t)u.e * 2048 + u.pn * 128 + c8; const float* bl = bg + 1024;
        const f32x4 bg0 = *(const f32x4*)bg, bg1 = *(const f32x4*)(bg + 4), bl0 = *(const f32x4*)bl, bl1 = *(const f32x4*)(bl + 4);
#pragma unroll
        for (int ai = 0; ai < 2; ++ai)
#pragma unroll
            for (int m = 0; m < 4; ++m) { const size_t row = (size_t)u.pm * 256 + ai * 128 + wr * 64 + m * 16 + fr;
                float v[8];
#pragma unroll
                for (int j = 0; j < 8; ++j) { float gl = (j < 4 ? acc[ai][0][m][0][j] + bg0[j] : acc[ai][0][m][1][j - 4] + bg1[j - 4]), li = (j < 4 ? acc[ai][1][m][0][j] + bl0[j] : acc[ai][1][m][1][j - 4] + bl1[j - 4]);
                    gl = fminf(gl, SW_LIMIT); li = fminf(fmaxf(li, -SW_LIMIT), SW_LIMIT);
                    v[j] = gl * __builtin_amdgcn_rcpf(1.f + __expf(-SW_ALPHA * gl)) * (li + 1.f); }
                u32x4 w; w.x = pk2(v[0], v[1]); w.y = pk2(v[2], v[3]); w.z = pk2(v[4], v[5]); w.w = pk2(v[6], v[7]);
                *(u32x4*)(ACT + row * 1024 + u.pn * 128 + c8) = w; }
    }
};
struct EpiDown {
    static constexpr bool PERM = true;
    bf16_t* YS; const float* bdn; const float* lgate; const LAS int* cnt; const LAS int* tstart;
    __device__ __forceinline__ void operator()(const f32x4 (&acc)[2][2][4][2], const pg8::Unit& u, int wr, int wc, int fr, int fq) const {
        const int nvalid = cnt[u.e] - (u.pm - tstart[u.e]) * 256;
#pragma unroll
        for (int ai = 0; ai < 2; ++ai)
#pragma unroll
            for (int m = 0; m < 4; ++m) { const int rl = ai * 128 + wr * 64 + m * 16 + fr; const size_t row = (size_t)u.pm * 256 + rl;
                const float gt = rl < nvalid ? lgate[(size_t)u.e * T + (u.pm - tstart[u.e]) * 256 + rl] : 0.f;
#pragma unroll
                for (int bj = 0; bj < 2; ++bj) { const int c0 = u.pn * 256 + bj * 128 + wc * 32 + 8 * fq; const float* bp = bdn + (size_t)u.e * 1024 + c0;
                    const f32x4 b0 = *(const f32x4*)bp, b1 = *(const f32x4*)(bp + 4);
                    u32x4 w; w.x = pk2((acc[ai][bj][m][0][0] + b0.x) * gt, (acc[ai][bj][m][0][1] + b0.y) * gt); w.y = pk2((acc[ai][bj][m][0][2] + b0.z) * gt, (acc[ai][bj][m][0][3] + b0.w) * gt);
                    w.z = pk2((acc[ai][bj][m][1][0] + b1.x) * gt, (acc[ai][bj][m][1][1] + b1.y) * gt); w.w = pk2((acc[ai][bj][m][1][2] + b1.z) * gt, (acc[ai][bj][m][1][3] + b1.w) * gt);
                    *(u32x4*)(YS + row * 1024 + c0) = w; } }
    }
};
#else
struct EpiUp {
    static constexpr bool PERM = true;
    unsigned char* ACT; const float* bup;
    __device__ __forceinline__ void operator()(const f32x4 (&acc)[2][2][4][2], const pg8::Unit& u, int wr, int wc, int fr, int fq) const {
        const int c8 = wc * 32 + 8 * fq; const float* bg = bup + (size_t)u.e * 2048 + u.pn * 128 + c8; const float* bl = bg + 1024;
        const f32x4 bg0 = *(const f32x4*)bg, bg1 = *(const f32x4*)(bg + 4), bl0 = *(const f32x4*)bl, bl1 = *(const f32x4*)(bl + 4);
        constexpr float IS = 1.f / W8_SCALE;
#pragma unroll
        for (int ai = 0; ai < 2; ++ai)
#pragma unroll
            for (int m = 0; m < 4; ++m) { const size_t row = (size_t)u.pm * 256 + ai * 128 + wr * 64 + m * 16 + fr;
                float v[8];
#pragma unroll
                for (int j = 0; j < 8; ++j) { float gl = (j < 4 ? acc[ai][0][m][0][j] * IS + bg0[j] : acc[ai][0][m][1][j - 4] * IS + bg1[j - 4]), li = (j < 4 ? acc[ai][1][m][0][j] * IS + bl0[j] : acc[ai][1][m][1][j - 4] * IS + bl1[j - 4]);
                    gl = fminf(gl, SW_LIMIT); li = fminf(fmaxf(li, -SW_LIMIT), SW_LIMIT);
                    v[j] = ACT8_SCALE * gl * __builtin_amdgcn_rcpf(1.f + __expf(-SW_ALPHA * gl)) * (li + 1.f); }
                u32x2 w; w.x = pk4_fp8(v[0], v[1], v[2], v[3]); w.y = pk4_fp8(v[4], v[5], v[6], v[7]);
                *(u32x2*)(ACT + row * 1024 + u.pn * 128 + c8) = w; }
    }
};
struct EpiDown {
    static constexpr bool PERM = true;
    bf16_t* YS; const float* bdn; const float* lgate; const LAS int* cnt; const LAS int* tstart;
    __device__ __forceinline__ void operator()(const f32x4 (&acc)[2][2][4][2], const pg8::Unit& u, int wr, int wc, int fr, int fq) const {
        const int nvalid = cnt[u.e] - (u.pm - tstart[u.e]) * 256;
        constexpr float IS = 1.f / (W8_SCALE * ACT8_SCALE);
#pragma unroll
        for (int ai = 0; ai < 2; ++ai)
#pragma unroll
            for (int m = 0; m < 4; ++m) { const int rl = ai * 128 + wr * 64 + m * 16 + fr; const size_t row = (size_t)u.pm * 256 + rl;
                const float gt = rl < nvalid ? lgate[(size_t)u.e * T + (u.pm - tstart[u.e]) * 256 + rl] : 0.f;
#pragma unroll
                for (int bj = 0; bj < 2; ++bj) { const int c0 = u.pn * 256 + bj * 128 + wc * 32 + 8 * fq; const float* bp = bdn + (size_t)u.e * 1024 + c0;
                    const f32x4 b0 = *(const f32x4*)bp, b1 = *(const f32x4*)(bp + 4);
                    u32x4 w; w.x = pk2((acc[ai][bj][m][0][0] * IS + b0.x) * gt, (acc[ai][bj][m][0][1] * IS + b0.y) * gt); w.y = pk2((acc[ai][bj][m][0][2] * IS + b0.z) * gt, (acc[ai][bj][m][0][3] * IS + b0.w) * gt);
                    w.z = pk2((acc[ai][bj][m][1][0] * IS + b1.x) * gt, (acc[ai][bj][m][1][1] * IS + b1.y) * gt); w.w = pk2((acc[ai][bj][m][1][2] * IS + b1.z) * gt, (acc[ai][bj][m][1][3] * IS + b1.w) * gt);
                    *(u32x4*)(YS + row * 1024 + c0) = w; } }
    }
};
#endif
__device__ __forceinline__ void p9_final(Frame& F, const Args& a) {
    F.refresh();
    const LAS int* tstart = (const LAS int*)(F.lds + XTRA_OFF + 4096) + 32;
    const bf16_t* H1 = (const bf16_t*)(F.ws + WS_H1); const bf16_t* YS = (const bf16_t*)(F.ws + WS_YS); const int* ts = (const int*)(F.ws + WS_TSLOT);
    const float* g = (const float*)a.in[21]; const float* bta = (const float*)a.in[22];
    const int gw = F.vcu * 8 + F.wave, NGW = F.G * 8;
    for (int m = gw; m < T; m += NGW) {
        float v[16];
#pragma unroll
        for (int j = 0; j < 2; ++j) { const u32x4 h = *(const GAS u32x4*)(H1 + (size_t)m * 1024 + 512 * j + 8 * F.lane);
#pragma unroll
            for (int q = 0; q < 4; ++q) { v[8 * j + 2 * q] = DN_ALPHA * __builtin_bit_cast(float, h[q] << 16); v[8 * j + 2 * q + 1] = DN_ALPHA * __builtin_bit_cast(float, h[q] & 0xffff0000u); } }
#pragma unroll
        for (int k = 0; k < 4; ++k) { const int sl = ts[(size_t)m * 4 + k]; const size_t row = (size_t)tstart[sl >> 16] * 256 + (sl & 0xffff);
#pragma unroll
            for (int j = 0; j < 2; ++j) { const u32x4 y = *(const GAS u32x4*)(YS + row * 1024 + 512 * j + 8 * F.lane);
#pragma unroll
                for (int q = 0; q < 4; ++q) { v[8 * j + 2 * q] += __builtin_bit_cast(float, y[q] << 16); v[8 * j + 2 * q + 1] += __builtin_bit_cast(float, y[q] & 0xffff0000u); } } }
        float s = 0.f;
#pragma unroll
        for (int i = 0; i < 16; ++i) s += v[i];
        const float mean = wave_sum(s) * (1.f / D); float s2 = 0.f;
#pragma unroll
        for (int i = 0; i < 16; ++i) { v[i] -= mean; s2 += v[i] * v[i]; }
        const float rstd = 1.f / sqrtf(wave_sum(s2) * (1.f / D) + LN_EPS);
#pragma unroll
        for (int j = 0; j < 2; ++j)
#pragma unroll
            for (int q = 0; q < 2; ++q) { const int c = 512 * j + 8 * F.lane + 4 * q; const f32x4 gg = *(const GAS f32x4*)(g + c), bb = *(const GAS f32x4*)(bta + c);
                f32x4 o; o.x = v[8 * j + 4 * q] * rstd * gg.x + bb.x; o.y = v[8 * j + 4 * q + 1] * rstd * gg.y + bb.y; o.z = v[8 * j + 4 * q + 2] * rstd * gg.z + bb.z; o.w = v[8 * j + 4 * q + 3] * rstd * gg.w + bb.w;
                *(GAS f32x4*)(a.out + (size_t)m * 1024 + c) = o; }
    }
}

__device__ __forceinline__ void dbg_fail(Frame& F, int id) { atomicOr((unsigned*)(F.ctl + CW_DBG), 1u << id); }
__device__ __forceinline__ bool close_enough(float got, float want, float atol, float rtol) { const float d = fabsf(got - want); return d <= atol + rtol * fabsf(want); }
__device__ __forceinline__ void dbg_check_proj(Frame& F, const Args& a) {
    F.refresh();
    const int NS = 16;
    if (F.vcu >= NS) return;
    const int row = (F.vcu * 1093 + 7) % T;
    const float* x = (const float*)a.in[0] + (size_t)row * D; const float* g = (const float*)a.in[2]; const float* b = (const float*)a.in[3];
    const float* w_in = (const float*)a.in[4]; const int* pos = (const int*)a.in[1]; const float* lbl = (const float*)a.in[9];
    LAS float* h = (LAS float*)F.lds; LAS float* red = h + 1024;
    float s = 0.f; for (int k = F.tid; k < D; k += 512) s += x[k];
    s = wave_sum(s); if (F.lane == 0) red[F.wave] = s; __syncthreads();
    float mean = 0.f; for (int w = 0; w < 8; ++w) mean += red[w]; mean *= (1.f / D); __syncthreads();
    float q = 0.f; for (int k = F.tid; k < D; k += 512) { const float d = x[k] - mean; q += d * d; }
    q = wave_sum(q); if (F.lane == 0) red[F.wave] = q; __syncthreads();
    float var = 0.f; for (int w = 0; w < 8; ++w) var += red[w]; var *= (1.f / D);
    const float rstd = 1.f / sqrtf(var + LN_EPS);
    const bf16_t* H0 = (const bf16_t*)(F.ws + WS_H0) + (size_t)row * D;
    for (int k = F.tid; k < D; k += 512) { const float hv = (x[k] - mean) * rstd * g[k] + b[k]; h[k] = hv; if (!close_enough(bf2f(H0[k]), hv, 0.02f, 0.01f)) dbg_fail(F, 1); }
    __syncthreads();
    const bf16_t* P = (const bf16_t*)(F.ws + WS_PROJ) + (size_t)row * NPROJ;
    for (int n = F.tid; n < IN_COLS; n += 512) {
        float acc = 0.f; for (int k = 0; k < D; ++k) acc += h[k] * w_in[(size_t)k * IN_COLS + n];
        float want; int c;
        if (n < 384) { c = PC_QA + n; want = acc; }
        else if (n < 640) { c = PC_KVA + (n - 384); want = acc; }
        else if (n < 672) {
            const int j = n - 640, i = j & 15, half = j >> 4; const int n2 = 640 + (1 - half) * 16 + i;
            float acc2 = 0.f; for (int k = 0; k < D; ++k) acc2 += h[k] * w_in[(size_t)k * IN_COLS + n2];
            const float inv = powf(10000.0f, -(float)(2 * i) / 32.0f); const float ang = (float)pos[row] * inv;
            const float cc = cosf(ang), ss = sinf(ang);
            const float x1 = half == 0 ? acc : acc2, x2 = half == 0 ? acc2 : acc;
            want = half == 0 ? x1 * cc - x2 * ss : x1 * ss + x2 * cc; c = PC_KR + 2 * i + half; }
        else if (n < 1184) { c = PC_HQ + (n - 672); want = acc / (1.f + expf(-acc)); }
        else if (n < 1696) { const int cc_ = n - 1184; c = PC_HF + cc_; const float lb = 1.f / (1.f + expf(lbl[512 + cc_] - lbl[cc_])); const float sg = 1.f / (1.f + expf(-acc)); want = logf(lb + (1.f - lb) * sg); }
        else if (n < 2208) { c = PC_HI + (n - 1696); want = acc; }
        else { c = PC_HG + (n - 2208); want = acc / (1.f + expf(-acc)); }
        if (!close_enough(bf2f(P[c]), want, 0.03f, 0.02f)) dbg_fail(F, 2);
    }
    for (int c = 672 + F.tid; c < 768; c += 512) if (bf2f(P[c]) != 0.f) dbg_fail(F, 3);
}
__device__ __forceinline__ void dbg_check_qkv(Frame& F, const Args& a) {
    F.refresh();
    const int NS = 16;
    if (F.vcu >= NS) return;
    const int row = (F.vcu * 2731 + 11) % T;
    const bf16_t* P = (const bf16_t*)(F.ws + WS_PROJ) + (size_t)row * NPROJ;
    const float* qg = (const float*)a.in[5]; const float* w_qb = (const float*)a.in[6]; const float* kvg = (const float*)a.in[7]; const float* w_kvb = (const float*)a.in[8];
    const int* pos = (const int*)a.in[1];
    LAS float* qa = (LAS float*)F.lds; LAS float* kva = qa + 384; LAS float* qraw = kva + 256;
    float sq = 0.f, sk = 0.f;
    for (int k = 0; k < 384; ++k) { const float v = bf2f(P[PC_QA + k]); sq += v * v; }
    for (int k = 0; k < 256; ++k) { const float v = bf2f(P[PC_KVA + k]); sk += v * v; }
    const float rq = 1.f / sqrtf(sq / 384.f + RMS_EPS), rk = 1.f / sqrtf(sk / 256.f + RMS_EPS);
    for (int k = F.tid; k < 384; k += 512) qa[k] = bf2f(P[PC_QA + k]) * rq * qg[k];
    for (int k = F.tid; k < 256; k += 512) kva[k] = bf2f(P[PC_KVA + k]) * rk * kvg[k];
    __syncthreads();
    for (int n = F.tid; n < 768; n += 512) { float acc = 0.f; for (int k = 0; k < 384; ++k) acc += qa[k] * w_qb[(size_t)k * 768 + n]; qraw[n] = acc; }
    __syncthreads();
    const bf16_t* Qb = (const bf16_t*)(F.ws + WS_Q) + (size_t)row * 768;
    for (int n = F.tid; n < 768; n += 512) {
        const int h = n / 96, d = n % 96; float want; int c;
        if (d < 64) { want = qraw[n]; c = n; }
        else { const int j = d - 64, i = j & 15, half = j >> 4; const float x1 = qraw[h * 96 + 64 + i], x2 = qraw[h * 96 + 80 + i];
            const float inv = powf(10000.0f, -(float)(2 * i) / 32.0f); const float ang = (float)pos[row] * inv; const float cc = cosf(ang), ss = sinf(ang);
            want = half == 0 ? x1 * cc - x2 * ss : x1 * ss + x2 * cc; c = h * 96 + 64 + 2 * i + half; }
        want *= QSCALE;
        if (!close_enough(bf2f(Qb[c]), want, 0.006f, 0.02f)) dbg_fail(F, 4);
    }
    const bf16_t* KVb = (const bf16_t*)(F.ws + WS_KV) + (size_t)row * 1024;
    for (int n = F.tid; n < 1024; n += 512) { float acc = 0.f; for (int k = 0; k < 256; ++k) acc += kva[k] * w_kvb[(size_t)k * 1024 + n];
        if (!close_enough(bf2f(KVb[n]), acc, 0.03f, 0.02f)) dbg_fail(F, 5); }
    __syncthreads();
}
__device__ __forceinline__ void dbg_check_attn(Frame& F) {
    F.refresh();
    const int NS = 64;
    if (F.vcu >= NS) return;
    const int t = (F.vcu * 4099 + 5 * F.vcu * F.vcu + 63) % T, h = F.vcu & 7;
    const int b = t / SEQ, tl = t % SEQ, nk = ((tl >> 6) + 1) * 64;
    const bf16_t* Q = (const bf16_t*)(F.ws + WS_Q) + (size_t)t * 768 + h * 96;
    const bf16_t* KV = (const bf16_t*)(F.ws + WS_KV) + (size_t)b * SEQ * 1024 + h * 128;
    const bf16_t* PR = (const bf16_t*)(F.ws + WS_PROJ) + (size_t)b * SEQ * NPROJ + PC_KR;
    LAS float* sc = (LAS float*)F.lds; LAS float* red = sc + 2048; LAS float* ov = red + 16;
    float mx = -INFINITY;
    for (int j = F.tid; j < nk; j += 512) { float s = 0.f;
        for (int d = 0; d < 64; ++d) s += bf2f(Q[d]) * bf2f(KV[(size_t)j * 1024 + d]);
        for (int d = 0; d < 32; ++d) s += bf2f(Q[64 + d]) * bf2f(PR[(size_t)j * NPROJ + d]);
        sc[j] = s; mx = fmaxf(mx, s); }
    for (int o = 1; o < 64; o <<= 1) mx = fmaxf(mx, __shfl_xor(mx, o));
    if (F.lane == 0) red[F.wave] = mx; __syncthreads();
    mx = red[0]; for (int w = 1; w < 8; ++w) mx = fmaxf(mx, red[w]); __syncthreads();
    float sm = 0.f;
    for (int j = F.tid; j < nk; j += 512) { const float p = exp2f(sc[j] - mx); sc[j] = p; sm += p; }
    sm = wave_sum(sm); if (F.lane == 0) red[F.wave] = sm; __syncthreads();
    float tot = 0.f; for (int w = 0; w < 8; ++w) tot += red[w];
    const bf16_t* M = (const bf16_t*)(F.ws + WS_MIX) + (size_t)t * 1024 + h * 64;
    if (F.tid < 64) { float acc = 0.f; for (int j = 0; j < nk; ++j) acc += sc[j] * bf2f(KV[(size_t)j * 1024 + 64 + F.tid]); acc /= tot; ov[F.tid] = acc;
        if (!close_enough(bf2f(M[F.tid]), acc, 0.01f, 0.03f)) dbg_fail(F, 6); }
    __syncthreads();
    if (F.tid == 0) { float s = 0.f; for (int d = 0; d < 64; ++d) s += ov[d] * ov[d]; const float got = ((const float*)(F.ws + WS_SSQ))[(size_t)t * 8 + h];
        if (!close_enough(got, s, 0.002f, 0.05f)) dbg_fail(F, 7); }
    __syncthreads();
}
__device__ __forceinline__ void dbg_check_norm(Frame& F, const float* g) {
    F.refresh();
    if (F.vcu >= 16 || F.tid != 0) return;
    const int t = (F.vcu * 1021 + 3) % T; const bf16_t* M = (const bf16_t*)(F.ws + WS_MIX) + (size_t)t * 1024;
    float s = 0.f; for (int c = 0; c < 512; ++c) { const float v = bf2f(M[c]) / g[c]; s += v * v; }
    if (!close_enough(s / 512.f, 1.f, 0.02f, 0.f)) dbg_fail(F, 8);
}
__device__ __forceinline__ void dbg_check_hgrn(Frame& F, const float* gout) {
    F.refresh();
    if (F.vcu >= 8) return;
    const int sidx = F.vcu * 8 + F.wave;
    const int tl = (sidx * 397 + 61 * (sidx & 7) + 5) % SEQ, b = sidx & 7, h = (sidx >> 3) & 3;
    const bf16_t* P = (const bf16_t*)(F.ws + WS_PROJ) + (size_t)b * SEQ * NPROJ;
    const int k0 = F.lane, k1 = F.lane + 64;
    const float q0 = bf2f(P[(size_t)tl * NPROJ + PC_HQ + h * 128 + k0]), q1 = bf2f(P[(size_t)tl * NPROJ + PC_HQ + h * 128 + k1]);
    float dec0 = 1.f, dec1 = 1.f, o0 = 0.f, o1 = 0.f;
    for (int s = tl; s >= 0; --s) {
        const bf16_t* ps = P + (size_t)s * NPROJ;
        const float g0 = bf2f(ps[PC_HF + h * 128 + k0]), g1 = bf2f(ps[PC_HF + h * 128 + k1]);
        float c = q0 * (1.f - expf(g0)) * dec0 + q1 * (1.f - expf(g1)) * dec1;
        c = wave_sum(c);
        o0 += c * bf2f(ps[PC_HI + h * 128 + k0]); o1 += c * bf2f(ps[PC_HI + h * 128 + k1]);
        dec0 *= expf(g0); dec1 *= expf(g1);
    }
    const float ss = wave_sum(o0 * o0 + o1 * o1), rs = 1.f / sqrtf(ss / 128.f + RMS_EPS);
    const bf16_t* pt = P + (size_t)tl * NPROJ;
    const float w0 = o0 * rs * gout[h * 128 + k0] * bf2f(pt[PC_HG + h * 128 + k0]), w1 = o1 * rs * gout[h * 128 + k1] * bf2f(pt[PC_HG + h * 128 + k1]);
    const bf16_t* M = (const bf16_t*)(F.ws + WS_MIX) + ((size_t)b * SEQ + tl) * 1024 + 512 + h * 128;
    if (!close_enough(bf2f(M[k0]), w0, 0.03f, 0.04f) || !close_enough(bf2f(M[k1]), w1, 0.03f, 0.04f)) dbg_fail(F, 9);
}
__device__ __forceinline__ void dbg_check_router(Frame& F, const Args& a) {
    F.refresh();
    if (F.vcu >= 16) return;
    const int row = (F.vcu * 3079 + 17) % T;
    const float* w_o = (const float*)a.in[12]; const float* g = (const float*)a.in[13]; const float* bta = (const float*)a.in[14]; const float* wr_ = (const float*)a.in[15]; const float* br = (const float*)a.in[16];
    const bf16_t* MIX = (const bf16_t*)(F.ws + WS_MIX) + (size_t)row * 1024; const bf16_t* H0 = (const bf16_t*)(F.ws + WS_H0) + (size_t)row * 1024;
    const float* Y = (const float*)(F.ws + WS_Y) + (size_t)row * 1024; const bf16_t* H1 = (const bf16_t*)(F.ws + WS_H1) + (size_t)row * 1024;
    LAS float* mx = (LAS float*)F.lds; LAS float* h1 = mx + 1024; LAS float* red = h1 + 1024; LAS float* lg = red + 16;
    for (int k = F.tid; k < 1024; k += 512) mx[k] = bf2f(MIX[k]);
    __syncthreads();
    for (int n = F.tid; n < 1024; n += 512) { float acc = 0.f; for (int k = 0; k < 1024; ++k) acc += mx[k] * w_o[(size_t)k * 1024 + n];
        const float want = DN_ALPHA * bf2f(H0[n]) + acc; if (!close_enough(Y[n], want, 0.03f, 0.02f)) dbg_fail(F, 10); }
    float s = 0.f; for (int k = F.tid; k < 1024; k += 512) s += Y[k];
    s = wave_sum(s); if (F.lane == 0) red[F.wave] = s; __syncthreads();
    float mean = 0.f; for (int w = 0; w < 8; ++w) mean += red[w]; mean *= (1.f / D); __syncthreads();
    float q = 0.f; for (int k = F.tid; k < 1024; k += 512) { const float d = Y[k] - mean; q += d * d; }
    q = wave_sum(q); if (F.lane == 0) red[F.wave] = q; __syncthreads();
    float var = 0.f; for (int w = 0; w < 8; ++w) var += red[w]; var *= (1.f / D);
    const float rstd = 1.f / sqrtf(var + LN_EPS);
    for (int k = F.tid; k < 1024; k += 512) { const float hv = (Y[k] - mean) * rstd * g[k] + bta[k]; h1[k] = hv; if (!close_enough(bf2f(H1[k]), hv, 0.02f, 0.01f)) dbg_fail(F, 11); }
    __syncthreads();
    if (F.tid < 32) { float acc = 0.f; for (int k = 0; k < 1024; ++k) acc += h1[k] * wr_[(size_t)k * 32 + F.tid]; lg[F.tid] = acc + br[F.tid]; }
    __syncthreads();
    if (F.tid == 0) {
        const int* ts = (const int*)(F.ws + WS_TSLOT) + (size_t)row * 4; float l[32]; for (int e = 0; e < 32; ++e) l[e] = lg[e];
        int se[4]; float sl[4];
        for (int k = 0; k < 4; ++k) { int bi = 0; for (int e = 1; e < 32; ++e) if (l[e] > l[bi]) bi = e; se[k] = bi; sl[k] = l[bi]; l[bi] = -INFINITY; }
        float den = 0.f; for (int k = 0; k < 4; ++k) den += expf(sl[k] - sl[0]);
        for (int k = 0; k < 4; ++k) { const int e = ts[k] >> 16, pos = ts[k] & 0xffff;
            if (e != se[k] && fabsf(lg[e] - sl[k]) > 1e-4f) dbg_fail(F, 12);
            const float gt = ((const float*)(F.ws + WS_LGATE))[(size_t)e * T + pos];
            if (!close_enough(gt, expf(sl[k] - sl[0]) / den, 1e-3f, 1e-3f)) dbg_fail(F, 12);
            if (((const int*)(F.ws + WS_LTOK))[(size_t)e * T + pos] != row) dbg_fail(F, 13);
            if (pos >= (int)__hip_atomic_load(F.ctl + CW_CNT + e, RLX_AGENT)) dbg_fail(F, 13); }
    }
    __syncthreads();
}
__device__ __forceinline__ void dbg_check_moe(Frame& F, const Args& a) {
    F.refresh();
    if (F.vcu >= 32) return;
    const LAS int* cnt = (const LAS int*)(F.lds + XTRA_OFF + 4096); const LAS int* tstart = cnt + 32;
    const int e = F.vcu; if (cnt[e] == 0) return;
    const int slot = (F.vcu * 997 + 13) % cnt[e];
    const size_t prow = (size_t)tstart[e] * 256 + slot;
    const int tok = ((const int*)(F.ws + WS_LTOK))[(size_t)e * T + slot]; const float gt = ((const float*)(F.ws + WS_LGATE))[(size_t)e * T + slot];
    const float* w_up = (const float*)a.in[17] + (size_t)e * 1024 * 2048; const float* b_up = (const float*)a.in[18] + (size_t)e * 2048;
    const float* w_dn = (const float*)a.in[19] + (size_t)e * 1024 * 1024; const float* b_dn = (const float*)a.in[20] + (size_t)e * 1024;
    const bf16_t* H1 = (const bf16_t*)(F.ws + WS_H1) + (size_t)tok * 1024; const bf16_t* ACT = (const bf16_t*)(F.ws + WS_ACT) + prow * 1024; const bf16_t* YS = (const bf16_t*)(F.ws + WS_YS) + prow * 1024;
    LAS float* hx = (LAS float*)F.lds + 4096; LAS float* ac = hx + 1024;
    __syncthreads();
#if MOE_FP8
    for (int k = F.tid; k < 1024; k += 512) { hx[k] = bf2f(H1[k]); const unsigned char* A8 = (const unsigned char*)(F.ws + WS_ACT) + prow * 1024; ac[k] = __builtin_amdgcn_cvt_f32_fp8((int)A8[k], 0) * (1.f / ACT8_SCALE); }
#else
    for (int k = F.tid; k < 1024; k += 512) { hx[k] = bf2f(H1[k]); ac[k] = bf2f(ACT[k]); }
#endif
    __syncthreads();
    for (int j = F.tid; j < 1024; j += 512) { float gl = 0.f, li = 0.f; for (int k = 0; k < 1024; ++k) { gl += hx[k] * w_up[(size_t)k * 2048 + j]; li += hx[k] * w_up[(size_t)k * 2048 + 1024 + j]; }
        gl += b_up[j]; li += b_up[1024 + j]; gl = fminf(gl, 7.f); li = fminf(fmaxf(li, -7.f), 7.f);
        const float want = gl / (1.f + expf(-1.702f * gl)) * (li + 1.f);
        if (!close_enough(ac[j], want, MOE_FP8 ? 0.2f : 0.03f, MOE_FP8 ? 0.15f : 0.03f)) dbg_fail(F, 14); }
    for (int n = F.tid; n < 1024; n += 512) { float acc = 0.f; for (int j = 0; j < 1024; ++j) acc += ac[j] * w_dn[(size_t)j * 1024 + n];
        const float want = (acc + b_dn[n]) * gt; if (!close_enough(bf2f(YS[n]), want, MOE_FP8 ? 0.04f : 0.01f, MOE_FP8 ? 0.1f : 0.03f)) dbg_fail(F, 15); }
    __syncthreads();
}
__device__ __forceinline__ void dbg_check_final(Frame& F, const Args& a) {
    F.refresh();
    if (F.vcu >= 16) return;
    const LAS int* tstart = (const LAS int*)(F.lds + XTRA_OFF + 4096) + 32;
    const int row = (F.vcu * 1789 + 29) % T; const int* ts = (const int*)(F.ws + WS_TSLOT) + (size_t)row * 4;
    const bf16_t* H1 = (const bf16_t*)(F.ws + WS_H1) + (size_t)row * 1024; const bf16_t* YS = (const bf16_t*)(F.ws + WS_YS);
    LAS float* vv = (LAS float*)F.lds + 8192; LAS float* red = vv + 1024;
    __syncthreads();
    float s = 0.f;
    for (int c = F.tid; c < 1024; c += 512) { float v = DN_ALPHA * bf2f(H1[c]); for (int k = 0; k < 4; ++k) v += bf2f(YS[((size_t)tstart[ts[k] >> 16] * 256 + (ts[k] & 0xffff)) * 1024 + c]); vv[c] = v; s += v; }
    s = wave_sum(s); if (F.lane == 0) red[F.wave] = s; __syncthreads();
    float mean = 0.f; for (int w = 0; w < 8; ++w) mean += red[w]; mean *= (1.f / D); __syncthreads();
    float q = 0.f; for (int c = F.tid; c < 1024; c += 512) { const float d = vv[c] - mean; q += d * d; }
    q = wave_sum(q); if (F.lane == 0) red[F.wave] = q; __syncthreads();
    float var = 0.f; for (int w = 0; w < 8; ++w) var += red[w]; var *= (1.f / D);
    const float rstd = 1.f / sqrtf(var + LN_EPS); const float* g = (const float*)a.in[21]; const float* bta = (const float*)a.in[22];
    for (int c = F.tid; c < 1024; c += 512) { const float want = (vv[c] - mean) * rstd * g[c] + bta[c]; if (!close_enough(a.out[(size_t)row * 1024 + c], want, 0.01f, 0.01f)) dbg_fail(F, 16); }
    __syncthreads();
}
__device__ __forceinline__ void dbg_emit(Frame& F, float* out) {
    F.refresh();
    const unsigned m = __hip_atomic_load(F.ctl + CW_DBG, RLX_AGENT);
    const unsigned tm = __hip_atomic_load(F.ctl + CW_BAR + XB_TMO, RLX_AGENT);
    float C = 0.f;
    if (tm) C = 1e15f;
    else if (m) { const int id = __builtin_ctz(m); C = sqrtf(powf(10.f, (float)id) - 1.f); }
    const f32x4 v = (f32x4){C, C, C, C};
    for (size_t i = (size_t)F.vcu * 512 + F.tid; i < (size_t)T * D / 4; i += (size_t)F.G * 512) ((GAS f32x4*)out)[i] = v;
}

__global__ void __launch_bounds__(512, 2) fwd_kernel(Args args) {
    extern __shared__ __attribute__((aligned(16))) unsigned char lds[];
    Frame F;
    F.lds = (LAS unsigned char*)lds;
    F.MISC = (volatile LAS unsigned*)(F.lds + MISC_OFF);
    F.wave = __builtin_amdgcn_readfirstlane((int)threadIdx.x >> 6); F.refresh();
    F.G = gridDim.x; { const int bx = blockIdx.x; F.vcu = (F.G % 8 == 0) ? (bx % 8) * (F.G / 8) + bx / 8 : bx; }
    F.ws = args.ws; F.ctl = (gu32*)(args.ws + WS_CTL);
    for (int u = F.tid; u < 64; u += 512) ((LAS unsigned*)(F.lds + MISC_OFF))[u] = 0u;
    __syncthreads();
    XcdBarrier bar = xcd_barrier_post((unsigned*)(F.ctl + CW_BAR), F.MISC + 8);

#if TPROBE > 0
    int n_stamp = 0;
#define STAMP() do { F.refresh(); if (blockIdx.x == 0 && F.tid == 0) { const unsigned long long t_ = __builtin_amdgcn_s_memrealtime(); __hip_atomic_store(F.ctl + CW_TS + 2 * n_stamp, (unsigned)t_, RLX_AGENT); __hip_atomic_store(F.ctl + CW_TS + 2 * n_stamp + 1, (unsigned)(t_ >> 32), RLX_AGENT); } ++n_stamp; } while (0)
#else
#define STAMP() do {} while (0)
#endif
#define RUN_PHASE(k, ...) { __VA_ARGS__ } if (DUP_PHASE == (k)) { __VA_ARGS__ }
    STAMP();
    RUN_PHASE(0,
    p0_prologue(F, args);
    xcd_barrier(bar); STAMP();
    )
    RUN_PHASE(1,
    {
        pg8::DenseOrder S; S.init((const bf16_t*)(F.ws + WS_H0), D, (const bf16_t*)(F.ws + WS_WIN), D, T, NPROJ, F.G, (int)blockIdx.x);
        EpiProj E{(bf16_t*)(F.ws + WS_PROJ), (const float*)(F.ws + WS_COS), (const float*)(F.ws + WS_SIN), (const float*)(F.ws + WS_LB)};
        pg8::gemm_phase<EpiProj, pg8::DenseOrder>(F.lds, D, S, E, F.wave);
    }
    xcd_barrier(bar); STAMP();
    )
#if DBG_STAGE == 1
    dbg_check_proj(F, args);
    xcd_barrier(bar);
    dbg_emit(F, args.out);
    return;
#endif
    RUN_PHASE(2,
    {
        const bf16_t* PROJ = (const bf16_t*)(F.ws + WS_PROJ);
        LAS float* tabkv = (LAS float*)(F.lds + XTRA_OFF); LAS float* tabq = tabkv + 256;
        pg8::DenseOrder Skv; Skv.init(PROJ + PC_KVA, NPROJ, (const bf16_t*)(F.ws + WS_WKVB), KVL, T, 1024, F.G, (int)blockIdx.x);
        pg8::DenseOrder Sq; Sq.init(PROJ + PC_QA, NPROJ, (const bf16_t*)(F.ws + WS_WQB), QL, T, 768, F.G, (int)blockIdx.x);
        pg8::Unit u; F.refresh();
        if (Skv.next(0, u)) rs_table(PROJ, u.pm, PC_KVA, KVL, tabkv, F.tid);
        if (Sq.next(0, u)) rs_table(PROJ, u.pm, PC_QA, QL, tabq, F.tid);
        LDS_WAIT(); __syncthreads();
        EpiKV Ekv{(bf16_t*)(F.ws + WS_KV), tabkv};
        pg8::gemm_phase<EpiKV, pg8::DenseOrder>(F.lds, KVL, Skv, Ekv, F.wave);
        EpiQ Eq{(bf16_t*)(F.ws + WS_Q), (const float*)(F.ws + WS_COS), (const float*)(F.ws + WS_SIN), tabq};
        pg8::gemm_phase<EpiQ, pg8::DenseOrder>(F.lds, QL, Sq, Eq, F.wave);
        for (int j = 0; j < 4; ++j) { const int unit = F.vcu * 4 + j; if (unit < 1024) hg::pass_a(unit, PROJ, (float*)(F.ws + WS_LT), (float*)(F.ws + WS_DEC), F.lds, F.wave); }
    }
    xcd_barrier(bar); STAMP();
    )
    RUN_PHASE(3,
    {
        F.refresh();
        hg::pass_b((const float*)(F.ws + WS_LT), (const float*)(F.ws + WS_DEC), (bf16_t*)(F.ws + WS_SST), F.vcu * 512 + F.tid, F.G * 512);
        const int bh = F.vcu >> 2, s = F.vcu & 3;
        if (bh < NB * 8) {
            att::unit(bh >> 3, bh & 7, 7 - s, (const bf16_t*)(F.ws + WS_Q), (const bf16_t*)(F.ws + WS_KV), (const bf16_t*)(F.ws + WS_PROJ), (bf16_t*)(F.ws + WS_MIX), (float*)(F.ws + WS_SSQ), F.lds, F.wave);
            att::unit(bh >> 3, bh & 7, s, (const bf16_t*)(F.ws + WS_Q), (const bf16_t*)(F.ws + WS_KV), (const bf16_t*)(F.ws + WS_PROJ), (bf16_t*)(F.ws + WS_MIX), (float*)(F.ws + WS_SSQ), F.lds, F.wave);
        }
    }
    xcd_barrier(bar); STAMP();
    )
#if DBG_STAGE >= 2
    dbg_check_proj(F, args);
    __syncthreads();
    dbg_check_qkv(F, args);
    dbg_check_attn(F);
    xcd_barrier(bar);
#endif
    attn_normalise(F, (const float*)args.in[10]);
    for (int j = 0; j < 4; ++j) { const int unit = F.vcu * 4 + j; if (unit < 1024) hg::pass_c(unit, (const bf16_t*)(F.ws + WS_PROJ), (const bf16_t*)(F.ws + WS_SST), (const float*)args.in[11], (bf16_t*)(F.ws + WS_MIX), F.lds, F.wave); }
    xcd_barrier(bar); STAMP();
    if (DUP_PHASE == 4) { for (int j = 0; j < 4; ++j) { const int unit = F.vcu * 4 + j; if (unit < 1024) hg::pass_c(unit, (const bf16_t*)(F.ws + WS_PROJ), (const bf16_t*)(F.ws + WS_SST), (const float*)args.in[11], (bf16_t*)(F.ws + WS_MIX), F.lds, F.wave); } xcd_barrier(bar); }
#if DBG_STAGE >= 3
    dbg_check_norm(F, (const float*)args.in[10]);
    dbg_check_hgrn(F, (const float*)args.in[11]);
    __syncthreads();
#endif
    RUN_PHASE(5,
    {
        pg8::DenseOrder S; S.init((const bf16_t*)(F.ws + WS_MIX), D, (const bf16_t*)(F.ws + WS_WO), D, T, D, F.G, (int)blockIdx.x);
        EpiY E{(float*)(F.ws + WS_Y), (const bf16_t*)(F.ws + WS_H0)};
        pg8::gemm_phase<EpiY, pg8::DenseOrder>(F.lds, D, S, E, F.wave);
    }
    xcd_barrier(bar); STAMP();
    )
    p6_router(F, args);
    xcd_barrier(bar); STAMP();
    moe_table(F);
    RUN_PHASE(7,
    {
        const LAS int* cnt = (const LAS int*)(F.lds + XTRA_OFF + 4096); const LAS int* tstart = cnt + 32;
#if MOE_FP8
        MoeOrder<true> S{(const void*)(F.ws + WS_H1F8), (const void*)(F.ws + WS_WUP), D, D, 8, F.G, F.vcu, (size_t)2048 * D, cnt, tstart, (const int*)(F.ws + WS_LTOK), 1};
        EpiUp E{(unsigned char*)(F.ws + WS_ACT), (const float*)args.in[18]};
        pg8::gemm_phase<EpiUp, MoeOrder<true>, true>(F.lds, D, S, E, F.wave);
#else
        MoeOrder<true> S{(const void*)(F.ws + WS_H1), (const void*)(F.ws + WS_WUP), D, D, 8, F.G, F.vcu, (size_t)2048 * D, cnt, tstart, (const int*)(F.ws + WS_LTOK), 2};
        EpiUp E{(bf16_t*)(F.ws + WS_ACT), (const float*)args.in[18]};
        pg8::gemm_phase<EpiUp, MoeOrder<true>>(F.lds, D, S, E, F.wave);
#endif
    }
    xcd_barrier(bar); STAMP();
    )
    RUN_PHASE(8,
    {
        const LAS int* cnt = (const LAS int*)(F.lds + XTRA_OFF + 4096); const LAS int* tstart = cnt + 32;
        MoeOrder<false> S{(const void*)(F.ws + WS_ACT), (const void*)(F.ws + WS_WDN), DE, DE, 4, F.G, F.vcu, (size_t)D * DE, cnt, tstart, nullptr, MOE_FP8 ? 1 : 2};
        EpiDown E{(bf16_t*)(F.ws + WS_YS), (const float*)args.in[20], (const float*)(F.ws + WS_LGATE), cnt, tstart};
        pg8::gemm_phase<EpiDown, MoeOrder<false>, MOE_FP8 != 0>(F.lds, DE, S, E, F.wave);
    }
    xcd_barrier(bar); STAMP();
    )
    p9_final(F, args);
    if (DUP_PHASE == 9) { xcd_barrier(bar); p9_final(F, args); }
#if TPROBE > 0
    xcd_barrier(bar); STAMP();
    {
        F.refresh();
        const int pa = 2 * (TPROBE - 1), pb = pa + 1;
        unsigned long long t[4];
        for (int j = 0; j < 4; ++j) { const int idx = (j < 2 ? pa + j : pb + (j - 2)); t[j] = (unsigned long long)__hip_atomic_load(F.ctl + CW_TS + 2 * idx, RLX_AGENT) | ((unsigned long long)__hip_atomic_load(F.ctl + CW_TS + 2 * idx + 1, RLX_AGENT) << 32); }
        const float ua = (float)(t[1] - t[0]) * 0.01f, ub = (float)(t[3] - t[2]) * 0.01f;
        const float Bv = sqrtf(ub); const f32x4 v = (f32x4){Bv, Bv, Bv, Bv};
        for (size_t i = (size_t)F.vcu * 512 + F.tid; i < (size_t)T * D / 4; i += (size_t)F.G * 512) ((GAS f32x4*)args.out)[i] = v;
        VM_WAIT(); xcd_barrier(bar);
        if (blockIdx.x == 0 && F.tid == 0) args.out[0] = ua;
    }
#endif
#if DBG_STAGE >= 3
    xcd_barrier(bar);
    dbg_check_router(F, args);
    dbg_check_moe(F, args);
    dbg_check_final(F, args);
    F.refresh(); if (F.vcu == 100 && F.tid == 0) dbg_fail(F, 20);
    xcd_barrier(bar);
    dbg_emit(F, args.out);
#endif
}

extern "C" void kernel_launch(void* const* d_in, const int* in_sizes, int n_in, void* d_out, int out_size, void* d_ws, size_t ws_size, hipStream_t stream) {
    static int grid = 0;
    if (grid == 0) {
        if (n_in != 23 || out_size != T * D || ws_size < WS_END_A) { fprintf(stderr, "kernel_launch: unexpected shapes (n_in %d out %d ws %zu)\n", n_in, out_size, ws_size); grid = -1; return; }
        int dev = 0, cus = 0, per_cu = 0;
        if (hipGetDevice(&dev) != hipSuccess || hipDeviceGetAttribute(&cus, hipDeviceAttributeMultiprocessorCount, dev) != hipSuccess) { grid = -1; return; }
        if (hipFuncSetAttribute((const void*)fwd_kernel, hipFuncAttributeMaxDynamicSharedMemorySize, LDS_BYTES) != hipSuccess) { fprintf(stderr, "kernel_launch: hipFuncSetAttribute failed\n"); grid = -1; return; }
        if (hipOccupancyMaxActiveBlocksPerMultiprocessor(&per_cu, (const void*)fwd_kernel, 512, LDS_BYTES) != hipSuccess || per_cu < 1) fprintf(stderr, "kernel_launch: occupancy query says %d\n", per_cu);
        (void)hipGetLastError();
        grid = cus;
    }
    if (grid < 0) return;
    if (hipMemsetAsync((char*)d_ws + WS_CTL, 0, CTL_ZERO_BYTES, stream) != hipSuccess) return;
    Args a{};
    for (int i = 0; i < 23; ++i) a.in[i] = d_in[i];
    a.out = (float*)d_out; a.ws = (unsigned char*)d_ws;
    hipLaunchKernelGGL(fwd_kernel, dim3(grid), dim3(512), LDS_BYTES, stream, a);
}
```

```cpp
#include <hip/hip_runtime.h>
#include <cstdio>
#include <cstdint>

#ifndef DBG_STAGE
#define DBG_STAGE 0
#endif

#ifndef MOE_FP8
#define MOE_FP8 1
#endif
#ifndef DUP_PHASE
#define DUP_PHASE -1
#endif
#ifndef TPROBE
#define TPROBE 0
#endif
#define GAS __attribute__((address_space(1)))
#define LAS __attribute__((address_space(3)))
typedef unsigned short bf16_t;
typedef short bf16x8 __attribute__((ext_vector_type(8)));
typedef float f32x4 __attribute__((ext_vector_type(4)));
typedef float f32x2 __attribute__((ext_vector_type(2)));
typedef unsigned u32x4 __attribute__((ext_vector_type(4)));
typedef unsigned u32x2 __attribute__((ext_vector_type(2)));
typedef GAS unsigned gu32;

constexpr int T = 16384, SEQ = 2048, NB = 8, D = 1024;
constexpr int IN_COLS = 2720, NPROJ = 2816;
constexpr int QL = 384, KVL = 256;
constexpr int NE = 32, DE = 1024;
constexpr float LN_EPS = 1e-5f, RMS_EPS = 1e-6f;
constexpr float DN_ALPHA = 1.189207115002721f;
constexpr int PC_KVA = 0, PC_QA = 256, PC_KR = 640, PC_HQ = 768, PC_HF = 1280, PC_HI = 1792, PC_HG = 2304;

constexpr size_t MiB = 1u << 20;
constexpr size_t WS_CTL = 0, CTL_ZERO_BYTES = 1 * MiB;
constexpr size_t WS_COS = 1 * MiB, WS_SIN = 2 * MiB, WS_LB = 3 * MiB;
constexpr size_t WS_WRH = 3 * MiB + 65536, WS_WRL = 3 * MiB + 131072;
constexpr size_t WS_WIN = 4 * MiB;
constexpr size_t WS_WQB = 10 * MiB, WS_WKVB = 11 * MiB, WS_WO = 12 * MiB;
constexpr size_t WS_WUP = 14 * MiB;
constexpr size_t WS_WDN = 78 * MiB;
constexpr size_t WS_H0 = 110 * MiB;
constexpr size_t WS_H1 = 110 * MiB;
constexpr size_t WS_PROJ = 142 * MiB;
constexpr size_t WS_Y = 142 * MiB;
constexpr size_t WS_Q = 230 * MiB;
constexpr size_t WS_KV = 254 * MiB;
constexpr size_t WS_YS = 142 * MiB;
constexpr size_t WS_MIX = 286 * MiB;
constexpr size_t WS_H1F8 = 286 * MiB;
constexpr size_t WS_LT = 318 * MiB;
constexpr size_t WS_SST = 382 * MiB;
constexpr size_t WS_ACT = 318 * MiB;
constexpr size_t WS_SSQ = 414 * MiB;
constexpr size_t WS_DEC = 415 * MiB;
constexpr size_t WS_LTOK = 416 * MiB, WS_LGATE = 418 * MiB, WS_TSLOT = 420 * MiB;
constexpr size_t WS_END_A = 422 * MiB;
static_assert(MOE_FP8, "the compact workspace map assumes the fp8 MoE buffers");
constexpr float W8_SCALE = 256.f, ACT8_SCALE = 4.f;
constexpr int CW_CNT = 1024;
constexpr int CW_TS = 2048;
constexpr int CW_DBG = 8;
constexpr int CW_BAR = 4096;

constexpr int RING_BYTES = 131072;
constexpr int XTRA_OFF = RING_BYTES, XTRA_BYTES = 20480;
constexpr int MISC_OFF = XTRA_OFF + XTRA_BYTES;
constexpr int LDS_BYTES = MISC_OFF + 256;

#define RLX_AGENT __ATOMIC_RELAXED, __HIP_MEMORY_SCOPE_AGENT
#define LDS_WAIT() asm volatile("s_waitcnt lgkmcnt(0)" ::: "memory")
#define VM_WAIT() asm volatile("s_waitcnt vmcnt(0)" ::: "memory")
__device__ __forceinline__ unsigned f2bf(float f) { unsigned u = __builtin_bit_cast(unsigned, f); return (u + 0x7fffu + ((u >> 16) & 1u)) >> 16; }
__device__ __forceinline__ unsigned pk2(float lo, float hi) { return f2bf(lo) | (f2bf(hi) << 16); }
__device__ __forceinline__ float bf2f(bf16_t h) { return __builtin_bit_cast(float, (unsigned)h << 16); }
__device__ __forceinline__ float wave_sum(float v) {
#pragma unroll
    for (int o = 1; o < 64; o <<= 1) v += __shfl_xor(v, o);
    return v;
}
__device__ __forceinline__ int fresh_lane() { int l; asm volatile("v_mbcnt_lo_u32_b32 %0, -1, 0\n\tv_mbcnt_hi_u32_b32 %0, -1, %0" : "=v"(l)); return l; }
__device__ __forceinline__ unsigned pk4_fp8(float a, float b, float c, float d) { int w = __builtin_amdgcn_cvt_pk_fp8_f32(a, b, 0, false); w = __builtin_amdgcn_cvt_pk_fp8_f32(c, d, w, true); return (unsigned)w; }
__device__ __forceinline__ float silu_f(float x) { return x * __builtin_amdgcn_rcpf(1.f + __expf(-x)); }

namespace pg8 {
constexpr int BM = 256, BK = 64, HALF = 128, HTB = HALF * BK * 2, STAGE_BYTES = 8 * HTB, NXCD = 8, WGM = 8;
__host__ __device__ __forceinline__ int lds_byte(int r, int c) { const int st = (r >> 4) * 2 + (c >> 5), rr = r & 15, cc = c & 31, ob = rr * 64 + cc * 2; return st * 1024 + (ob ^ (((ob >> 9) & 1) << 5)); }
__host__ __device__ __forceinline__ void stage_rc(int b, int& R, int& C) { const int st = b / 1024, sb = b % 1024, swz = sb ^ (((sb >> 9) & 1) << 5); R = (st >> 1) * 16 + swz / 64; C = (st & 1) * 32 + (swz % 64) / 2; }
__host__ __device__ __forceinline__ int perm32(int rho) { const int n = rho >> 4, i = rho & 15; return 8 * (i >> 2) + 4 * n + (i & 3); }

struct Unit { int pm, pn, e; };

struct DenseOrder {
    const bf16_t* A; const bf16_t* Bt; int lda, K;
    int nM, nN, nwg, G, c;
    __device__ __forceinline__ void init(const bf16_t* A_, int lda_, const bf16_t* Bt_, int K_, int M, int N, int G_, int c_) { A = A_; Bt = Bt_; lda = lda_; K = K_; nM = M / BM; nN = N / BM; nwg = nM * nN; G = G_; c = c_; }
    __device__ __forceinline__ bool next(int i, Unit& u) const {
        const long L = (long)i * G + c; if (L >= nwg) return false;
        int wgid = (int)L; { const int q = nwg / NXCD, r = nwg % NXCD, xcd = wgid % NXCD, off = wgid / NXCD; wgid = (xcd < r ? xcd * (q + 1) : r * (q + 1) + (xcd - r) * q) + off; }
        const int nig = WGM * nN, gid = wgid / nig, fm = gid * WGM, gsz = (nM - fm) < WGM ? (nM - fm) : WGM;
        u.pm = fm + ((wgid % nig) % gsz); u.pn = (wgid % nig) / gsz; u.e = 0; return true;
    }
    __device__ __forceinline__ const char* a_base(const Unit& u) const { return (const char*)A + (size_t)u.pm * BM * lda * 2; }
    __device__ __forceinline__ const char* b_base(const Unit& u) const { return (const char*)Bt + (size_t)u.pn * BM * K * 2; }
    __device__ __forceinline__ void a_offs(const Unit&, const int (&R)[2], const int (&C)[2], unsigned (&v)[2][2]) const {
#pragma unroll
        for (int h = 0; h < 2; ++h)
#pragma unroll
            for (int i = 0; i < 2; ++i) v[h][i] = (unsigned)((h * HALF + R[i]) * lda + C[i]) * 2u;
    }
    static constexpr bool GATHER = false;
};

template <class Epi, class Sched, bool FP8 = false>
__device__ __forceinline__ void gemm_phase(LAS unsigned char* lds, const int K, const Sched& S, const Epi& E, const int wave) {
    typedef int v8i32 __attribute__((ext_vector_type(8)));
    constexpr int ESZ = FP8 ? 1 : 2;
    const int lane = fresh_lane(), wid = wave, tid = wid * 64 + lane, wr = wid >> 2, wc = wid & 3, fr = lane & 15, fq = lane >> 4;
    const int nt = K * ESZ / 128;
    int RA[2], CA[2]; unsigned voffB[2];
#pragma unroll
    for (int i = 0; i < 2; ++i) { int R, C; stage_rc(tid * 16 + i * 8192, R, C); const int Rb = Epi::PERM ? ((R & ~31) + perm32(R & 31)) : R;
        RA[i] = R; CA[i] = C; voffB[i] = (unsigned)(Rb * K * ESZ + C * 2); }
    const size_t kstep = (size_t)(BK * 2);
    const size_t hstepB = (size_t)HALF * K * ESZ;
    const unsigned ldsw = (unsigned)wid * 1024u;
    const int aoff = lds_byte(wr * 64 + fr, fq * 8), boff = lds_byte(wc * 32 + fr, fq * 8);
#define PG8_SA(b, h) (((b) * 2 + (h)) * HTB)
#define PG8_SB(b, h) ((4 + (b) * 2 + (h)) * HTB)
#define PG8_STAGE(bufoff, gbase, voff) do { _Pragma("unroll") for (int _i = 0; _i < 2; ++_i) \
        __builtin_amdgcn_global_load_lds((const unsigned*)((const char*)(gbase) + (voff)[_i]), (LAS unsigned*)(lds + (bufoff) + ldsw + _i * 8192), 16, 0, 0); } while (0)
#define PG8_LDA(dst, b, h) do { _Pragma("unroll") for (int m = 0; m < 4; ++m) _Pragma("unroll") for (int k = 0; k < 2; ++k) dst[m][k] = *(const LAS bf16x8*)(lds + PG8_SA(b, h) + aoff + m * 2048 + k * 1024); } while (0)
#define PG8_LDB(dst, b, h) do { _Pragma("unroll") for (int n = 0; n < 2; ++n) _Pragma("unroll") for (int k = 0; k < 2; ++k) dst[n][k] = *(const LAS bf16x8*)(lds + PG8_SB(b, h) + boff + n * 2048 + k * 1024); } while (0)
#define PG8_CAT(x) __builtin_shufflevector(__builtin_bit_cast(__attribute__((ext_vector_type(4))) int, (x)[0]), __builtin_bit_cast(__attribute__((ext_vector_type(4))) int, (x)[1]), 0, 1, 2, 3, 4, 5, 6, 7)
#define PG8_MMA(ai, bj, At, Bt) do { __builtin_amdgcn_s_setprio(1); _Pragma("unroll") for (int m = 0; m < 4; ++m) _Pragma("unroll") for (int n = 0; n < 2; ++n) { \
        if constexpr (FP8) { const v8i32 b_ = (v8i32)PG8_CAT(Bt[n]), a_ = (v8i32)PG8_CAT(At[m]); asm volatile("v_mfma_f32_16x16x128_f8f6f4 %0, %1, %2, %0" : "+v"(acc[ai][bj][m][n]) : "v"(b_), "v"(a_)); } \
        else { _Pragma("unroll") for (int k = 0; k < 2; ++k) acc[ai][bj][m][n] = __builtin_amdgcn_mfma_f32_16x16x32_bf16(Bt[n][k], At[m][k], acc[ai][bj][m][n], 0, 0, 0); } } __builtin_amdgcn_s_setprio(0); } while (0)
#define PG8_WAIT_V(n) asm volatile("s_waitcnt vmcnt(" #n ")" ::: "memory")
#define PG8_WAIT_L(n) asm volatile("s_waitcnt lgkmcnt(" #n ")" ::: "memory")
#define PG8_BAR __builtin_amdgcn_s_barrier()
#define PG8_SCHED __builtin_amdgcn_sched_barrier(0)
    Unit cur, nxt; int ui = 0;
    if (!S.next(0, cur)) return;
    f32x4 acc[2][2][4][2];
#pragma unroll
    for (int a = 0; a < 2; ++a)
#pragma unroll
        for (int b = 0; b < 2; ++b)
#pragma unroll
            for (int m = 0; m < 4; ++m)
#pragma unroll
                for (int n = 0; n < 2; ++n) acc[a][b][m][n] = (f32x4){0.f, 0.f, 0.f, 0.f};
    bf16x8 At[4][2], B0[2][2], B1[2][2];
    const char* cA = S.a_base(cur); const char* cB = S.b_base(cur);
    unsigned vC[2][2], vN[2][2];
    S.a_offs(cur, RA, CA, vC);
#pragma unroll
    for (int h = 0; h < 2; ++h) { vN[h][0] = vC[h][0]; vN[h][1] = vC[h][1]; }
    PG8_STAGE(PG8_SB(0, 0), cB, voffB); PG8_STAGE(PG8_SB(0, 1), cB + hstepB, voffB); PG8_STAGE(PG8_SA(0, 0), cA, vC[0]); PG8_STAGE(PG8_SA(0, 1), cA, vC[1]);
    if (wr == 1) PG8_BAR;
    PG8_WAIT_V(2); PG8_BAR;
    PG8_STAGE(PG8_SB(1, 0), cB + kstep, voffB); PG8_STAGE(PG8_SA(1, 0), cA + kstep, vC[0]); PG8_STAGE(PG8_SB(1, 1), cB + hstepB + kstep, voffB);
    PG8_WAIT_V(6); PG8_BAR;
    for (;;) {
        const bool has_next = S.next(ui + 1, nxt);
        const char* nA = has_next ? S.a_base(nxt) : cA; const char* nB = has_next ? S.b_base(nxt) : cB;
        if (Sched::GATHER) { if (has_next) S.a_offs(nxt, RA, CA, vN); else {
#pragma unroll
            for (int h = 0; h < 2; ++h) { vN[h][0] = vC[h][0]; vN[h][1] = vC[h][1]; } } }
#pragma nounroll
        for (int t = 0; t < nt; t += 2) {
            const bool last = (t == nt - 2);
            const char* a1 = cA + (size_t)(t + 1) * kstep;
            const char* a2 = last ? nA : cA + (size_t)(t + 2) * kstep; const char* b2 = last ? nB : cB + (size_t)(t + 2) * kstep;
            const char* a3 = a2 + kstep; const char* b3 = b2 + kstep;
            unsigned v2[2][2];
#pragma unroll
            for (int h = 0; h < 2; ++h) { v2[h][0] = (Sched::GATHER && last) ? vN[h][0] : vC[h][0]; v2[h][1] = (Sched::GATHER && last) ? vN[h][1] : vC[h][1]; }
            PG8_LDB(B0, 0, 0); PG8_LDB(B1, 0, 1); PG8_SCHED; PG8_LDA(At, 0, 0); PG8_STAGE(PG8_SA(1, 1), a1, vC[1]);
            PG8_WAIT_V(8); PG8_WAIT_L(0); PG8_BAR; PG8_MMA(0, 0, At, B0); PG8_MMA(0, 1, At, B1); PG8_BAR; PG8_SCHED;
            PG8_LDA(At, 0, 1); PG8_STAGE(PG8_SB(0, 0), b2, voffB); PG8_STAGE(PG8_SB(0, 1), b2 + hstepB, voffB); PG8_STAGE(PG8_SA(0, 0), a2, v2[0]);
            PG8_WAIT_V(8); PG8_WAIT_L(0); PG8_BAR; PG8_MMA(1, 0, At, B0); PG8_MMA(1, 1, At, B1); PG8_BAR; PG8_SCHED;
            PG8_LDB(B0, 1, 0); PG8_LDB(B1, 1, 1); PG8_SCHED; PG8_LDA(At, 1, 0); PG8_STAGE(PG8_SA(0, 1), a2, v2[1]);
            PG8_WAIT_V(8); PG8_WAIT_L(0); PG8_BAR; PG8_MMA(0, 0, At, B0); PG8_MMA(0, 1, At, B1); PG8_BAR; PG8_SCHED;
            PG8_LDA(At, 1, 1); PG8_STAGE(PG8_SB(1, 0), b3, voffB); PG8_STAGE(PG8_SB(1, 1), b3 + hstepB, voffB); PG8_STAGE(PG8_SA(1, 0), a3, v2[0]);
            PG8_WAIT_V(8); PG8_WAIT_L(0); PG8_BAR; PG8_MMA(1, 0, At, B0); PG8_MMA(1, 1, At, B1); PG8_BAR; PG8_SCHED;
        }
        if constexpr (FP8) asm volatile("s_nop 15\n\ts_nop 15" ::: "memory");
        if (wr == 0) PG8_BAR;
        { int fr_e = fr, fq_e = fq; asm volatile("" : "+v"(fr_e), "+v"(fq_e));
          E(acc, cur, wr, wc, fr_e, fq_e); }
        if (!has_next) break;
#pragma unroll
        for (int a = 0; a < 2; ++a)
#pragma unroll
            for (int b = 0; b < 2; ++b)
#pragma unroll
                for (int m = 0; m < 4; ++m)
#pragma unroll
                    for (int n = 0; n < 2; ++n) acc[a][b][m][n] = (f32x4){0.f, 0.f, 0.f, 0.f};
        cur = nxt; cA = nA; cB = nB; ++ui;
#pragma unroll
        for (int h = 0; h < 2; ++h) { vC[h][0] = vN[h][0]; vC[h][1] = vN[h][1]; }
        if (wr == 1) PG8_BAR;
    }
    PG8_WAIT_V(0);
    PG8_BAR;
#undef PG8_SA
#undef PG8_SB
#undef PG8_STAGE
#undef PG8_LDA
#undef PG8_LDB
#undef PG8_MMA
#undef PG8_CAT
#undef PG8_WAIT_V
#undef PG8_WAIT_L
#undef PG8_BAR
#undef PG8_SCHED
}
}

#define XB_TMO      128
#define XB_XCNT(j)  (256  + 64 * (j))
#define XB_XSUB(j)  (1280 + 64 * (j))
#define XB_XGEN(j)  (2304 + 64 * (j))
#define XB_TOP      3328
#define XB_TOPGEN   3392
#define XCD_BAR_WORDS 3456
#define XB_SPIN_CAP (1u << 18)
__device__ __forceinline__ unsigned xb_ld(unsigned* p)              { return __hip_atomic_load(p, __ATOMIC_RELAXED, __HIP_MEMORY_SCOPE_AGENT); }
__device__ __forceinline__ unsigned xb_add(unsigned* p, unsigned v) { return __hip_atomic_fetch_add(p, v, __ATOMIC_RELAXED, __HIP_MEMORY_SCOPE_AGENT); }
__device__ __forceinline__ unsigned xb_xcc_id() { return (unsigned)__builtin_amdgcn_s_getreg((3 << 11) | 20) & 0xFu; }
#define XB_SPIN(cond, bar) do { unsigned _sp = 0; while (cond) { __builtin_amdgcn_s_sleep(1); \
    if ((++_sp & 255u) == 0u) { if (xb_ld(&(bar)[XB_TMO])) break; if (_sp > XB_SPIN_CAP) { atomicAdd(&(bar)[XB_TMO], 1u); break; } } } } while (0)
struct XcdBarrier { unsigned* bar; unsigned x; volatile LAS unsigned* st; };
__device__ __forceinline__ XcdBarrier xcd_barrier_post(unsigned* bar, volatile LAS unsigned* st) {
    XcdBarrier b; b.bar = bar; b.x = xb_xcc_id(); b.st = st;
    if (threadIdx.x == 0) (void)xb_add(&bar[XB_XCNT(b.x)], 1u);
    return b;
}
__device__ __forceinline__ void xcd_barrier_complete(unsigned* bar, unsigned x, unsigned& nloc, unsigned& nx) {
    const unsigned G = gridDim.x * gridDim.y * gridDim.z;
    unsigned sum, cnt, mine, sp = 0u;
    for (;;) {
        sum = 0u; cnt = 0u; mine = 0u;
#pragma unroll
        for (unsigned j = 0; j < 16; ++j) { const unsigned c = xb_ld(&bar[XB_XCNT(j)]); sum += c; cnt += (c > 0u) ? 1u : 0u; mine = (j == x) ? c : mine; }
        if (sum == G) break;
        __builtin_amdgcn_s_sleep(1);
        if ((++sp & 255u) == 0u) { if (xb_ld(&bar[XB_TMO])) break; if (sp > XB_SPIN_CAP) { atomicAdd(&bar[XB_TMO], 1u); break; } }
    }
    nloc = mine > 0u ? mine : 1u; nx = cnt > 0u ? cnt : 1u;
}
__device__ __forceinline__ void xcd_barrier(const XcdBarrier& b) {
    asm volatile("s_waitcnt vmcnt(0)" ::: "memory");
    __syncthreads();
    if (threadIdx.x == 0) {
        unsigned* bar = b.bar;
        __builtin_amdgcn_s_waitcnt(0);
        unsigned nloc = b.st[0], nx = b.st[1];
        if (nloc == 0u) { xcd_barrier_complete(bar, b.x, nloc, nx); b.st[0] = nloc; b.st[1] = nx; }
        const unsigned old = xb_add(&bar[XB_XSUB(b.x)], 1u);
        const unsigned gen = old / nloc;
        if (old + 1u == (gen + 1u) * nloc) {
            __builtin_amdgcn_fence(__ATOMIC_RELEASE, "agent");
            asm volatile("s_waitcnt vmcnt(0)" ::: "memory");
            const unsigned og = xb_add(&bar[XB_TOP], 1u);
            const unsigned tg = og / nx;
            if (og + 1u == (tg + 1u) * nx) xb_add(&bar[XB_TOPGEN], 1u);
            else XB_SPIN(xb_ld(&bar[XB_TOPGEN]) == tg, bar);
            __builtin_amdgcn_fence(__ATOMIC_ACQUIRE, "agent");
            xb_add(&bar[XB_XGEN(b.x)], 1u);
            asm volatile("s_waitcnt vmcnt(0)" ::: "memory");
        } else {
            XB_SPIN(xb_ld(&bar[XB_XGEN(b.x)]) == gen, bar);
            __builtin_amdgcn_fence(__ATOMIC_ACQUIRE, "agent");
            asm volatile("s_waitcnt vmcnt(0)" ::: "memory");
        }
    }
    __syncthreads();
}

struct Args { const void* in[23]; float* out; unsigned char* ws; };
struct Frame {
    LAS unsigned char* lds;
    volatile LAS unsigned* MISC;
    gu32* ctl;
    int tid, lane, wave, vcu, G;
    unsigned char* ws;
    __device__ __forceinline__ void refresh() { lane = fresh_lane(); tid = wave * 64 + lane; }
};

__device__ __forceinline__ int srcmap(int kind, int r) {
    if (kind == 0) { if (r < 256) return 384 + r; if (r < 640) return r - 256; if (r < 672) { const int j = r - 640; return 640 + (j & 1) * 16 + (j >> 1); } if (r < 768) return -1; return r - 96; }
    if (kind == 1) { const int h = r / 96, d = r - h * 96; if (d < 64) return r; const int j = d - 64; return h * 96 + 64 + (j & 1) * 16 + (j >> 1); }
    if (kind == 3) { const int pn = r >> 8, j = r & 255; return j < 128 ? pn * 128 + j : 1024 + pn * 128 + (j - 128); }
    return r;
}
__device__ __forceinline__ void transpose_item(const float* W, int Nsrc, int Kd, bf16_t* WT, int kind, const float* kscale, int ndest, LAS float* scr, int item, int lane) {
    const int nblk = ndest >> 6, kb = item / nblk, nb = item - kb * nblk, k0 = 64 * kb, r0 = 64 * nb;
    const int n4 = lane & 15, kq = lane >> 4;
    const int s0 = srcmap(kind, r0 + 4 * n4), s1 = srcmap(kind, r0 + 4 * n4 + 1), s2 = srcmap(kind, r0 + 4 * n4 + 2), s3 = srcmap(kind, r0 + 4 * n4 + 3);
    const bool fast = (s0 >= 0) && ((s0 & 3) == 0) && (s1 == s0 + 1) && (s2 == s0 + 2) && (s3 == s0 + 3);
    if (fast) {
        f32x4 v[16];
#pragma unroll
        for (int i = 0; i < 16; ++i) v[i] = *(const GAS f32x4*)(W + (size_t)(k0 + kq + 4 * i) * Nsrc + s0);
#pragma unroll
        for (int i = 0; i < 16; ++i) { const int kk = kq + 4 * i; const float sc = kscale ? kscale[k0 + kk] : 1.f; LAS float* d = scr + kk * 65 + 4 * n4;
            d[0] = v[i].x * sc; d[1] = v[i].y * sc; d[2] = v[i].z * sc; d[3] = v[i].w * sc; }
    } else {
        for (int i = 0; i < 16; ++i) { const int kk = kq + 4 * i; const float sc = kscale ? kscale[k0 + kk] : 1.f; const float* wr_ = W + (size_t)(k0 + kk) * Nsrc; LAS float* d = scr + kk * 65 + 4 * n4;
            d[0] = s0 >= 0 ? wr_[s0] * sc : 0.f; d[1] = s1 >= 0 ? wr_[s1] * sc : 0.f; d[2] = s2 >= 0 ? wr_[s2] * sc : 0.f; d[3] = s3 >= 0 ? wr_[s3] * sc : 0.f; }
    }
    LDS_WAIT(); asm volatile("" ::: "memory");
    const int c = lane & 7;
#pragma unroll
    for (int j = 0; j < 8; ++j) { const int n = (lane >> 3) + 8 * j; const LAS float* s = scr + (8 * c) * 65 + n;
        u32x4 o; o.x = pk2(s[0 * 65], s[1 * 65]); o.y = pk2(s[2 * 65], s[3 * 65]); o.z = pk2(s[4 * 65], s[5 * 65]); o.w = pk2(s[6 * 65], s[7 * 65]);
        *(GAS u32x4*)(WT + (size_t)(r0 + n) * Kd + k0 + 8 * c) = o; }
    LDS_WAIT(); asm volatile("" ::: "memory");
}
__device__ __forceinline__ void transpose_item_f8(const float* W, int Nsrc, int Kd, unsigned char* WT8, int kind, float scale, int ndest, LAS float* scr, int item, int lane) {
    const int nblk = ndest >> 6, kb = item / nblk, nb = item - kb * nblk, k0 = 64 * kb, r0 = 64 * nb;
    const int n4 = lane & 15, kq = lane >> 4;
    const int s0 = srcmap(kind, r0 + 4 * n4);
    f32x4 v[16];
#pragma unroll
    for (int i = 0; i < 16; ++i) v[i] = *(const GAS f32x4*)(W + (size_t)(k0 + kq + 4 * i) * Nsrc + s0);
#pragma unroll
    for (int i = 0; i < 16; ++i) { const int kk = kq + 4 * i; LAS float* d = scr + kk * 65 + 4 * n4;
        d[0] = v[i].x * scale; d[1] = v[i].y * scale; d[2] = v[i].z * scale; d[3] = v[i].w * scale; }
    LDS_WAIT(); asm volatile("" ::: "memory");
    const int c = lane & 3;
#pragma unroll
    for (int j = 0; j < 4; ++j) { const int n = (lane >> 2) + 16 * j; const LAS float* s = scr + (16 * c) * 65 + n;
        u32x4 o; o.x = pk4_fp8(s[0 * 65], s[1 * 65], s[2 * 65], s[3 * 65]); o.y = pk4_fp8(s[4 * 65], s[5 * 65], s[6 * 65], s[7 * 65]);
        o.z = pk4_fp8(s[8 * 65], s[9 * 65], s[10 * 65], s[11 * 65]); o.w = pk4_fp8(s[12 * 65], s[13 * 65], s[14 * 65], s[15 * 65]);
        *(GAS u32x4*)(WT8 + (size_t)(r0 + n) * Kd + k0 + 16 * c) = o; }
    LDS_WAIT(); asm volatile("" ::: "memory");
}
__device__ __forceinline__ void ln_row_to_bf16(const float* xrow, const float* g, const float* b, bf16_t* orow, int lane, float eps) {
    const GAS f32x4* xr = (const GAS f32x4*)xrow + lane;
    f32x4 v[4]; float s = 0.f;
#pragma unroll
    for (int j = 0; j < 4; ++j) { v[j] = xr[64 * j]; s += (v[j].x + v[j].y) + (v[j].z + v[j].w); }
    const float mean = wave_sum(s) * (1.f / D); float s2 = 0.f;
#pragma unroll
    for (int j = 0; j < 4; ++j) { v[j] = v[j] - mean; s2 += (v[j].x * v[j].x + v[j].y * v[j].y) + (v[j].z * v[j].z + v[j].w * v[j].w); }
    const float rstd = 1.f / sqrtf(wave_sum(s2) * (1.f / D) + eps);
    GAS unsigned long long* o8 = (GAS unsigned long long*)orow + lane;
#pragma unroll
    for (int j = 0; j < 4; ++j) { const f32x4 gg = *((const GAS f32x4*)g + lane + 64 * j), bb = *((const GAS f32x4*)b + lane + 64 * j);
        const f32x4 o = v[j] * rstd * gg + bb;
        o8[64 * j] = (unsigned long long)pk2(o.x, o.y) | ((unsigned long long)pk2(o.z, o.w) << 32); }
}
__device__ __forceinline__ void p0_prologue(Frame& F, const Args& a) {
    F.refresh();
    LAS float* scr = (LAS float*)(F.lds + F.wave * 16640);
    const int gw = F.vcu * 8 + F.wave, NGW = F.G * 8;
    const float* w_in = (const float*)a.in[4]; const float* qg = (const float*)a.in[5]; const float* w_qb = (const float*)a.in[6];
    const float* kvg = (const float*)a.in[7]; const float* w_kvb = (const float*)a.in[8]; const float* w_o = (const float*)a.in[12];
    const float* w_up = (const float*)a.in[17]; const float* w_dn = (const float*)a.in[19];
    bf16_t* WinT = (bf16_t*)(F.ws + WS_WIN); bf16_t* WqbT = (bf16_t*)(F.ws + WS_WQB); bf16_t* WkvbT = (bf16_t*)(F.ws + WS_WKVB); bf16_t* WoT = (bf16_t*)(F.ws + WS_WO);
    bf16_t* WupT = (bf16_t*)(F.ws + WS_WUP); bf16_t* WdnT = (bf16_t*)(F.ws + WS_WDN);
    constexpr int I_IN = 16 * 44, I_QB = 6 * 12, I_KVB = 4 * 16, I_O = 16 * 16, I_UP1 = 16 * 32, I_DN1 = 16 * 16;
#if DBG_STAGE == 1
    constexpr int NITEMS = I_IN + I_QB + I_KVB + I_O;
#else
    constexpr int NITEMS = I_IN + I_QB + I_KVB + I_O + NE * I_UP1 + NE * I_DN1;
#endif
    for (int it = gw; it < NITEMS; it += NGW) {
        int r = it;
        if (r < I_IN) { transpose_item(w_in, IN_COLS, D, WinT, 0, nullptr, NPROJ, scr, r, F.lane); continue; } r -= I_IN;
        if (r < I_QB) { transpose_item(w_qb, 768, QL, WqbT, 1, qg, 768, scr, r, F.lane); continue; } r -= I_QB;
        if (r < I_KVB) { transpose_item(w_kvb, 1024, KVL, WkvbT, 2, kvg, 1024, scr, r, F.lane); continue; } r -= I_KVB;
        if (r < I_O) { transpose_item(w_o, 1024, 1024, WoT, 2, nullptr, 1024, scr, r, F.lane); continue; } r -= I_O;
#if MOE_FP8
        if (r < NE * I_UP1) { const int e = r / I_UP1; transpose_item_f8(w_up + (size_t)e * D * 2048, 2048, D, (unsigned char*)WupT + (size_t)e * 2048 * D, 3, W8_SCALE, 2048, scr, r - e * I_UP1, F.lane); continue; } r -= NE * I_UP1;
        { const int e = r / I_DN1; transpose_item_f8(w_dn + (size_t)e * DE * D, D, DE, (unsigned char*)WdnT + (size_t)e * D * DE, 2, W8_SCALE, D, scr, r - e * I_DN1, F.lane); }
#else
        if (r < NE * I_UP1) { const int e = r / I_UP1; transpose_item(w_up + (size_t)e * D * 2048, 2048, D, WupT + (size_t)e * 2048 * D, 3, nullptr, 2048, scr, r - e * I_UP1, F.lane); continue; } r -= NE * I_UP1;
        { const int e = r / I_DN1; transpose_item(w_dn + (size_t)e * DE * D, D, DE, WdnT + (size_t)e * D * DE, 2, nullptr, D, scr, r - e * I_DN1, F.lane); }
#endif
    }
    const float* x = (const float*)a.in[0]; const float* g = (const float*)a.in[2]; const float* b = (const float*)a.in[3];
    bf16_t* H0 = (bf16_t*)(F.ws + WS_H0);
    for (int m = gw; m < T; m += NGW) ln_row_to_bf16(x + (size_t)m * D, g, b, H0 + (size_t)m * D, F.lane, LN_EPS);
    const int* pos = (const int*)a.in[1]; float* cs = (float*)(F.ws + WS_COS); float* sn = (float*)(F.ws + WS_SIN);
    for (int i = F.vcu * 512 + F.tid; i < T * 16; i += F.G * 512) {
        const int t = i >> 4, j = i & 15;
        const float inv = powf(10000.0f, -(float)(2 * j) / 32.0f);
        const float ang = (float)pos[t] * inv;
        double rev = (double)ang * 0.15915494309189535; rev -= floor(rev);
        const float rf = (float)rev;
        cs[i] = __builtin_amdgcn_cosf(rf); sn[i] = __builtin_amdgcn_sinf(rf);
    }
    { const float* wr_ = (const float*)a.in[15]; bf16_t* wh = (bf16_t*)(F.ws + WS_WRH); bf16_t* wl = (bf16_t*)(F.ws + WS_WRL);
      for (int i = F.vcu * 512 + F.tid; i < 32 * 1024; i += F.G * 512) { const int e = i >> 10, k = i & 1023; const float w = wr_[(size_t)k * 32 + e];
          const unsigned h = f2bf(w); wh[i] = (bf16_t)h; wl[i] = (bf16_t)f2bf(w - __builtin_bit_cast(float, h << 16)); } }
    if (F.vcu == 0) { const float* lbl = (const float*)a.in[9]; float* lb = (float*)(F.ws + WS_LB);
        for (int c = F.tid; c < 512; c += 512) lb[c] = 1.f / (1.f + expf(lbl[512 + c] - lbl[c])); }
}

struct EpiProj {
    static constexpr bool PERM = true;
    bf16_t* P; const float* cs; const float* sn; const float* lb;
    __device__ __forceinline__ void operator()(const f32x4 (&acc)[2][2][4][2], const pg8::Unit& u, int wr, int wc, int fr, int fq) const {
#pragma unroll
        for (int bj = 0; bj < 2; ++bj) {
            const int cb = u.pn * 256 + bj * 128 + wc * 32, c0 = cb + 8 * fq;
            const int kind = cb < PC_KR ? 0 : cb == PC_KR ? 1 : cb < PC_HQ ? 0 : cb < PC_HF ? 2 : cb < PC_HI ? 3 : cb < PC_HG ? 0 : 2;
            float lbv[8];
            if (kind == 3) {
#pragma unroll
                for (int j = 0; j < 8; ++j) lbv[j] = lb[c0 - PC_HF + j];
            }
#pragma unroll
            for (int ai = 0; ai < 2; ++ai)
#pragma unroll
                for (int m = 0; m < 4; ++m) {
                    const int row = u.pm * 256 + ai * 128 + wr * 64 + m * 16 + fr;
                    float v[8];
#pragma unroll
                    for (int j = 0; j < 4; ++j) { v[j] = acc[ai][bj][m][0][j]; v[4 + j] = acc[ai][bj][m][1][j]; }
                    if (kind == 1) {
                        const f32x4 cc = *(const f32x4*)(cs + (size_t)row * 16 + 4 * fq), ss = *(const f32x4*)(sn + (size_t)row * 16 + 4 * fq);
#pragma unroll
                        for (int p = 0; p < 4; ++p) { const float x1 = v[2 * p], x2 = v[2 * p + 1]; v[2 * p] = x1 * cc[p] - x2 * ss[p]; v[2 * p + 1] = x1 * ss[p] + x2 * cc[p]; }
                    } else if (kind == 2) {
#pragma unroll
                        for (int j = 0; j < 8; ++j) v[j] = silu_f(v[j]);
                    } else if (kind == 3) {
#pragma unroll
                        for (int j = 0; j < 8; ++j) { const float s = __builtin_amdgcn_rcpf(1.f + __expf(-v[j])); v[j] = __logf(lbv[j] + (1.f - lbv[j]) * s); }
                    }
                    u32x4 w; w.x = pk2(v[0], v[1]); w.y = pk2(v[2], v[3]); w.z = pk2(v[4], v[5]); w.w = pk2(v[6], v[7]);
                    *(u32x4*)(P + (size_t)row * NPROJ + c0) = w;
                }
        }
    }
};

constexpr float QSCALE = 0.10206207261596577f * 1.4426950408889634f;
__device__ __forceinline__ void rs_table(const bf16_t* P, int pm, int c0, int ncols, LAS float* tab, int tid) {
    const int r = tid >> 1, half = tid & 1, nh = ncols >> 1;
    const bf16_t* p = P + (size_t)(pm * 256 + r) * NPROJ + c0 + half * nh;
    float s = 0.f;
    for (int k = 0; k < nh; k += 8) { const u32x4 w = *(const GAS u32x4*)(p + k);
#pragma unroll
        for (int j = 0; j < 4; ++j) { const float a = __builtin_bit_cast(float, w[j] << 16), b = __builtin_bit_cast(float, w[j] & 0xffff0000u); s += a * a + b * b; } }
    s += __shfl_xor(s, 1);
    if (half == 0) tab[r] = 1.f / sqrtf(s / (float)ncols + RMS_EPS);
}
struct EpiQ {
    static constexpr bool PERM = true;
    bf16_t* Q; const float* cs; const float* sn; const LAS float* rs;
    __device__ __forceinline__ void operator()(const f32x4 (&acc)[2][2][4][2], const pg8::Unit& u, int wr, int wc, int fr, int fq) const {
#pragma unroll
        for (int bj = 0; bj < 2; ++bj) {
            const int c0 = u.pn * 256 + bj * 128 + wc * 32 + 8 * fq;
            const int hh = c0 / 96, d0 = c0 - hh * 96;
#pragma unroll
            for (int ai = 0; ai < 2; ++ai)
#pragma unroll
                for (int m = 0; m < 4; ++m) {
                    const int rl = ai * 128 + wr * 64 + m * 16 + fr, row = u.pm * 256 + rl;
                    const float sc = rs[rl] * QSCALE;
                    float v[8];
#pragma unroll
                    for (int j = 0; j < 4; ++j) { v[j] = acc[ai][bj][m][0][j] * sc; v[4 + j] = acc[ai][bj][m][1][j] * sc; }
                    if (d0 >= 64) {
                        const int i0 = (d0 - 64) >> 1;
                        const f32x4 cc = *(const f32x4*)(cs + (size_t)row * 16 + i0), ss = *(const f32x4*)(sn + (size_t)row * 16 + i0);
#pragma unroll
                        for (int p = 0; p < 4; ++p) { const float x1 = v[2 * p], x2 = v[2 * p + 1]; v[2 * p] = x1 * cc[p] - x2 * ss[p]; v[2 * p + 1] = x1 * ss[p] + x2 * cc[p]; }
                    }
                    u32x4 w; w.x = pk2(v[0], v[1]); w.y = pk2(v[2], v[3]); w.z = pk2(v[4], v[5]); w.w = pk2(v[6], v[7]);
                    *(u32x4*)(Q + (size_t)row * 768 + c0) = w;
                }
        }
    }
};
struct EpiKV {
    static constexpr bool PERM = true;
    bf16_t* KV; const LAS float* rs;
    __device__ __forceinline__ void operator()(const f32x4 (&acc)[2][2][4][2], const pg8::Unit& u, int wr, int wc, int fr, int fq) const {
#pragma unroll
        for (int bj = 0; bj < 2; ++bj) {
            const int c0 = u.pn * 256 + bj * 128 + wc * 32 + 8 * fq;
#pragma unroll
            for (int ai = 0; ai < 2; ++ai)
#pragma unroll
                for (int m = 0; m < 4; ++m) {
                    const int rl = ai * 128 + wr * 64 + m * 16 + fr, row = u.pm * 256 + rl;
                    const float sc = rs[rl];
                    u32x4 w; w.x = pk2(acc[ai][bj][m][0][0] * sc, acc[ai][bj][m][0][1] * sc); w.y = pk2(acc[ai][bj][m][0][2] * sc, acc[ai][bj][m][0][3] * sc);
                    w.z = pk2(acc[ai][bj][m][1][0] * sc, acc[ai][bj][m][1][1] * sc); w.w = pk2(acc[ai][bj][m][1][2] * sc, acc[ai][bj][m][1][3] * sc);
                    *(u32x4*)(KV + (size_t)row * 1024 + c0) = w;
                }
        }
    }
};

namespace att {
typedef float f32x16 __attribute__((ext_vector_type(16)));
typedef short s16x4 __attribute__((ext_vector_type(4)));
constexpr int KSLOT = 12288, VSLOT = 8192, BUFB = KSLOT + VSLOT;
constexpr int LDS_WS = 2 * BUFB, LDS_OST = LDS_WS + 2048, LDS_END = LDS_OST + 8 * 4096;
__device__ __forceinline__ int crow(int r, int hi) { return (r & 3) + 8 * (r >> 2) + 4 * hi; }
__device__ __forceinline__ unsigned cvtpk(float lo, float hi) { unsigned r; asm volatile("v_cvt_pk_bf16_f32 %0, %1, %2" : "=v"(r) : "v"(lo), "v"(hi)); return r; }
__device__ __forceinline__ void pv(f32x16* o, int vb, bf16x8 pa0, bf16x8 pa1, bf16x8 pa2, bf16x8 pa3) {
#pragma unroll
    for (int d0 = 0; d0 < 2; ++d0) { s16x4 lo[4], hi[4];
        asm volatile("ds_read_b64_tr_b16 %0,%8 offset:%c9\n\tds_read_b64_tr_b16 %1,%8 offset:%c10\n\tds_read_b64_tr_b16 %2,%8 offset:%c11\n\tds_read_b64_tr_b16 %3,%8 offset:%c12\n\t"
                     "ds_read_b64_tr_b16 %4,%8 offset:%c13\n\tds_read_b64_tr_b16 %5,%8 offset:%c14\n\tds_read_b64_tr_b16 %6,%8 offset:%c15\n\tds_read_b64_tr_b16 %7,%8 offset:%c16\n\ts_waitcnt lgkmcnt(0)"
                     : "=&v"(lo[0]), "=&v"(hi[0]), "=&v"(lo[1]), "=&v"(hi[1]), "=&v"(lo[2]), "=&v"(hi[2]), "=&v"(lo[3]), "=&v"(hi[3])
                     : "v"(vb), "i"(d0 * 4096), "i"(d0 * 4096 + 512), "i"(d0 * 4096 + 1024), "i"(d0 * 4096 + 1536), "i"(d0 * 4096 + 2048), "i"(d0 * 4096 + 2560), "i"(d0 * 4096 + 3072), "i"(d0 * 4096 + 3584) : "memory");
#define PK(k) (bf16x8){lo[k][0], lo[k][1], lo[k][2], lo[k][3], hi[k][0], hi[k][1], hi[k][2], hi[k][3]}
        o[d0] = __builtin_amdgcn_mfma_f32_32x32x16_bf16(pa0, PK(0), o[d0], 0, 0, 0);
        o[d0] = __builtin_amdgcn_mfma_f32_32x32x16_bf16(pa1, PK(1), o[d0], 0, 0, 0);
        o[d0] = __builtin_amdgcn_mfma_f32_32x32x16_bf16(pa2, PK(2), o[d0], 0, 0, 0);
        o[d0] = __builtin_amdgcn_mfma_f32_32x32x16_bf16(pa3, PK(3), o[d0], 0, 0, 0);
#undef PK
    }
}
__device__ __forceinline__ void unit(int b, int h, int qb, const bf16_t* Q, const bf16_t* KV, const bf16_t* PROJ, bf16_t* MIX, float* SSQ, LAS unsigned char* lds, const int wid) {
    const int lane = fresh_lane(), r32 = lane & 31, hi = lane >> 5;
    const size_t rowbase = (size_t)b * SEQ; const int q0 = qb * 256;
    const bf16_t* Qw = Q + (rowbase + q0 + wid * 32) * 768 + h * 96;
    bf16x8 qr[6];
#pragma unroll
    for (int d0 = 0; d0 < 6; ++d0) qr[d0] = *(const GAS bf16x8*)(Qw + (size_t)r32 * 768 + d0 * 16 + hi * 8);
    const int cw = (q0 + 32 * wid) >> 6, NT = 4 * qb + 4;
    LAS float* wsf = (LAS float*)(lds + LDS_WS) + wid * 64;
    const bf16_t* ksrc = KV + (rowbase + lane) * 1024 + h * 128 + wid * 8;
    const bf16_t* rsrc = PROJ + (rowbase + lane) * NPROJ + PC_KR + (wid & 3) * 8;
    const bf16_t* vsrc = KV + (rowbase + 16 * (wid & 3) + (lane >> 2)) * 1024 + h * 128 + 64 + (wid >> 2) * 32 + (lane & 3) * 8;
#define ATT_DMA(t, buf) do { \
        __builtin_amdgcn_global_load_lds((const unsigned*)(ksrc + (size_t)(t) * 64 * 1024), (LAS unsigned*)(lds + (buf) * BUFB + wid * 1024), 16, 0, 0); \
        if (wid < 4) __builtin_amdgcn_global_load_lds((const unsigned*)(rsrc + (size_t)(t) * 64 * NPROJ), (LAS unsigned*)(lds + (buf) * BUFB + (8 + wid) * 1024), 16, 0, 0); \
        __builtin_amdgcn_global_load_lds((const unsigned*)(vsrc + (size_t)(t) * 64 * 1024), (LAS unsigned*)(lds + (buf) * BUFB + KSLOT + wid * 1024), 16, 0, 0); } while (0)
    float m_run = -INFINITY, l_run = 0.f; f32x16 o[2]; o[0] = f32x16{}; o[1] = f32x16{};
    const int vb0 = (int)(unsigned)(size_t)(lds + KSLOT) + ((lane >> 4) & 1) * 32 + (lane & 3) * 8 + (4 * hi + ((lane & 15) >> 2)) * 64;
    asm volatile("s_waitcnt vmcnt(0)" ::: "memory");
    ATT_DMA(0, 0);
    for (int t = 0; t < NT; ++t) {
        const int buf = t & 1;
        if (t + 1 < NT) { ATT_DMA(t + 1, buf ^ 1); if (wid < 4) asm volatile("s_waitcnt vmcnt(3)" ::: "memory"); else asm volatile("s_waitcnt vmcnt(2)" ::: "memory"); }
        else asm volatile("s_waitcnt vmcnt(0)" ::: "memory");
        __builtin_amdgcn_s_barrier(); asm volatile("" ::: "memory");
        if (t <= cw) {
            f32x16 p0 = f32x16{}, p1 = f32x16{};
            const LAS unsigned char* kb = lds + buf * BUFB + hi * 1024 + r32 * 16;
#pragma unroll
            for (int d0 = 0; d0 < 6; ++d0) {
                const bf16x8 b0 = *(const LAS bf16x8*)(kb + d0 * 2048), b1 = *(const LAS bf16x8*)(kb + d0 * 2048 + 512);
                p0 = __builtin_amdgcn_mfma_f32_32x32x16_bf16(b0, qr[d0], p0, 0, 0, 0); p1 = __builtin_amdgcn_mfma_f32_32x32x16_bf16(b1, qr[d0], p1, 0, 0, 0); }
            float rm = p0[0];
#pragma unroll
            for (int r = 1; r < 16; ++r) rm = fmaxf(rm, p0[r]);
#pragma unroll
            for (int r = 0; r < 16; ++r) rm = fmaxf(rm, p1[r]);
            { auto rr = __builtin_amdgcn_permlane32_swap(__float_as_uint(rm), __float_as_uint(rm), false, false); rm = fmaxf(__uint_as_float(rr[0]), __uint_as_float(rr[1])); }
            const float m_new = fmaxf(m_run, rm), sc = __builtin_amdgcn_exp2f(m_run - m_new); m_run = m_new;
            float ls = 0.f;
#pragma unroll
            for (int r = 0; r < 16; ++r) { p0[r] = __builtin_amdgcn_exp2f(p0[r] - m_new); p1[r] = __builtin_amdgcn_exp2f(p1[r] - m_new); ls += p0[r] + p1[r]; }
            l_run = l_run * sc + ls;
            if (hi == 0) wsf[r32] = sc;
            asm volatile("s_waitcnt lgkmcnt(0)" ::: "memory");
#pragma unroll
            for (int r = 0; r < 16; ++r) { const float f = wsf[crow(r, hi)]; o[0][r] *= f; o[1][r] *= f; }
            u32x4 pw0, pw1, pw2, pw3;
            pw0 = (u32x4){cvtpk(p0[0], p0[1]), cvtpk(p0[2], p0[3]), cvtpk(p0[4], p0[5]), cvtpk(p0[6], p0[7])};
            pw1 = (u32x4){cvtpk(p0[8], p0[9]), cvtpk(p0[10], p0[11]), cvtpk(p0[12], p0[13]), cvtpk(p0[14], p0[15])};
            pw2 = (u32x4){cvtpk(p1[0], p1[1]), cvtpk(p1[2], p1[3]), cvtpk(p1[4], p1[5]), cvtpk(p1[6], p1[7])};
            pw3 = (u32x4){cvtpk(p1[8], p1[9]), cvtpk(p1[10], p1[11]), cvtpk(p1[12], p1[13]), cvtpk(p1[14], p1[15])};
            pv(o, vb0 + buf * BUFB, __builtin_bit_cast(bf16x8, pw0), __builtin_bit_cast(bf16x8, pw1), __builtin_bit_cast(bf16x8, pw2), __builtin_bit_cast(bf16x8, pw3));
        }
        asm volatile("s_waitcnt lgkmcnt(0)" ::: "memory"); __builtin_amdgcn_s_barrier(); asm volatile("" ::: "memory");
    }
#undef ATT_DMA
    { auto rr = __builtin_amdgcn_permlane32_swap(__float_as_uint(l_run), __float_as_uint(l_run), false, false); l_run = __uint_as_float(rr[0]) + __uint_as_float(rr[1]); }
    if (hi == 0) wsf[32 + r32] = l_run;
    asm volatile("s_waitcnt lgkmcnt(0)" ::: "memory");
    LAS bf16_t* stg = (LAS bf16_t*)(lds + LDS_OST) + wid * 2048;
#pragma unroll
    for (int r = 0; r < 16; ++r) { const int orow = crow(r, hi); const float rl = __builtin_amdgcn_rcpf(wsf[32 + orow]);
        stg[orow * 64 + r32] = (bf16_t)f2bf(o[0][r] * rl); stg[orow * 64 + 32 + r32] = (bf16_t)f2bf(o[1][r] * rl); }
    asm volatile("s_waitcnt lgkmcnt(0)" ::: "memory");
    bf16_t* Ow = MIX + (rowbase + q0 + wid * 32) * 1024 + h * 64;
#pragma unroll
    for (int i = 0; i < 4; ++i) { const int row = i * 8 + (lane >> 3), ch = lane & 7; const u32x4 v = *(const LAS u32x4*)(stg + row * 64 + ch * 8);
        *(GAS u32x4*)(Ow + (size_t)row * 1024 + ch * 8) = v;
        float s = 0.f;
#pragma unroll
        for (int j = 0; j < 4; ++j) { const float a = __builtin_bit_cast(float, v[j] << 16), bb = __builtin_bit_cast(float, v[j] & 0xffff0000u); s += a * a + bb * bb; }
        s += __shfl_xor(s, 1); s += __shfl_xor(s, 2); s += __shfl_xor(s, 4);
        if (ch == 0) SSQ[(rowbase + q0 + wid * 32 + row) * 8 + h] = s; }
    asm volatile("s_waitcnt lgkmcnt(0)" ::: "memory"); __builtin_amdgcn_s_barrier(); asm volatile("" ::: "memory");
}
}

__device__ __forceinline__ void attn_normalise(Frame& F, const float* g) {
    F.refresh();
    bf16_t* MIX = (bf16_t*)(F.ws + WS_MIX); const float* SSQ = (const float*)(F.ws + WS_SSQ);
    const int gw = F.vcu * 8 + F.wave, NGW = F.G * 8;
    f32x4 g0 = *((const GAS f32x4*)g + 2 * F.lane), g1 = *((const GAS f32x4*)g + 2 * F.lane + 1);
    for (int m = gw; m < T; m += NGW) {
        const f32x4 s0 = *(const GAS f32x4*)(SSQ + (size_t)m * 8), s1 = *(const GAS f32x4*)(SSQ + (size_t)m * 8 + 4);
        const float tot = ((s0.x + s0.y) + (s0.z + s0.w)) + ((s1.x + s1.y) + (s1.z + s1.w));
        const float rs = 1.f / sqrtf(tot * (1.f / 512.f) + RMS_EPS);
        GAS u32x4* p = (GAS u32x4*)(MIX + (size_t)m * 1024) + F.lane;
        const u32x4 v = *p; u32x4 w;
        w.x = pk2(__builtin_bit_cast(float, v.x << 16) * rs * g0.x, __builtin_bit_cast(float, v.x & 0xffff0000u) * rs * g0.y);
        w.y = pk2(__builtin_bit_cast(float, v.y << 16) * rs * g0.z, __builtin_bit_cast(float, v.y & 0xffff0000u) * rs * g0.w);
        w.z = pk2(__builtin_bit_cast(float, v.z << 16) * rs * g1.x, __builtin_bit_cast(float, v.z & 0xffff0000u) * rs * g1.y);
        w.w = pk2(__builtin_bit_cast(float, v.w << 16) * rs * g1.z, __builtin_bit_cast(float, v.w & 0xffff0000u) * rs * g1.w);
        *p = w;
    }
}

namespace hg {
typedef float f32x16 __attribute__((ext_vector_type(16)));
typedef short s16x4 __attribute__((ext_vector_type(4)));
constexpr int OFF_QDEC = 0, OFF_QD1 = 16384, OFF_KD0 = 24576, OFF_KD1 = 32768, OFF_V = 49152, OFF_S = 65536, OFF_O = 98304, OFF_TOT = 132096;
constexpr int OPITCH = 132;
__device__ __forceinline__ int crow(int r, int hi) { return (r & 3) + 8 * (r >> 2) + 4 * hi; }
__device__ __forceinline__ bf16x8 trfrag(int base, int off) {
    s16x4 lo, hi;
    asm volatile("ds_read_b64_tr_b16 %0,%2\n\tds_read_b64_tr_b16 %1,%2 offset:512\n\ts_waitcnt lgkmcnt(0)" : "=&v"(lo), "=&v"(hi) : "v"(base + off) : "memory");
    return (bf16x8){lo[0], lo[1], lo[2], lo[3], hi[0], hi[1], hi[2], hi[3]};
}
__device__ __forceinline__ void dma_tl(const bf16_t* src, LAS unsigned char* img, int wid, int lane) {
#pragma unroll
    for (int i = 0; i < 2; ++i) { const int p = wid * 2 + i, cb = p >> 2, tg = p & 3;
        __builtin_amdgcn_global_load_lds((const unsigned*)(src + (size_t)(tg * 16 + (lane >> 2)) * NPROJ + cb * 32 + (lane & 3) * 8), (LAS unsigned*)(img + p * 1024), 16, 0, 0); }
}
__device__ __forceinline__ void cumsum16(const bf16_t* gsrc, int kcol, int seg, float (&g)[16], float (&b)[16], LAS float* tot, float& r1, float& blast) {
#pragma unroll
    for (int i = 0; i < 16; ++i) g[i] = bf2f(gsrc[(size_t)(seg * 16 + i) * NPROJ + kcol]);
    float run = 0.f;
#pragma unroll
    for (int i = 0; i < 16; ++i) { run += g[i]; b[i] = run; }
    tot[seg * 128 + kcol] = run;
    LDS_WAIT(); __syncthreads();
    const float t0 = tot[kcol], t1 = tot[128 + kcol], t2 = tot[256 + kcol], t3 = tot[384 + kcol];
    const float off = seg == 0 ? 0.f : seg == 1 ? t0 : seg == 2 ? t0 + t1 : t0 + t1 + t2;
    r1 = t0 + t1; blast = (t0 + t1) + (t2 + t3);
#pragma unroll
    for (int i = 0; i < 16; ++i) b[i] += off;
}
__device__ __forceinline__ void pass_a4(int unit0, const bf16_t* PROJ, bf16_t* LT, float* DEC, LAS unsigned char* lds, const int wid) {
    const int lane = fresh_lane(), tid = wid * 64 + lane, r32 = lane & 31, hi = lane >> 5;
    __syncthreads();
#pragma unroll
    for (int i = 0; i < 8; ++i) { const int pp = wid * 8 + i, j = pp >> 4, p = pp & 15, cb = p >> 2, tg = p & 3; const int unit = unit0 + j, bh = unit >> 5, n = unit & 31;
        const size_t tok0 = (size_t)(bh >> 2) * SEQ + n * 64;
        __builtin_amdgcn_global_load_lds((const unsigned*)(PROJ + (tok0 + tg * 16 + (lane >> 2)) * NPROJ + PC_HI + (bh & 3) * 128 + cb * 32 + (lane & 3) * 8), (LAS unsigned*)(lds + j * 32768 + 16384 + p * 1024), 16, 0, 0); }
    { const int j = tid >> 7, kcol = tid & 127, unit = unit0 + j, bh = unit >> 5, n = unit & 31; const size_t tok0 = (size_t)(bh >> 2) * SEQ + n * 64;
      const bf16_t* gsrc = PROJ + tok0 * NPROJ + PC_HF + (bh & 3) * 128 + kcol;
      float g[64];
#pragma unroll
      for (int t = 0; t < 64; ++t) g[t] = bf2f(gsrc[(size_t)t * NPROJ]);
      float blast = 0.f;
#pragma unroll
      for (int t = 0; t < 64; ++t) blast += g[t];
      float run = 0.f; LAS unsigned char* kimg = lds + j * 32768 + (kcol >> 5) * 4096 + (kcol & 31) * 2;
#pragma unroll
      for (int t = 0; t < 64; ++t) { run += g[t]; const float kd = (1.f - __expf(g[t])) * __expf(blast - run);
          *(LAS bf16_t*)(kimg + (t >> 4) * 1024 + (t & 15) * 64) = (bf16_t)f2bf(kd); }
      DEC[(size_t)unit * 128 + kcol] = __expf(blast); }
    asm volatile("s_waitcnt vmcnt(0) lgkmcnt(0)" ::: "memory"); __syncthreads();
    { const int j = wid >> 1, s = wid & 1, unit = unit0 + j;
      const int lo_ = ((lane >> 4) & 1) * 32 + (lane & 3) * 8 + (4 * hi + ((lane & 15) >> 2)) * 64;
      const int kbase = (int)(unsigned)(size_t)(lds + j * 32768) + lo_, vbase = kbase + 16384;
      bf16_t* dstu = LT + (size_t)unit * 16384;
#pragma unroll
      for (int vv = 0; vv < 2; ++vv) { const int vb = 2 * s + vv;
        bf16x8 bfv[4];
#pragma unroll
        for (int ks = 0; ks < 4; ++ks) bfv[ks] = trfrag(vbase, vb * 4096 + ks * 1024);
#pragma unroll
        for (int kb = 0; kb < 4; ++kb) { f32x16 acc = f32x16{};
#pragma unroll
            for (int ks = 0; ks < 4; ++ks) { const bf16x8 afk = trfrag(kbase, kb * 4096 + ks * 1024); acc = __builtin_amdgcn_mfma_f32_32x32x16_bf16(afk, bfv[ks], acc, 0, 0, 0); }
            bf16_t* dst = dstu + (size_t)(vb * 32 + r32) * 128 + kb * 32 + 4 * hi;
#pragma unroll
            for (int g4 = 0; g4 < 4; ++g4) { u32x2 w; w.x = pk2(acc[4 * g4], acc[4 * g4 + 1]); w.y = pk2(acc[4 * g4 + 2], acc[4 * g4 + 3]); *(GAS u32x2*)(dst + 8 * g4) = w; } } } }
}
__device__ __forceinline__ void pass_b(const bf16_t* LT, const float* DEC, bf16_t* SST, int gtid, int gthreads) {
    for (int i = gtid; i < 32 * 4096; i += gthreads) {
        const int bh = i >> 12, e4 = i & 4095, k4 = (e4 & 31) * 4;
        f32x4 S = (f32x4){0.f, 0.f, 0.f, 0.f};
#pragma unroll 8
        for (int n = 0; n < 32; ++n) { const size_t u = (size_t)bh * 32 + n;
            u32x2 w; w.x = pk2(S.x, S.y); w.y = pk2(S.z, S.w);
            *(GAS u32x2*)(SST + u * 16384 + (size_t)e4 * 4) = w;
            const u32x2 Lw = *(const GAS u32x2*)(LT + u * 16384 + (size_t)e4 * 4); const f32x4 Dv = *(const GAS f32x4*)(DEC + u * 128 + k4);
            const f32x4 L = (f32x4){__builtin_bit_cast(float, Lw.x << 16), __builtin_bit_cast(float, Lw.x & 0xffff0000u), __builtin_bit_cast(float, Lw.y << 16), __builtin_bit_cast(float, Lw.y & 0xffff0000u)};
            S = Dv * S + L; }
    }
}
constexpr int C_QDEC = 0, C_QD1 = 16384, C_KD0 = 24576, C_KD1 = 32768, C_V = 49152, C_O = 81920, C_TOT = 115712;
struct PrefC { unsigned short g[16], q[16]; u32x4 gate[2]; bf16x8 S[8]; };
__device__ __forceinline__ void pass_c_prefetch(PrefC& P, int unit, const bf16_t* PROJ, const bf16_t* SST, LAS unsigned char* vimg, int tid, int lane, int wid) {
    const int bh = unit >> 5, n = unit & 31, h = bh & 3; const size_t tok0 = (size_t)(bh >> 2) * SEQ + n * 64;
    const int kcol = tid & 127, seg = tid >> 7, r32 = lane & 31, hi = lane >> 5, vb = wid >> 1;
    dma_tl(PROJ + tok0 * NPROJ + PC_HI + h * 128, vimg, wid, lane);
    const bf16_t* gs = PROJ + (tok0 + seg * 16) * NPROJ + PC_HF + h * 128 + kcol; const bf16_t* qs = PROJ + (tok0 + seg * 16) * NPROJ + PC_HQ + h * 128 + kcol;
#pragma unroll
    for (int i = 0; i < 16; ++i) { P.g[i] = gs[(size_t)i * NPROJ]; P.q[i] = qs[(size_t)i * NPROJ]; }
#pragma unroll
    for (int it = 0; it < 2; ++it) { const int task = it * 512 + tid, t = task >> 4, c8 = (task & 15) * 8; P.gate[it] = *(const GAS u32x4*)(PROJ + (tok0 + t) * NPROJ + PC_HG + h * 128 + c8); }
    const bf16_t* S = SST + (size_t)unit * 16384 + (size_t)(vb * 32 + r32) * 128 + 8 * hi;
#pragma unroll
    for (int kk = 0; kk < 8; ++kk) P.S[kk] = *(const GAS bf16x8*)(S + 16 * kk);
}
template <int NU>
__device__ __forceinline__ void pass_c_units(int unit0, const bf16_t* PROJ, const bf16_t* SST, const float* gout, bf16_t* MIX, LAS unsigned char* lds, const int wid) {
    const int lane = fresh_lane(), tid = wid * 64 + lane, r32 = lane & 31, hi = lane >> 5;
    const int kcol = tid & 127, seg = tid >> 7, I = wid & 1, vb = wid >> 1;
    LAS float* tot = (LAS float*)(lds + C_TOT); LAS float* ot = (LAS float*)(lds + C_O);
    __syncthreads();
    PrefC P;
    pass_c_prefetch(P, unit0, PROJ, SST, lds + C_V, tid, lane, wid);
#pragma unroll
    for (int u = 0; u < NU; ++u) {
        const int unit = unit0 + u, bh = unit >> 5, n = unit & 31, h = bh & 3; const size_t tok0 = (size_t)(bh >> 2) * SEQ + n * 64;
        LAS unsigned char* vimg = lds + C_V + (u & 1) * 16384;
        asm volatile("s_waitcnt vmcnt(0)" ::: "memory");
        float g[16], b[16];
        { float run = 0.f;
#pragma unroll
          for (int i = 0; i < 16; ++i) { g[i] = bf2f(P.g[i]); run += g[i]; b[i] = run; }
          tot[seg * 128 + kcol] = run; }
        LDS_WAIT(); __syncthreads();
        float r1;
        { const float t0 = tot[kcol], t1 = tot[128 + kcol], t2 = tot[256 + kcol];
          const float off = seg == 0 ? 0.f : seg == 1 ? t0 : seg == 2 ? t0 + t1 : t0 + t1 + t2; r1 = t0 + t1;
#pragma unroll
          for (int i = 0; i < 16; ++i) b[i] += off; }
        { const int cl = (kcol >> 3), ce = (kcol & 7) * 2;
#pragma unroll
          for (int i = 0; i < 16; ++i) { const int t = seg * 16 + i;
            const float q = bf2f(P.q[i]), kk = 1.f - __expf(g[i]);
            *(LAS bf16_t*)(lds + C_QDEC + cl * 1024 + t * 16 + ce) = (bf16_t)f2bf(q * __expf(b[i]));
            *(LAS bf16_t*)(lds + C_KD1 + cl * 1024 + t * 16 + ce) = (bf16_t)f2bf(kk * __expf(r1 - b[i]));
            if (seg < 2) *(LAS bf16_t*)(lds + C_KD0 + cl * 512 + t * 16 + ce) = (bf16_t)f2bf(kk * __expf(-b[i]));
            else *(LAS bf16_t*)(lds + C_QD1 + cl * 512 + (t - 32) * 16 + ce) = (bf16_t)f2bf(q * __expf(b[i] - r1)); } }
        bf16x8 Sf[8]; u32x4 gate[2];
#pragma unroll
        for (int kk = 0; kk < 8; ++kk) Sf[kk] = P.S[kk];
        gate[0] = P.gate[0]; gate[1] = P.gate[1];
        LDS_WAIT(); __syncthreads();
        if (u + 1 < NU) pass_c_prefetch(P, unit + 1, PROJ, SST, lds + C_V + ((u + 1) & 1) * 16384, tid, lane, wid);
        f32x16 o = f32x16{};
#pragma unroll
        for (int kk = 0; kk < 8; ++kk) {
            const bf16x8 a = *(const LAS bf16x8*)(lds + C_QDEC + (2 * kk + hi) * 1024 + (I * 32 + r32) * 16);
            o = __builtin_amdgcn_mfma_f32_32x32x16_bf16(a, Sf[kk], o, 0, 0, 0); }
        const int vbase = (int)(unsigned)(size_t)vimg + ((lane >> 4) & 1) * 32 + (lane & 3) * 8 + (4 * hi + ((lane & 15) >> 2)) * 64;
        for (int J = 0; J <= I; ++J) {
            f32x16 st = f32x16{};
#pragma unroll
            for (int kk = 0; kk < 8; ++kk) {
                const bf16x8 a = (I == 0) ? *(const LAS bf16x8*)(lds + C_KD0 + (2 * kk + hi) * 512 + r32 * 16) : *(const LAS bf16x8*)(lds + C_KD1 + (2 * kk + hi) * 1024 + (J * 32 + r32) * 16);
                const bf16x8 bq = (I == 0) ? *(const LAS bf16x8*)(lds + C_QDEC + (2 * kk + hi) * 1024 + r32 * 16) : *(const LAS bf16x8*)(lds + C_QD1 + (2 * kk + hi) * 512 + r32 * 16);
                st = __builtin_amdgcn_mfma_f32_32x32x16_bf16(a, bq, st, 0, 0, 0); }
            if (J == I) {
#pragma unroll
                for (int r = 0; r < 16; ++r) if (crow(r, hi) > r32) st[r] = 0.f; }
            u32x4 pw0, pw1;
            pw0 = (u32x4){pk2(st[0], st[1]), pk2(st[2], st[3]), pk2(st[4], st[5]), pk2(st[6], st[7])};
            pw1 = (u32x4){pk2(st[8], st[9]), pk2(st[10], st[11]), pk2(st[12], st[13]), pk2(st[14], st[15])};
            const bf16x8 v0 = trfrag(vbase, vb * 4096 + (2 * J) * 1024), v1 = trfrag(vbase, vb * 4096 + (2 * J + 1) * 1024);
            o = __builtin_amdgcn_mfma_f32_32x32x16_bf16(__builtin_bit_cast(bf16x8, pw0), v0, o, 0, 0, 0);
            o = __builtin_amdgcn_mfma_f32_32x32x16_bf16(__builtin_bit_cast(bf16x8, pw1), v1, o, 0, 0, 0);
        }
#pragma unroll
        for (int r = 0; r < 16; ++r) ot[(I * 32 + crow(r, hi)) * OPITCH + vb * 32 + r32] = o[r];
        LDS_WAIT(); __syncthreads();
#pragma unroll
        for (int it = 0; it < 2; ++it) { const int task = it * 512 + tid, t = task >> 4, c8 = (task & 15) * 8;
            const f32x4 x0 = *(const LAS f32x4*)(ot + t * OPITCH + c8), x1 = *(const LAS f32x4*)(ot + t * OPITCH + c8 + 4);
            float s = (x0.x * x0.x + x0.y * x0.y) + (x0.z * x0.z + x0.w * x0.w) + (x1.x * x1.x + x1.y * x1.y) + (x1.z * x1.z + x1.w * x1.w);
            s += __shfl_xor(s, 1); s += __shfl_xor(s, 2); s += __shfl_xor(s, 4); s += __shfl_xor(s, 8);
            const float rs = 1.f / sqrtf(s * (1.f / 128.f) + RMS_EPS);
            const f32x4 g0 = *(const GAS f32x4*)(gout + h * 128 + c8), g1 = *(const GAS f32x4*)(gout + h * 128 + c8 + 4);
            const u32x4 gt = gate[it];
            u32x4 w;
            w.x = pk2(x0.x * rs * g0.x * __builtin_bit_cast(float, gt.x << 16), x0.y * rs * g0.y * __builtin_bit_cast(float, gt.x & 0xffff0000u));
            w.y = pk2(x0.z * rs * g0.z * __builtin_bit_cast(float, gt.y << 16), x0.w * rs * g0.w * __builtin_bit_cast(float, gt.y & 0xffff0000u));
            w.z = pk2(x1.x * rs * g1.x * __builtin_bit_cast(float, gt.z << 16), x1.y * rs * g1.y * __builtin_bit_cast(float, gt.z & 0xffff0000u));
            w.w = pk2(x1.z * rs * g1.z * __builtin_bit_cast(float, gt.w << 16), x1.w * rs * g1.w * __builtin_bit_cast(float, gt.w & 0xffff0000u));
            *(GAS u32x4*)(MIX + (tok0 + t) * 1024 + 512 + h * 128 + c8) = w; }
    }
}
}

struct EpiY {
    static constexpr bool PERM = false;
    float* Y; const bf16_t* H0;
    __device__ __forceinline__ void operator()(const f32x4 (&acc)[2][2][4][2], const pg8::Unit& u, int wr, int wc, int fr, int fq) const {
#pragma unroll
        for (int ai = 0; ai < 2; ++ai)
#pragma unroll
            for (int m = 0; m < 4; ++m) { const size_t row = (size_t)u.pm * 256 + ai * 128 + wr * 64 + m * 16 + fr;
#pragma unroll
                for (int bj = 0; bj < 2; ++bj)
#pragma unroll
                    for (int n = 0; n < 2; ++n) { const int c = u.pn * 256 + bj * 128 + wc * 32 + 16 * n + 4 * fq;
                        const u32x2 hv = *(const u32x2*)(H0 + row * 1024 + c);
                        f32x4 o = acc[ai][bj][m][n];
                        o.x += DN_ALPHA * __builtin_bit_cast(float, hv.x << 16); o.y += DN_ALPHA * __builtin_bit_cast(float, hv.x & 0xffff0000u);
                        o.z += DN_ALPHA * __builtin_bit_cast(float, hv.y << 16); o.w += DN_ALPHA * __builtin_bit_cast(float, hv.y & 0xffff0000u);
                        *(f32x4*)(Y + row * 1024 + c) = o; } }
    }
};

__device__ __forceinline__ void p6_router(Frame& F, const Args& a) {
    F.refresh();
    typedef float f32x16 __attribute__((ext_vector_type(16)));
    const float* Y = (const float*)(F.ws + WS_Y); bf16_t* H1 = (bf16_t*)(F.ws + WS_H1);
    const float* g = (const float*)a.in[13]; const float* bta = (const float*)a.in[14]; const float* br = (const float*)a.in[16];
    constexpr int APITCH = 2064, A_LO = 32 * APITCH;
    LAS unsigned* cnt = (LAS unsigned*)(F.lds + XTRA_OFF + 2048); LAS unsigned* base = cnt + 32;
    LAS int* asg_e = (LAS int*)(cnt + 64); LAS int* asg_r = asg_e + 256; LAS float* asg_g = (LAS float*)(asg_r + 256);
    LAS float* part = (LAS float*)F.lds; LAS float* logit = part + 8 * 1024;
    if (F.tid < 32) cnt[F.tid] = 0u;
    const int e = F.lane & 31, hi = F.lane >> 5, r32 = e, k0 = F.wave * 128;
    bf16x8 Bh[8], Bl[8];
    { const bf16_t* wh = (const bf16_t*)(F.ws + WS_WRH) + (size_t)e * 1024 + k0 + 8 * hi; const bf16_t* wl = (const bf16_t*)(F.ws + WS_WRL) + (size_t)e * 1024 + k0 + 8 * hi;
#pragma unroll
      for (int kk = 0; kk < 8; ++kk) { Bh[kk] = *(const GAS bf16x8*)(wh + 16 * kk); Bl[kk] = *(const GAS bf16x8*)(wl + 16 * kk); } }
    const float be = br[e];
    for (int p = 0; p < 2; ++p) {
        __syncthreads();
#pragma unroll
        for (int r = 0; r < 4; ++r) {
            const int rb = F.wave * 4 + r; const size_t row = (size_t)F.vcu * 64 + p * 32 + rb;
            const GAS f32x4* yr = (const GAS f32x4*)(Y + row * 1024) + F.lane;
            f32x4 v[4]; float s = 0.f;
#pragma unroll
            for (int j = 0; j < 4; ++j) { v[j] = yr[64 * j]; s += (v[j].x + v[j].y) + (v[j].z + v[j].w); }
            const float mean = wave_sum(s) * (1.f / D); float s2 = 0.f;
#pragma unroll
            for (int j = 0; j < 4; ++j) { v[j] = v[j] - mean; s2 += (v[j].x * v[j].x + v[j].y * v[j].y) + (v[j].z * v[j].z + v[j].w * v[j].w); }
            const float rstd = 1.f / sqrtf(wave_sum(s2) * (1.f / D) + LN_EPS);
            GAS unsigned long long* o8 = (GAS unsigned long long*)(H1 + row * 1024) + F.lane;
#pragma unroll
            for (int j = 0; j < 4; ++j) { const f32x4 gg = *((const GAS f32x4*)g + F.lane + 64 * j), bb = *((const GAS f32x4*)bta + F.lane + 64 * j);
                const f32x4 o = v[j] * rstd * gg + bb;
                const unsigned h0 = f2bf(o.x), h1_ = f2bf(o.y), h2 = f2bf(o.z), h3 = f2bf(o.w);
                const unsigned long long hw = (unsigned long long)(h0 | (h1_ << 16)) | ((unsigned long long)(h2 | (h3 << 16)) << 32);
                o8[64 * j] = hw;
#if MOE_FP8
                *((GAS unsigned*)((unsigned char*)(F.ws + WS_H1F8) + row * 1024) + F.lane + 64 * j) = pk4_fp8(o.x, o.y, o.z, o.w);
#endif
                const unsigned l0 = pk2(o.x - __builtin_bit_cast(float, h0 << 16), o.y - __builtin_bit_cast(float, h1_ << 16)), l1 = pk2(o.z - __builtin_bit_cast(float, h2 << 16), o.w - __builtin_bit_cast(float, h3 << 16));
                *(LAS unsigned long long*)(F.lds + rb * APITCH + 8 * (F.lane + 64 * j)) = hw;
                *(LAS unsigned long long*)(F.lds + A_LO + rb * APITCH + 8 * (F.lane + 64 * j)) = (unsigned long long)l0 | ((unsigned long long)l1 << 32); }
        }
        LDS_WAIT(); __syncthreads();
        f32x16 acc = f32x16{};
#pragma unroll
        for (int kk = 0; kk < 8; ++kk) {
            const bf16x8 ah = *(const LAS bf16x8*)(F.lds + r32 * APITCH + (k0 + 16 * kk + 8 * hi) * 2), al = *(const LAS bf16x8*)(F.lds + A_LO + r32 * APITCH + (k0 + 16 * kk + 8 * hi) * 2);
            acc = __builtin_amdgcn_mfma_f32_32x32x16_bf16(ah, Bh[kk], acc, 0, 0, 0);
            acc = __builtin_amdgcn_mfma_f32_32x32x16_bf16(ah, Bl[kk], acc, 0, 0, 0);
            acc = __builtin_amdgcn_mfma_f32_32x32x16_bf16(al, Bh[kk], acc, 0, 0, 0); }
        LDS_WAIT(); __syncthreads();
#pragma unroll
        for (int r = 0; r < 16; ++r) part[F.wave * 1024 + ((r & 3) + 8 * (r >> 2) + 4 * hi) * 32 + r32] = acc[r];
        LDS_WAIT(); __syncthreads();
#pragma unroll
        for (int q = 0; q < 2; ++q) { const int o = q * 512 + F.tid; float s = 0.f;
#pragma unroll
            for (int w = 0; w < 8; ++w) s += part[w * 1024 + o];
            logit[o] = s; }
        LDS_WAIT(); __syncthreads();
#pragma unroll
        for (int r = 0; r < 4; ++r) {
            const int rb = F.wave * 4 + r;
            float val = logit[rb * 32 + e] + be;
            int se[4]; float sl[4];
#pragma unroll
            for (int k = 0; k < 4; ++k) { float bv = val; int bi = e;
#pragma unroll
                for (int o = 1; o < 32; o <<= 1) { const float ov = __shfl_xor(bv, o); const int oi = __shfl_xor(bi, o); if (ov > bv || (ov == bv && oi < bi)) { bv = ov; bi = oi; } }
                se[k] = bi; sl[k] = bv; if (e == bi) val = -INFINITY; }
            const float e1 = __expf(sl[1] - sl[0]), e2 = __expf(sl[2] - sl[0]), e3 = __expf(sl[3] - sl[0]); const float inv = 1.f / (1.f + e1 + e2 + e3);
            const float gk[4] = {inv, e1 * inv, e2 * inv, e3 * inv};
            if (F.lane < 4) { const int k = F.lane; const int ee = k == 0 ? se[0] : k == 1 ? se[1] : k == 2 ? se[2] : se[3]; const float gg = k == 0 ? gk[0] : k == 1 ? gk[1] : k == 2 ? gk[2] : gk[3];
                const unsigned rank = __hip_atomic_fetch_add(&cnt[ee], 1u, __ATOMIC_RELAXED, __HIP_MEMORY_SCOPE_WORKGROUP); const int ai = (p * 32 + rb) * 4 + k;
                asg_e[ai] = ee; asg_r[ai] = (int)rank; asg_g[ai] = gg; }
        }
    }
    LDS_WAIT(); __syncthreads();
    F.refresh();
    if (F.tid < 32) base[F.tid] = __hip_atomic_fetch_add((unsigned*)(F.ctl + CW_CNT) + F.tid, cnt[F.tid], __ATOMIC_RELAXED, __HIP_MEMORY_SCOPE_AGENT);
    __syncthreads();
    if (F.tid < 256) { const int ee = asg_e[F.tid]; const int pos = (int)base[ee] + asg_r[F.tid]; const int tok = F.vcu * 64 + (F.tid >> 2);
        ((int*)(F.ws + WS_LTOK))[(size_t)ee * T + pos] = tok; ((float*)(F.ws + WS_LGATE))[(size_t)ee * T + pos] = asg_g[F.tid];
        ((int*)(F.ws + WS_TSLOT))[(size_t)tok * 4 + (F.tid & 3)] = (ee << 16) | pos; }
}
__device__ __forceinline__ void moe_table(Frame& F) {
    F.refresh();
    LAS int* cnt = (LAS int*)(F.lds + XTRA_OFF + 4096); LAS int* tstart = cnt + 32;
    if (F.tid < 32) cnt[F.tid] = (int)__hip_atomic_load(F.ctl + CW_CNT + F.tid, RLX_AGENT);
    __syncthreads();
    if (F.tid == 0) { int s = 0; for (int e = 0; e < 32; ++e) { tstart[e] = s; s += (cnt[e] + 255) >> 8; } tstart[32] = s; }
    __syncthreads();
}
template <bool GATH>
struct MoeOrder {
    const void* A; const void* Bt; int lda, K, npn, G, c; size_t bstride; const LAS int* cnt; const LAS int* tstart; const int* list; int esz;
    static constexpr bool GATHER = GATH;
    __device__ __forceinline__ bool next(int i, pg8::Unit& u) const {
        const int L = i * G + c; const int rt = L / npn;
        if (rt >= tstart[32]) return false;
        int e = 0; while (rt >= tstart[e + 1]) ++e;
        u.pm = rt; u.pn = L - rt * npn; u.e = e; return true;
    }
    __device__ __forceinline__ const char* a_base(const pg8::Unit& u) const { return GATH ? (const char*)A : (const char*)A + (size_t)u.pm * 256 * lda * esz; }
    __device__ __forceinline__ const char* b_base(const pg8::Unit& u) const { return (const char*)Bt + ((size_t)u.e * bstride + (size_t)u.pn * 256 * K) * esz; }
    __device__ __forceinline__ void a_offs(const pg8::Unit& u, const int (&R)[2], const int (&C)[2], unsigned (&v)[2][2]) const {
#pragma unroll
        for (int h = 0; h < 2; ++h)
#pragma unroll
            for (int i = 0; i < 2; ++i) {
                if (GATH) { const int slot = (u.pm - tstart[u.e]) * 256 + h * 128 + R[i]; const int tok = slot < cnt[u.e] ? list[(size_t)u.e * T + slot] : 0; v[h][i] = (unsigned)(tok * lda * esz + C[i] * 2); }
                else v[h][i] = (unsigned)((h * 128 + R[i]) * lda * esz + C[i] * 2); }
    }
};
constexpr float SW_LIMIT = 7.0f, SW_ALPHA = 1.702f;
#if !MOE_FP8
struct EpiUp {
    static constexpr bool PERM = true;
    bf16_t* ACT; const float* bup;
    __device__ __forceinline__ void operator()(const f32x4 (&acc)[2][2][4][2], const pg8::Unit& u, int wr, int wc, int fr, int fq) const {
        const int c8 = wc * 32 + 8 * fq; const float* bg = bup + (size_t)u.e * 2048 + u.pn * 128 + c8; const float* bl = bg + 1024;
        const f32x4 bg0 = *(const f32x4*)bg, bg1 = *(const f32x4*)(bg + 4), bl0 = *(const f32x4*)bl, bl1 = *(const f32x4*)(bl + 4);
#pragma unroll
        for (int ai = 0; ai < 2; ++ai)
#pragma unroll
            for (int m = 0; m < 4; ++m) { const size_t row = (size_t)u.pm * 256 + ai * 128 + wr * 64 + m * 16 + fr;
                float v[8];
#pragma unroll
                for (int j = 0; j < 8; ++j) { float gl = (j < 4 ? acc[ai][0][m][0][j] + bg0[j] : acc[ai][0][m][1][j - 4] + bg1[j - 4]), li = (j < 4 ? acc[ai][1][m][0][j] + bl0[j] : acc[ai][1][m][1][j - 4] + bl1[j - 4]);
                    gl = fminf(gl, SW_LIMIT); li = fminf(fmaxf(li, -SW_LIMIT), SW_LIMIT);
                    v[j] = gl * __builtin_amdgcn_rcpf(1.f + __expf(-SW_ALPHA * gl)) * (li + 1.f); }
                u32x4 w; w.x = pk2(v[0], v[1]); w.y = pk2(v[2], v[3]); w.z = pk2(v[4], v[5]); w.w = pk2(v[6], v[7]);
                *(u32x4*)(ACT + row * 1024 + u.pn * 128 + c8) = w; }
    }
};
struct EpiDown {
    static constexpr bool PERM = true;
    bf16_t* YS; const float* bdn; const float* lgate; const LAS int* cnt; const LAS int* tstart;
    __device__ __forceinline__ void operator()(const f32x4 (&acc)[2][2][4][2], const pg8::Unit& u, int wr, int wc, int fr, int fq) const {
        const int nvalid = cnt[u.e] - (u.pm - tstart[u.e]) * 256;
#pragma unroll
        for (int ai = 0; ai < 2; ++ai)
#pragma unroll
            for (int m = 0; m < 4; ++m) { const int rl = ai * 128 + wr * 64 + m * 16 + fr; const size_t row = (size_t)u.pm * 256 + rl;
                const float gt = rl < nvalid ? lgate[(size_t)u.e * T + (u.pm - tstart[u.e]) * 256 + rl] : 0.f;
#pragma unroll
                for (int bj = 0; bj < 2; ++bj) { const int c0 = u.pn * 256 + bj * 128 + wc * 32 + 8 * fq; const float* bp = bdn + (size_t)u.e * 1024 + c0;
                    const f32x4 b0 = *(const f32x4*)bp, b1 = *(const f32x4*)(bp + 4);
                    u32x4 w; w.x = pk2((acc[ai][bj][m][0][0] + b0.x) * gt, (acc[ai][bj][m][0][1] + b0.y) * gt); w.y = pk2((acc[ai][bj][m][0][2] + b0.z) * gt, (acc[ai][bj][m][0][3] + b0.w) * gt);
                    w.z = pk2((acc[ai][bj][m][1][0] + b1.x) * gt, (acc[ai][bj][m][1][1] + b1.y) * gt); w.w = pk2((acc[ai][bj][m][1][2] + b1.z) * gt, (acc[ai][bj][m][1][3] + b1.w) * gt);
                    *(u32x4*)(YS + row * 1024 + c0) = w; } }
    }
};
#else
struct EpiUp {
    static constexpr bool PERM = true;
    unsigned char* ACT; const float* bup;
    __device__ __forceinline__ void operator()(const f32x4 (&acc)[2][2][4][2], const pg8::Unit& u, int wr, int wc, int fr, int fq) const {
        const int c8 = wc * 32 + 8 * fq; const float* bg = bup + (size_t)u.e * 2048 + u.pn * 128 + c8; const float* bl = bg + 1024;
        const f32x4 bg0 = *(const f32x4*)bg, bg1 = *(const f32x4*)(bg + 4), bl0 = *(const f32x4*)bl, bl1 = *(const f32x4*)(bl + 4);
        constexpr float IS = 1.f / W8_SCALE;
#pragma unroll
        for (int ai = 0; ai < 2; ++ai)
#pragma unroll
            for (int m = 0; m < 4; ++m) { const size_t row = (size_t)u.pm * 256 + ai * 128 + wr * 64 + m * 16 + fr;
                float v[8];
#pragma unroll
                for (int j = 0; j < 8; ++j) { float gl = (j < 4 ? acc[ai][0][m][0][j] * IS + bg0[j] : acc[ai][0][m][1][j - 4] * IS + bg1[j - 4]), li = (j < 4 ? acc[ai][1][m][0][j] * IS + bl0[j] : acc[ai][1][m][1][j - 4] * IS + bl1[j - 4]);
                    gl = fminf(gl, SW_LIMIT); li = fminf(fmaxf(li, -SW_LIMIT), SW_LIMIT);
                    v[j] = ACT8_SCALE * gl * __builtin_amdgcn_rcpf(1.f + __expf(-SW_ALPHA * gl)) * (li + 1.f); }
                u32x2 w; w.x = pk4_fp8(v[0], v[1], v[2], v[3]); w.y = pk4_fp8(v[4], v[5], v[6], v[7]);
                *(u32x2*)(ACT + row * 1024 + u.pn * 128 + c8) = w; }
    }
};
struct EpiDown {
    static constexpr bool PERM = true;
    bf16_t* YS; const float* bdn; const float* lgate; const LAS int* cnt; const LAS int* tstart;
    __device__ __forceinline__ void operator()(const f32x4 (&acc)[2][2][4][2], const pg8::Unit& u, int wr, int wc, int fr, int fq) const {
        const int nvalid = cnt[u.e] - (u.pm - tstart[u.e]) * 256;
        constexpr float IS = 1.f / (W8_SCALE * ACT8_SCALE);
#pragma unroll
        for (int ai = 0; ai < 2; ++ai)
#pragma unroll
            for (int m = 0; m < 4; ++m) { const int rl = ai * 128 + wr * 64 + m * 16 + fr; const size_t row = (size_t)u.pm * 256 + rl;
                const float gt = rl < nvalid ? lgate[(size_t)u.e * T + (u.pm - tstart[u.e]) * 256 + rl] : 0.f;
#pragma unroll
                for (int bj = 0; bj < 2; ++bj) { const int c0 = u.pn * 256 + bj * 128 + wc * 32 + 8 * fq; const float* bp = bdn + (size_t)u.e * 1024 + c0;
                    const f32x4 b0 = *(const f32x4*)bp, b1 = *(const f32x4*)(bp + 4);
                    u32x4 w; w.x = pk2((acc[ai][bj][m][0][0] * IS + b0.x) * gt, (acc[ai][bj][m][0][1] * IS + b0.y) * gt); w.y = pk2((acc[ai][bj][m][0][2] * IS + b0.z) * gt, (acc[ai][bj][m][0][3] * IS + b0.w) * gt);
                    w.z = pk2((acc[ai][bj][m][1][0] * IS + b1.x) * gt, (acc[ai][bj][m][1][1] * IS + b1.y) * gt); w.w = pk2((acc[ai][bj][m][1][2] * IS + b1.z) * gt, (acc[ai][bj][m][1][3] * IS + b1.w) * gt);
                    *(u32x4*)(YS + row * 1024 + c0) = w; } }
    }
};
#endif
__device__ __forceinline__ void p9_final(Frame& F, const Args& a) {
    F.refresh();
    const LAS int* tstart = (const LAS int*)(F.lds + XTRA_OFF + 4096) + 32;
    const bf16_t* H1 = (const bf16_t*)(F.ws + WS_H1); const bf16_t* YS = (const bf16_t*)(F.ws + WS_YS); const int* ts = (const int*)(F.ws + WS_TSLOT);
    const float* g = (const float*)a.in[21]; const float* bta = (const float*)a.in[22];
    const int gw = F.vcu * 8 + F.wave, NGW = F.G * 8;
    for (int m = gw; m < T; m += NGW) {
        float v[16];
#pragma unroll
        for (int j = 0; j < 2; ++j) { const u32x4 h = *(const GAS u32x4*)(H1 + (size_t)m * 1024 + 512 * j + 8 * F.lane);
#pragma unroll
            for (int q = 0; q < 4; ++q) { v[8 * j + 2 * q] = DN_ALPHA * __builtin_bit_cast(float, h[q] << 16); v[8 * j + 2 * q + 1] = DN_ALPHA * __builtin_bit_cast(float, h[q] & 0xffff0000u); } }
#pragma unroll
        for (int k = 0; k < 4; ++k) { const int sl = ts[(size_t)m * 4 + k]; const size_t row = (size_t)tstart[sl >> 16] * 256 + (sl & 0xffff);
#pragma unroll
            for (int j = 0; j < 2; ++j) { const u32x4 y = *(const GAS u32x4*)(YS + row * 1024 + 512 * j + 8 * F.lane);
#pragma unroll
                for (int q = 0; q < 4; ++q) { v[8 * j + 2 * q] += __builtin_bit_cast(float, y[q] << 16); v[8 * j + 2 * q + 1] += __builtin_bit_cast(float, y[q] & 0xffff0000u); } } }
        float s = 0.f;
#pragma unroll
        for (int i = 0; i < 16; ++i) s += v[i];
        const float mean = wave_sum(s) * (1.f / D); float s2 = 0.f;
#pragma unroll
        for (int i = 0; i < 16; ++i) { v[i] -= mean; s2 += v[i] * v[i]; }
        const float rstd = 1.f / sqrtf(wave_sum(s2) * (1.f / D) + LN_EPS);
#pragma unroll
        for (int j = 0; j < 2; ++j)
#pragma unroll
            for (int q = 0; q < 2; ++q) { const int c = 512 * j + 8 * F.lane + 4 * q; const f32x4 gg = *(const GAS f32x4*)(g + c), bb = *(const GAS f32x4*)(bta + c);
                f32x4 o; o.x = v[8 * j + 4 * q] * rstd * gg.x + bb.x; o.y = v[8 * j + 4 * q + 1] * rstd * gg.y + bb.y; o.z = v[8 * j + 4 * q + 2] * rstd * gg.z + bb.z; o.w = v[8 * j + 4 * q + 3] * rstd * gg.w + bb.w;
                *(GAS f32x4*)(a.out + (size_t)m * 1024 + c) = o; }
    }
}

__device__ __forceinline__ void dbg_fail(Frame& F, int id) { atomicOr((unsigned*)(F.ctl + CW_DBG), 1u << id); }
__device__ __forceinline__ bool close_enough(float got, float want, float atol, float rtol) { const float d = fabsf(got - want); return d <= atol + rtol * fabsf(want); }
__device__ __forceinline__ void dbg_check_proj(Frame& F, const Args& a) {
    F.refresh();
    const int NS = 16;
    if (F.vcu >= NS) return;
    const int row = (F.vcu * 1093 + 7) % T;
    const float* x = (const float*)a.in[0] + (size_t)row * D; const float* g = (const float*)a.in[2]; const float* b = (const float*)a.in[3];
    const float* w_in = (const float*)a.in[4]; const int* pos = (const int*)a.in[1]; const float* lbl = (const float*)a.in[9];
    LAS float* h = (LAS float*)F.lds; LAS float* red = h + 1024;
    float s = 0.f; for (int k = F.tid; k < D; k += 512) s += x[k];
    s = wave_sum(s); if (F.lane == 0) red[F.wave] = s; __syncthreads();
    float mean = 0.f; for (int w = 0; w < 8; ++w) mean += red[w]; mean *= (1.f / D); __syncthreads();
    float q = 0.f; for (int k = F.tid; k < D; k += 512) { const float d = x[k] - mean; q += d * d; }
    q = wave_sum(q); if (F.lane == 0) red[F.wave] = q; __syncthreads();
    float var = 0.f; for (int w = 0; w < 8; ++w) var += red[w]; var *= (1.f / D);
    const float rstd = 1.f / sqrtf(var + LN_EPS);
    const bf16_t* H0 = (const bf16_t*)(F.ws + WS_H0) + (size_t)row * D;
    for (int k = F.tid; k < D; k += 512) { const float hv = (x[k] - mean) * rstd * g[k] + b[k]; h[k] = hv; if (!close_enough(bf2f(H0[k]), hv, 0.02f, 0.01f)) dbg_fail(F, 1); }
    __syncthreads();
    const bf16_t* P = (const bf16_t*)(F.ws + WS_PROJ) + (size_t)row * NPROJ;
    for (int n = F.tid; n < IN_COLS; n += 512) {
        float acc = 0.f; for (int k = 0; k < D; ++k) acc += h[k] * w_in[(size_t)k * IN_COLS + n];
        float want; int c;
        if (n < 384) { c = PC_QA + n; want = acc; }
        else if (n < 640) { c = PC_KVA + (n - 384); want = acc; }
        else if (n < 672) {
            const int j = n - 640, i = j & 15, half = j >> 4; const int n2 = 640 + (1 - half) * 16 + i;
            float acc2 = 0.f; for (int k = 0; k < D; ++k) acc2 += h[k] * w_in[(size_t)k * IN_COLS + n2];
            const float inv = powf(10000.0f, -(float)(2 * i) / 32.0f); const float ang = (float)pos[row] * inv;
            const float cc = cosf(ang), ss = sinf(ang);
            const float x1 = half == 0 ? acc : acc2, x2 = half == 0 ? acc2 : acc;
            want = half == 0 ? x1 * cc - x2 * ss : x1 * ss + x2 * cc; c = PC_KR + 2 * i + half; }
        else if (n < 1184) { c = PC_HQ + (n - 672); want = acc / (1.f + expf(-acc)); }
        else if (n < 1696) { const int cc_ = n - 1184; c = PC_HF + cc_; const float lb = 1.f / (1.f + expf(lbl[512 + cc_] - lbl[cc_])); const float sg = 1.f / (1.f + expf(-acc)); want = logf(lb + (1.f - lb) * sg); }
        else if (n < 2208) { c = PC_HI + (n - 1696); want = acc; }
        else { c = PC_HG + (n - 2208); want = acc / (1.f + expf(-acc)); }
        if (!close_enough(bf2f(P[c]), want, 0.03f, 0.02f)) dbg_fail(F, 2);
    }
    for (int c = 672 + F.tid; c < 768; c += 512) if (bf2f(P[c]) != 0.f) dbg_fail(F, 3);
}
__device__ __forceinline__ void dbg_check_qkv(Frame& F, const Args& a) {
    F.refresh();
    const int NS = 16;
    if (F.vcu >= NS) return;
    const int row = (F.vcu * 2731 + 11) % T;
    const bf16_t* P = (const bf16_t*)(F.ws + WS_PROJ) + (size_t)row * NPROJ;
    const float* qg = (const float*)a.in[5]; const float* w_qb = (const float*)a.in[6]; const float* kvg = (const float*)a.in[7]; const float* w_kvb = (const float*)a.in[8];
    const int* pos = (const int*)a.in[1];
    LAS float* qa = (LAS float*)F.lds; LAS float* kva = qa + 384; LAS float* qraw = kva + 256;
    float sq = 0.f, sk = 0.f;
    for (int k = 0; k < 384; ++k) { const float v = bf2f(P[PC_QA + k]); sq += v * v; }
    for (int k = 0; k < 256; ++k) { const float v = bf2f(P[PC_KVA + k]); sk += v * v; }
    const float rq = 1.f / sqrtf(sq / 384.f + RMS_EPS), rk = 1.f / sqrtf(sk / 256.f + RMS_EPS);
    for (int k = F.tid; k < 384; k += 512) qa[k] = bf2f(P[PC_QA + k]) * rq * qg[k];
    for (int k = F.tid; k < 256; k += 512) kva[k] = bf2f(P[PC_KVA + k]) * rk * kvg[k];
    __syncthreads();
    for (int n = F.tid; n < 768; n += 512) { float acc = 0.f; for (int k = 0; k < 384; ++k) acc += qa[k] * w_qb[(size_t)k * 768 + n]; qraw[n] = acc; }
    __syncthreads();
    const bf16_t* Qb = (const bf16_t*)(F.ws + WS_Q) + (size_t)row * 768;
    for (int n = F.tid; n < 768; n += 512) {
        const int h = n / 96, d = n % 96; float want; int c;
        if (d < 64) { want = qraw[n]; c = n; }
        else { const int j = d - 64, i = j & 15, half = j >> 4; const float x1 = qraw[h * 96 + 64 + i], x2 = qraw[h * 96 + 80 + i];
            const float inv = powf(10000.0f, -(float)(2 * i) / 32.0f); const float ang = (float)pos[row] * inv; const float cc = cosf(ang), ss = sinf(ang);
            want = half == 0 ? x1 * cc - x2 * ss : x1 * ss + x2 * cc; c = h * 96 + 64 + 2 * i + half; }
        want *= QSCALE;
        if (!close_enough(bf2f(Qb[c]), want, 0.006f, 0.02f)) dbg_fail(F, 4);
    }
    const bf16_t* KVb = (const bf16_t*)(F.ws + WS_KV) + (size_t)row * 1024;
    for (int n = F.tid; n < 1024; n += 512) { float acc = 0.f; for (int k = 0; k < 256; ++k) acc += kva[k] * w_kvb[(size_t)k * 1024 + n];
        if (!close_enough(bf2f(KVb[n]), acc, 0.03f, 0.02f)) dbg_fail(F, 5); }
    __syncthreads();
}
__device__ __forceinline__ void dbg_check_attn(Frame& F) {
    F.refresh();
    const int NS = 64;
    if (F.vcu >= NS) return;
    const int t = (F.vcu * 4099 + 5 * F.vcu * F.vcu + 63) % T, h = F.vcu & 7;
    const int b = t / SEQ, tl = t % SEQ, nk = ((tl >> 6) + 1) * 64;
    const bf16_t* Q = (const bf16_t*)(F.ws + WS_Q) + (size_t)t * 768 + h * 96;
    const bf16_t* KV = (const bf16_t*)(F.ws + WS_KV) + (size_t)b * SEQ * 1024 + h * 128;
    const bf16_t* PR = (const bf16_t*)(F.ws + WS_PROJ) + (size_t)b * SEQ * NPROJ + PC_KR;
    LAS float* sc = (LAS float*)F.lds; LAS float* red = sc + 2048; LAS float* ov = red + 16;
    float mx = -INFINITY;
    for (int j = F.tid; j < nk; j += 512) { float s = 0.f;
        for (int d = 0; d < 64; ++d) s += bf2f(Q[d]) * bf2f(KV[(size_t)j * 1024 + d]);
        for (int d = 0; d < 32; ++d) s += bf2f(Q[64 + d]) * bf2f(PR[(size_t)j * NPROJ + d]);
        sc[j] = s; mx = fmaxf(mx, s); }
    for (int o = 1; o < 64; o <<= 1) mx = fmaxf(mx, __shfl_xor(mx, o));
    if (F.lane == 0) red[F.wave] = mx; __syncthreads();
    mx = red[0]; for (int w = 1; w < 8; ++w) mx = fmaxf(mx, red[w]); __syncthreads();
    float sm = 0.f;
    for (int j = F.tid; j < nk; j += 512) { const float p = exp2f(sc[j] - mx); sc[j] = p; sm += p; }
    sm = wave_sum(sm); if (F.lane == 0) red[F.wave] = sm; __syncthreads();
    float tot = 0.f; for (int w = 0; w < 8; ++w) tot += red[w];
    const bf16_t* M = (const bf16_t*)(F.ws + WS_MIX) + (size_t)t * 1024 + h * 64;
    if (F.tid < 64) { float acc = 0.f; for (int j = 0; j < nk; ++j) acc += sc[j] * bf2f(KV[(size_t)j * 1024 + 64 + F.tid]); acc /= tot; ov[F.tid] = acc;
        if (!close_enough(bf2f(M[F.tid]), acc, 0.01f, 0.03f)) dbg_fail(F, 6); }
    __syncthreads();
    if (F.tid == 0) { float s = 0.f; for (int d = 0; d < 64; ++d) s += ov[d] * ov[d]; const float got = ((const float*)(F.ws + WS_SSQ))[(size_t)t * 8 + h];
        if (!close_enough(got, s, 0.002f, 0.05f)) dbg_fail(F, 7); }
    __syncthreads();
}
__device__ __forceinline__ void dbg_check_norm(Frame& F, const float* g) {
    F.refresh();
    if (F.vcu >= 16 || F.tid != 0) return;
    const int t = (F.vcu * 1021 + 3) % T; const bf16_t* M = (const bf16_t*)(F.ws + WS_MIX) + (size_t)t * 1024;
    float s = 0.f; for (int c = 0; c < 512; ++c) { const float v = bf2f(M[c]) / g[c]; s += v * v; }
    if (!close_enough(s / 512.f, 1.f, 0.02f, 0.f)) dbg_fail(F, 8);
}
__device__ __forceinline__ void dbg_check_hgrn(Frame& F, const float* gout) {
    F.refresh();
    if (F.vcu >= 8) return;
    const int sidx = F.vcu * 8 + F.wave;
    const int tl = (sidx * 397 + 61 * (sidx & 7) + 5) % SEQ, b = sidx & 7, h = (sidx >> 3) & 3;
    const bf16_t* P = (const bf16_t*)(F.ws + WS_PROJ) + (size_t)b * SEQ * NPROJ;
    const int k0 = F.lane, k1 = F.lane + 64;
    const float q0 = bf2f(P[(size_t)tl * NPROJ + PC_HQ + h * 128 + k0]), q1 = bf2f(P[(size_t)tl * NPROJ + PC_HQ + h * 128 + k1]);
    float dec0 = 1.f, dec1 = 1.f, o0 = 0.f, o1 = 0.f;
    for (int s = tl; s >= 0; --s) {
        const bf16_t* ps = P + (size_t)s * NPROJ;
        const float g0 = bf2f(ps[PC_HF + h * 128 + k0]), g1 = bf2f(ps[PC_HF + h * 128 + k1]);
        float c = q0 * (1.f - expf(g0)) * dec0 + q1 * (1.f - expf(g1)) * dec1;
        c = wave_sum(c);
        o0 += c * bf2f(ps[PC_HI + h * 128 + k0]); o1 += c * bf2f(ps[PC_HI + h * 128 + k1]);
        dec0 *= expf(g0); dec1 *= expf(g1);
    }
    const float ss = wave_sum(o0 * o0 + o1 * o1), rs = 1.f / sqrtf(ss / 128.f + RMS_EPS);
    const bf16_t* pt = P + (size_t)tl * NPROJ;
    const float w0 = o0 * rs * gout[h * 128 + k0] * bf2f(pt[PC_HG + h * 128 + k0]), w1 = o1 * rs * gout[h * 128 + k1] * bf2f(pt[PC_HG + h * 128 + k1]);
    const bf16_t* M = (const bf16_t*)(F.ws + WS_MIX) + ((size_t)b * SEQ + tl) * 1024 + 512 + h * 128;
    if (!close_enough(bf2f(M[k0]), w0, 0.03f, 0.04f) || !close_enough(bf2f(M[k1]), w1, 0.03f, 0.04f)) dbg_fail(F, 9);
}
__device__ __forceinline__ void dbg_check_router(Frame& F, const Args& a) {
    F.refresh();
    if (F.vcu >= 16) return;
    const int row = (F.vcu * 3079 + 17) % T;
    const float* w_o = (const float*)a.in[12]; const float* g = (const float*)a.in[13]; const float* bta = (const float*)a.in[14]; const float* wr_ = (const float*)a.in[15]; const float* br = (const float*)a.in[16];
    const bf16_t* MIX = (const bf16_t*)(F.ws + WS_MIX) + (size_t)row * 1024; const bf16_t* H0 = (const bf16_t*)(F.ws + WS_H0) + (size_t)row * 1024;
    const float* Y = (const float*)(F.ws + WS_Y) + (size_t)row * 1024; const bf16_t* H1 = (const bf16_t*)(F.ws + WS_H1) + (size_t)row * 1024;
    LAS float* mx = (LAS float*)F.lds; LAS float* h1 = mx + 1024; LAS float* red = h1 + 1024; LAS float* lg = red + 16;
    for (int k = F.tid; k < 1024; k += 512) mx[k] = bf2f(MIX[k]);
    __syncthreads();
    for (int n = F.tid; n < 1024; n += 512) { float acc = 0.f; for (int k = 0; k < 1024; ++k) acc += mx[k] * w_o[(size_t)k * 1024 + n];
        const float want = DN_ALPHA * bf2f(H0[n]) + acc; if (!close_enough(Y[n], want, 0.03f, 0.02f)) dbg_fail(F, 10); }
    float s = 0.f; for (int k = F.tid; k < 1024; k += 512) s += Y[k];
    s = wave_sum(s); if (F.lane == 0) red[F.wave] = s; __syncthreads();
    float mean = 0.f; for (int w = 0; w < 8; ++w) mean += red[w]; mean *= (1.f / D); __syncthreads();
    float q = 0.f; for (int k = F.tid; k < 1024; k += 512) { const float d = Y[k] - mean; q += d * d; }
    q = wave_sum(q); if (F.lane == 0) red[F.wave] = q; __syncthreads();
    float var = 0.f; for (int w = 0; w < 8; ++w) var += red[w]; var *= (1.f / D);
    const float rstd = 1.f / sqrtf(var + LN_EPS);
    for (int k = F.tid; k < 1024; k += 512) { const float hv = (Y[k] - mean) * rstd * g[k] + bta[k]; h1[k] = hv; if (!close_enough(bf2f(H1[k]), hv, 0.02f, 0.01f)) dbg_fail(F, 11); }
    __syncthreads();
    if (F.tid < 32) { float acc = 0.f; for (int k = 0; k < 1024; ++k) acc += h1[k] * wr_[(size_t)k * 32 + F.tid]; lg[F.tid] = acc + br[F.tid]; }
    __syncthreads();
    if (F.tid == 0) {
        const int* ts = (const int*)(F.ws + WS_TSLOT) + (size_t)row * 4; float l[32]; for (int e = 0; e < 32; ++e) l[e] = lg[e];
        int se[4]; float sl[4];
        for (int k = 0; k < 4; ++k) { int bi = 0; for (int e = 1; e < 32; ++e) if (l[e] > l[bi]) bi = e; se[k] = bi; sl[k] = l[bi]; l[bi] = -INFINITY; }
        float den = 0.f; for (int k = 0; k < 4; ++k) den += expf(sl[k] - sl[0]);
        for (int k = 0; k < 4; ++k) { const int e = ts[k] >> 16, pos = ts[k] & 0xffff;
            if (e != se[k] && fabsf(lg[e] - sl[k]) > 1e-4f) dbg_fail(F, 12);
            const float gt = ((const float*)(F.ws + WS_LGATE))[(size_t)e * T + pos];
            if (!close_enough(gt, expf(sl[k] - sl[0]) / den, 1e-3f, 1e-3f)) dbg_fail(F, 12);
            if (((const int*)(F.ws + WS_LTOK))[(size_t)e * T + pos] != row) dbg_fail(F, 13);
            if (pos >= (int)__hip_atomic_load(F.ctl + CW_CNT + e, RLX_AGENT)) dbg_fail(F, 13); }
    }
    __syncthreads();
}
__device__ __forceinline__ void dbg_check_moe(Frame& F, const Args& a) {
    F.refresh();
    if (F.vcu >= 32) return;
    const LAS int* cnt = (const LAS int*)(F.lds + XTRA_OFF + 4096); const LAS int* tstart = cnt + 32;
    const int e = F.vcu; if (cnt[e] == 0) return;
    const int slot = (F.vcu * 997 + 13) % cnt[e];
    const size_t prow = (size_t)tstart[e] * 256 + slot;
    const int tok = ((const int*)(F.ws + WS_LTOK))[(size_t)e * T + slot]; const float gt = ((const float*)(F.ws + WS_LGATE))[(size_t)e * T + slot];
    const float* w_up = (const float*)a.in[17] + (size_t)e * 1024 * 2048; const float* b_up = (const float*)a.in[18] + (size_t)e * 2048;
    const float* w_dn = (const float*)a.in[19] + (size_t)e * 1024 * 1024; const float* b_dn = (const float*)a.in[20] + (size_t)e * 1024;
    const bf16_t* H1 = (const bf16_t*)(F.ws + WS_H1) + (size_t)tok * 1024; const bf16_t* ACT = (const bf16_t*)(F.ws + WS_ACT) + prow * 1024; const bf16_t* YS = (const bf16_t*)(F.ws + WS_YS) + prow * 1024;
    LAS float* hx = (LAS float*)F.lds + 4096; LAS float* ac = hx + 1024;
    __syncthreads();
#if MOE_FP8
    for (int k = F.tid; k < 1024; k += 512) { hx[k] = bf2f(H1[k]); const unsigned char* A8 = (const unsigned char*)(F.ws + WS_ACT) + prow * 1024; ac[k] = __builtin_amdgcn_cvt_f32_fp8((int)A8[k], 0) * (1.f / ACT8_SCALE); }
#else
    for (int k = F.tid; k < 1024; k += 512) { hx[k] = bf2f(H1[k]); ac[k] = bf2f(ACT[k]); }
#endif
    __syncthreads();
    for (int j = F.tid; j < 1024; j += 512) { float gl = 0.f, li = 0.f; for (int k = 0; k < 1024; ++k) { gl += hx[k] * w_up[(size_t)k * 2048 + j]; li += hx[k] * w_up[(size_t)k * 2048 + 1024 + j]; }
        gl += b_up[j]; li += b_up[1024 + j]; gl = fminf(gl, 7.f); li = fminf(fmaxf(li, -7.f), 7.f);
        const float want = gl / (1.f + expf(-1.702f * gl)) * (li + 1.f);
        if (!close_enough(ac[j], want, MOE_FP8 ? 0.2f : 0.03f, MOE_FP8 ? 0.15f : 0.03f)) dbg_fail(F, 14); }
    for (int n = F.tid; n < 1024; n += 512) { float acc = 0.f; for (int j = 0; j < 1024; ++j) acc += ac[j] * w_dn[(size_t)j * 1024 + n];
        const float want = (acc + b_dn[n]) * gt; if (!close_enough(bf2f(YS[n]), want, MOE_FP8 ? 0.04f : 0.01f, MOE_FP8 ? 0.1f : 0.03f)) dbg_fail(F, 15); }
    __syncthreads();
}
__device__ __forceinline__ void dbg_check_final(Frame& F, const Args& a) {
    F.refresh();
    if (F.vcu >= 16) return;
    const LAS int* tstart = (const LAS int*)(F.lds + XTRA_OFF + 4096) + 32;
    const int row = (F.vcu * 1789 + 29) % T; const int* ts = (const int*)(F.ws + WS_TSLOT) + (size_t)row * 4;
    const bf16_t* H1 = (const bf16_t*)(F.ws + WS_H1) + (size_t)row * 1024; const bf16_t* YS = (const bf16_t*)(F.ws + WS_YS);
    LAS float* vv = (LAS float*)F.lds + 8192; LAS float* red = vv + 1024;
    __syncthreads();
    float s = 0.f;
    for (int c = F.tid; c < 1024; c += 512) { float v = DN_ALPHA * bf2f(H1[c]); for (int k = 0; k < 4; ++k) v += bf2f(YS[((size_t)tstart[ts[k] >> 16] * 256 + (ts[k] & 0xffff)) * 1024 + c]); vv[c] = v; s += v; }
    s = wave_sum(s); if (F.lane == 0) red[F.wave] = s; __syncthreads();
    float mean = 0.f; for (int w = 0; w < 8; ++w) mean += red[w]; mean *= (1.f / D); __syncthreads();
    float q = 0.f; for (int c = F.tid; c < 1024; c += 512) { const float d = vv[c] - mean; q += d * d; }
    q = wave_sum(q); if (F.lane == 0) red[F.wave] = q; __syncthreads();
    float var = 0.f; for (int w = 0; w < 8; ++w) var += red[w]; var *= (1.f / D);
    const float rstd = 1.f / sqrtf(var + LN_EPS); const float* g = (const float*)a.in[21]; const float* bta = (const float*)a.in[22];
    for (int c = F.tid; c < 1024; c += 512) { const float want = (vv[c] - mean) * rstd * g[c] + bta[c]; if (!close_enough(a.out[(size_t)row * 1024 + c], want, 0.01f, 0.01f)) dbg_fail(F, 16); }
    __syncthreads();
}
__device__ __forceinline__ void dbg_emit(Frame& F, float* out) {
    F.refresh();
    const unsigned m = __hip_atomic_load(F.ctl + CW_DBG, RLX_AGENT);
    const unsigned tm = __hip_atomic_load(F.ctl + CW_BAR + XB_TMO, RLX_AGENT);
    float C = 0.f;
    if (tm) C = 1e15f;
    else if (m) { const int id = __builtin_ctz(m); C = sqrtf(powf(10.f, (float)id) - 1.f); }
    const f32x4 v = (f32x4){C, C, C, C};
    for (size_t i = (size_t)F.vcu * 512 + F.tid; i < (size_t)T * D / 4; i += (size_t)F.G * 512) ((GAS f32x4*)out)[i] = v;
}

__global__ void __launch_bounds__(512, 2) fwd_kernel(Args args) {
    extern __shared__ __attribute__((aligned(16))) unsigned char lds[];
    Frame F;
    F.lds = (LAS unsigned char*)lds;
    F.MISC = (volatile LAS unsigned*)(F.lds + MISC_OFF);
    F.wave = __builtin_amdgcn_readfirstlane((int)threadIdx.x >> 6); F.refresh();
    F.G = gridDim.x; { const int bx = blockIdx.x; F.vcu = (F.G % 8 == 0) ? (bx % 8) * (F.G / 8) + bx / 8 : bx; }
    F.ws = args.ws; F.ctl = (gu32*)(args.ws + WS_CTL);
    for (int u = F.tid; u < 64; u += 512) ((LAS unsigned*)(F.lds + MISC_OFF))[u] = 0u;
    __syncthreads();
    XcdBarrier bar = xcd_barrier_post((unsigned*)(F.ctl + CW_BAR), F.MISC + 8);

#if TPROBE > 0
    int n_stamp = 0;
#define STAMP() do { F.refresh(); if (blockIdx.x == 0 && F.tid == 0) { const unsigned long long t_ = __builtin_amdgcn_s_memrealtime(); __hip_atomic_store(F.ctl + CW_TS + 2 * n_stamp, (unsigned)t_, RLX_AGENT); __hip_atomic_store(F.ctl + CW_TS + 2 * n_stamp + 1, (unsigned)(t_ >> 32), RLX_AGENT); } ++n_stamp; } while (0)
#else
#define STAMP() do {} while (0)
#endif
#define RUN_PHASE(k, ...) { __VA_ARGS__ } if (DUP_PHASE == (k)) { __VA_ARGS__ }
    STAMP();
    RUN_PHASE(0,
    p0_prologue(F, args);
    xcd_barrier(bar); STAMP();
    )
    RUN_PHASE(1,
    {
        pg8::DenseOrder S; S.init((const bf16_t*)(F.ws + WS_H0), D, (const bf16_t*)(F.ws + WS_WIN), D, T, NPROJ, F.G, (int)blockIdx.x);
        EpiProj E{(bf16_t*)(F.ws + WS_PROJ), (const float*)(F.ws + WS_COS), (const float*)(F.ws + WS_SIN), (const float*)(F.ws + WS_LB)};
        pg8::gemm_phase<EpiProj, pg8::DenseOrder>(F.lds, D, S, E, F.wave);
    }
    xcd_barrier(bar); STAMP();
    )
#if DBG_STAGE == 1
    dbg_check_proj(F, args);
    xcd_barrier(bar);
    dbg_emit(F, args.out);
    return;
#endif
    RUN_PHASE(2,
    {
        const bf16_t* PROJ = (const bf16_t*)(F.ws + WS_PROJ);
        LAS float* tabkv = (LAS float*)(F.lds + XTRA_OFF); LAS float* tabq = tabkv + 256;
        pg8::DenseOrder Skv; Skv.init(PROJ + PC_KVA, NPROJ, (const bf16_t*)(F.ws + WS_WKVB), KVL, T, 1024, F.G, (int)blockIdx.x);
        pg8::DenseOrder Sq; Sq.init(PROJ + PC_QA, NPROJ, (const bf16_t*)(F.ws + WS_WQB), QL, T, 768, F.G, (int)blockIdx.x);
        pg8::Unit u; F.refresh();
        if (Skv.next(0, u)) rs_table(PROJ, u.pm, PC_KVA, KVL, tabkv, F.tid);
        if (Sq.next(0, u)) rs_table(PROJ, u.pm, PC_QA, QL, tabq, F.tid);
        LDS_WAIT(); __syncthreads();
        EpiKV Ekv{(bf16_t*)(F.ws + WS_KV), tabkv};
        pg8::gemm_phase<EpiKV, pg8::DenseOrder>(F.lds, KVL, Skv, Ekv, F.wave);
        EpiQ Eq{(bf16_t*)(F.ws + WS_Q), (const float*)(F.ws + WS_COS), (const float*)(F.ws + WS_SIN), tabq};
        pg8::gemm_phase<EpiQ, pg8::DenseOrder>(F.lds, QL, Sq, Eq, F.wave);
        if (F.vcu * 4 + 3 < 1024) hg::pass_a4(F.vcu * 4, PROJ, (bf16_t*)(F.ws + WS_LT), (float*)(F.ws + WS_DEC), F.lds, F.wave);
    }
    xcd_barrier(bar); STAMP();
    )
    RUN_PHASE(3,
    {
        F.refresh();
        hg::pass_b((const bf16_t*)(F.ws + WS_LT), (const float*)(F.ws + WS_DEC), (bf16_t*)(F.ws + WS_SST), F.vcu * 512 + F.tid, F.G * 512);
        const int bh = F.vcu >> 2, s = F.vcu & 3;
        if (bh < NB * 8) {
            att::unit(bh >> 3, bh & 7, 7 - s, (const bf16_t*)(F.ws + WS_Q), (const bf16_t*)(F.ws + WS_KV), (const bf16_t*)(F.ws + WS_PROJ), (bf16_t*)(F.ws + WS_MIX), (float*)(F.ws + WS_SSQ), F.lds, F.wave);
            att::unit(bh >> 3, bh & 7, s, (const bf16_t*)(F.ws + WS_Q), (const bf16_t*)(F.ws + WS_KV), (const bf16_t*)(F.ws + WS_PROJ), (bf16_t*)(F.ws + WS_MIX), (float*)(F.ws + WS_SSQ), F.lds, F.wave);
        }
    }
    xcd_barrier(bar); STAMP();
    )
#if DBG_STAGE >= 2
    dbg_check_proj(F, args);
    __syncthreads();
    dbg_check_qkv(F, args);
    dbg_check_attn(F);
    xcd_barrier(bar);
#endif
    attn_normalise(F, (const float*)args.in[10]);
    if (F.vcu * 4 + 3 < 1024) hg::pass_c_units<4>(F.vcu * 4, (const bf16_t*)(F.ws + WS_PROJ), (const bf16_t*)(F.ws + WS_SST), (const float*)args.in[11], (bf16_t*)(F.ws + WS_MIX), F.lds, F.wave);
    xcd_barrier(bar); STAMP();
    if (DUP_PHASE == 4) { if (F.vcu * 4 + 3 < 1024) hg::pass_c_units<4>(F.vcu * 4, (const bf16_t*)(F.ws + WS_PROJ), (const bf16_t*)(F.ws + WS_SST), (const float*)args.in[11], (bf16_t*)(F.ws + WS_MIX), F.lds, F.wave); xcd_barrier(bar); }
#if DBG_STAGE >= 3
    dbg_check_norm(F, (const float*)args.in[10]);
    dbg_check_hgrn(F, (const float*)args.in[11]);
    xcd_barrier(bar);
#endif
    RUN_PHASE(5,
    {
        pg8::DenseOrder S; S.init((const bf16_t*)(F.ws + WS_MIX), D, (const bf16_t*)(F.ws + WS_WO), D, T, D, F.G, (int)blockIdx.x);
        EpiY E{(float*)(F.ws + WS_Y), (const bf16_t*)(F.ws + WS_H0)};
        pg8::gemm_phase<EpiY, pg8::DenseOrder>(F.lds, D, S, E, F.wave);
    }
    xcd_barrier(bar); STAMP();
    )
    p6_router(F, args);
    xcd_barrier(bar); STAMP();
    moe_table(F);
    RUN_PHASE(7,
    {
        const LAS int* cnt = (const LAS int*)(F.lds + XTRA_OFF + 4096); const LAS int* tstart = cnt + 32;
#if MOE_FP8
        MoeOrder<true> S{(const void*)(F.ws + WS_H1F8), (const void*)(F.ws + WS_WUP), D, D, 8, F.G, F.vcu, (size_t)2048 * D, cnt, tstart, (const int*)(F.ws + WS_LTOK), 1};
        EpiUp E{(unsigned char*)(F.ws + WS_ACT), (const float*)args.in[18]};
        pg8::gemm_phase<EpiUp, MoeOrder<true>, true>(F.lds, D, S, E, F.wave);
#else
        MoeOrder<true> S{(const void*)(F.ws + WS_H1), (const void*)(F.ws + WS_WUP), D, D, 8, F.G, F.vcu, (size_t)2048 * D, cnt, tstart, (const int*)(F.ws + WS_LTOK), 2};
        EpiUp E{(bf16_t*)(F.ws + WS_ACT), (const float*)args.in[18]};
        pg8::gemm_phase<EpiUp, MoeOrder<true>>(F.lds, D, S, E, F.wave);
#endif
    }
    xcd_barrier(bar); STAMP();
    )
    RUN_PHASE(8,
    {
        const LAS int* cnt = (const LAS int*)(F.lds + XTRA_OFF + 4096); const LAS int* tstart = cnt + 32;
        MoeOrder<false> S{(const void*)(F.ws + WS_ACT), (const void*)(F.ws + WS_WDN), DE, DE, 4, F.G, F.vcu, (size_t)D * DE, cnt, tstart, nullptr, MOE_FP8 ? 1 : 2};
        EpiDown E{(bf16_t*)(F.ws + WS_YS), (const float*)args.in[20], (const float*)(F.ws + WS_LGATE), cnt, tstart};
        pg8::gemm_phase<EpiDown, MoeOrder<false>, MOE_FP8 != 0>(F.lds, DE, S, E, F.wave);
    }
    xcd_barrier(bar); STAMP();
    )
    p9_final(F, args);
    if (DUP_PHASE == 9) { xcd_barrier(bar); p9_final(F, args); }
#if TPROBE > 0
    xcd_barrier(bar); STAMP();
    {
        F.refresh();
        const int pa = 2 * (TPROBE - 1), pb = pa + 1;
        unsigned long long t[4];
        for (int j = 0; j < 4; ++j) { const int idx = (j < 2 ? pa + j : pb + (j - 2)); t[j] = (unsigned long long)__hip_atomic_load(F.ctl + CW_TS + 2 * idx, RLX_AGENT) | ((unsigned long long)__hip_atomic_load(F.ctl + CW_TS + 2 * idx + 1, RLX_AGENT) << 32); }
        const float ua = (float)(t[1] - t[0]) * 0.01f, ub = (float)(t[3] - t[2]) * 0.01f;
        const float Bv = sqrtf(ub); const f32x4 v = (f32x4){Bv, Bv, Bv, Bv};
        for (size_t i = (size_t)F.vcu * 512 + F.tid; i < (size_t)T * D / 4; i += (size_t)F.G * 512) ((GAS f32x4*)args.out)[i] = v;
        VM_WAIT(); xcd_barrier(bar);
        if (blockIdx.x == 0 && F.tid == 0) args.out[0] = ua;
    }
#endif
#if DBG_STAGE >= 3
    xcd_barrier(bar);
#if DBG_STAGE >= 4
    dbg_check_moe(F, args);
#endif
    dbg_check_final(F, args);
    F.refresh(); if (F.vcu == 100 && F.tid == 0) dbg_fail(F, 20);
    xcd_barrier(bar);
    dbg_emit(F, args.out);
#endif
}

extern "C" void kernel_launch(void* const* d_in, const int* in_sizes, int n_in, void* d_out, int out_size, void* d_ws, size_t ws_size, hipStream_t stream) {
    static int grid = 0;
    if (grid == 0) {
        if (n_in != 23 || out_size != T * D || ws_size < WS_END_A) { fprintf(stderr, "kernel_launch: unexpected shapes (n_in %d out %d ws %zu)\n", n_in, out_size, ws_size); grid = -1; return; }
        int dev = 0, cus = 0, per_cu = 0;
        if (hipGetDevice(&dev) != hipSuccess || hipDeviceGetAttribute(&cus, hipDeviceAttributeMultiprocessorCount, dev) != hipSuccess) { grid = -1; return; }
        if (hipFuncSetAttribute((const void*)fwd_kernel, hipFuncAttributeMaxDynamicSharedMemorySize, LDS_BYTES) != hipSuccess) { fprintf(stderr, "kernel_launch: hipFuncSetAttribute failed\n"); grid = -1; return; }
        if (hipOccupancyMaxActiveBlocksPerMultiprocessor(&per_cu, (const void*)fwd_kernel, 512, LDS_BYTES) != hipSuccess || per_cu < 1) fprintf(stderr, "kernel_launch: occupancy query says %d\n", per_cu);
        (void)hipGetLastError();
        grid = cus;
    }
    if (grid < 0) return;
    if (hipMemsetAsync((char*)d_ws + WS_CTL, 0, CTL_ZERO_BYTES, stream) != hipSuccess) return;
    Args a{};
    for (int i = 0; i < 23; ++i) a.in[i] = d_in[i];
    a.out = (float*)d_out; a.ws = (unsigned char*)d_ws;
    hipLaunchKernelGGL(fwd_kernel, dim3(grid), dim3(512), LDS_BYTES, stream, a);
}
```
